# Optimizing an MI355X kernel written in HIP

```python
import math
import jax
import jax.numpy as jnp
from jax import lax
import numpy as np

D_MODEL = 1024
BATCH = 2
SEQ = 8192
DEPTH = 1

SSM_WIDTH = D_MODEL // 2
SSM_GROUP = 16
SSM_GROUPS = SSM_WIDTH // SSM_GROUP
SSM_STATE = 64
DT_MIN = 1e-3
DT_MAX = 1e-1

N_HEADS = 8
HEAD_DIM = 64
ATTN_WIDTH = N_HEADS * HEAD_DIM
IDX_HEADS = 8
IDX_DIM = 64
TOPK_KEYS = 256
Q_BLOCK = 128

N_EXPERTS = 32
TOP_K = 4
D_FF = D_MODEL
SWIGLU_LIMIT = 7.0
SWIGLU_ALPHA = 1.702
MOE_BLOCK = 128

N_BRANCHES = 2
LN_EPS = 1e-5
DEEPNORM_ALPHA = (2 * DEPTH) ** 0.25
DEEPNORM_BETA = (8 * DEPTH) ** -0.25

IN_SIZES = (SSM_WIDTH, ATTN_WIDTH, ATTN_WIDTH, ATTN_WIDTH, IDX_HEADS * IDX_DIM, IDX_DIM, IDX_HEADS, N_BRANCHES * D_MODEL)
IN_WIDTH = SSM_WIDTH + 3 * ATTN_WIDTH + IDX_HEADS * IDX_DIM + IDX_DIM + IDX_HEADS + N_BRANCHES * D_MODEL

kernel_name = "hybrid_s5_dsa_moe_deepnorm"


def layer_norm(x, g, b):
    xf = x.astype(jnp.float32)
    mu = jnp.mean(xf, axis=-1, keepdims=True)
    var = jnp.mean(jnp.square(xf - mu), axis=-1, keepdims=True)
    y = (xf - mu) * lax.rsqrt(var + LN_EPS) * g.astype(jnp.float32) + b.astype(jnp.float32)
    return y.astype(x.dtype)


def alibi_slopes(n_heads):
    return jnp.asarray([2.0 ** (-8.0 * (hh + 1) / n_heads) for hh in range(n_heads)], jnp.float32)


def s5_branch(u, lam_re, lam_im, log_dt, b_re, b_im, c_re, c_im, d_skip, w_glu):
    f32 = jnp.float32
    bsz, seq, _ = u.shape
    uf = u.astype(f32).reshape(bsz, seq, SSM_GROUPS, SSM_GROUP)
    lam = lax.complex(lam_re.astype(f32), lam_im.astype(f32))
    dt = jnp.exp(log_dt.astype(f32))[:, None]
    a_bar = jnp.exp(lam * dt)
    b_c = lax.complex(b_re.astype(f32), b_im.astype(f32))
    b_bar = ((a_bar - 1.0) / lam)[..., None] * b_c
    bu = jnp.einsum('blgp,gnp->blgn', uf.astype(jnp.complex64), b_bar)
    a_seq = jnp.broadcast_to(a_bar, bu.shape)

    def combine(e1, e2):
        a1, s1 = e1
        a2, s2 = e2
        return a1 * a2, a2 * s1 + s2

    _, states = lax.associative_scan(combine, (a_seq, bu), axis=1)
    c_c = lax.complex(c_re.astype(f32), c_im.astype(f32))
    y = jnp.einsum('blgn,gpn->blgp', states, c_c).real + d_skip.astype(f32) * uf
    y = jax.nn.gelu(y.reshape(bsz, seq, SSM_WIDTH)).astype(u.dtype)
    val, gate = jnp.split(y @ w_glu, 2, axis=-1)
    return val * jax.nn.sigmoid(gate)


def dsa_branch(q, k, v, q_idx, k_idx, w_idx):
    f32 = jnp.float32
    bsz, seq = q.shape[:2]
    n_sel = min(TOPK_KEYS, seq // 4)
    n_blk = seq // Q_BLOCK
    slopes = alibi_slopes(N_HEADS)
    key_pos = jnp.arange(seq, dtype=jnp.int32)
    k_idx_f = k_idx.astype(f32)

    def to_blocks(t):
        return t.reshape(bsz, n_blk, Q_BLOCK, *t.shape[2:]).swapaxes(0, 1)

    def block_fn(args):
        blk, qb, qib, wb = args
        q_pos = blk * Q_BLOCK + jnp.arange(Q_BLOCK, dtype=jnp.int32)
        causal = key_pos[None, :] <= q_pos[:, None]
        dots = jnp.einsum('bqhd,bsd->bhqs', qib.astype(f32), k_idx_f) * IDX_DIM ** -0.5
        score = jnp.einsum('bqh,bhqs->bqs', wb.astype(f32) * IDX_HEADS ** -0.5, jax.nn.relu(dots))
        score = jnp.where(causal[None], score, -jnp.inf)
        _, sel = lax.top_k(score, n_sel)
        k_sel = jax.vmap(lambda kk, ii: kk[ii])(k, sel)
        v_sel = jax.vmap(lambda vv, ii: vv[ii])(v, sel)
        dist = (q_pos[None, :, None] - sel).astype(f32)
        logits = jnp.einsum('bqhd,bqkhd->bhqk', qb.astype(f32), k_sel.astype(f32)) * HEAD_DIM ** -0.5
        logits = logits - slopes[None, :, None, None] * dist[:, None]
        logits = jnp.where((dist >= 0)[:, None], logits, -jnp.inf)
        p = jax.nn.softmax(logits, axis=-1)
        return jnp.einsum('bhqk,bqkhd->bqhd', p.astype(v.dtype), v_sel)

    outs = lax.map(block_fn, (jnp.arange(n_blk, dtype=jnp.int32), to_blocks(q), to_blocks(q_idx), to_blocks(w_idx)))
    return outs.swapaxes(0, 1).reshape(bsz, seq, N_HEADS * HEAD_DIM)


def moe_ffn(x, w_router, b_router, w_up, b_up, w_down, b_down):
    bsz, seq, d = x.shape
    xt = x.reshape(-1, d)
    n_tok = xt.shape[0]
    logits = (xt @ w_router + b_router).astype(jnp.float32)
    top_val, top_idx = lax.top_k(logits, TOP_K)
    gates = jax.nn.softmax(top_val, axis=-1)
    n_assign = n_tok * TOP_K
    flat_e = top_idx.reshape(-1)
    flat_tok = jnp.repeat(jnp.arange(n_tok, dtype=jnp.int32), TOP_K)
    flat_g = gates.reshape(-1)
    order = jnp.argsort(flat_e)
    se, stok, sg = flat_e[order], flat_tok[order], flat_g[order]
    counts = jnp.bincount(flat_e, length=N_EXPERTS)
    starts = jnp.cumsum(counts) - counts
    padded = (counts + MOE_BLOCK - 1) // MOE_BLOCK * MOE_BLOCK
    pends = jnp.cumsum(padded)
    pstarts = pends - padded
    dest = pstarts[se] + jnp.arange(n_assign, dtype=jnp.int32) - starts[se]
    n_rows = n_assign + N_EXPERTS * MOE_BLOCK
    n_blocks = n_rows // MOE_BLOCK
    row_tok = jnp.full((n_rows,), n_tok, jnp.int32).at[dest].set(stok)
    row_gate = jnp.zeros((n_rows,), jnp.float32).at[dest].set(sg)
    blk_start = jnp.arange(n_blocks, dtype=jnp.int32) * MOE_BLOCK
    blk_expert = jnp.minimum(jnp.searchsorted(pends, blk_start, side='right'), N_EXPERTS - 1)

    def expert_block(args):
        e, toks, g = args
        xb = jnp.take(xt, toks, axis=0, mode='clip')
        hdn = xb @ w_up[e] + b_up[e]
        h_gate, h_lin = jnp.split(hdn, 2, axis=-1)
        h_gate = jnp.minimum(h_gate, SWIGLU_LIMIT)
        h_lin = jnp.clip(h_lin, -SWIGLU_LIMIT, SWIGLU_LIMIT)
        act = (h_lin + 1.0) * (h_gate * jax.nn.sigmoid(SWIGLU_ALPHA * h_gate))
        y = act @ w_down[e] + b_down[e]
        return y * g[:, None].astype(y.dtype)

    ys = lax.map(expert_block, (blk_expert, row_tok.reshape(n_blocks, MOE_BLOCK), row_gate.reshape(n_blocks, MOE_BLOCK)))
    out = jnp.zeros_like(xt).at[row_tok].add(ys.reshape(n_rows, d), mode='drop')
    return out.reshape(bsz, seq, d)


def setup_inputs(seed: int = 0) -> dict:
    key = jax.random.key(seed)
    ks = jax.random.split(key, 26)
    f32 = jnp.float32

    def nrm(k, shape, scale):
        return scale * jax.random.normal(k, shape, f32)

    nl, d = DEPTH, D_MODEL
    n_idx = jnp.arange(SSM_STATE, dtype=f32)
    g_shape = (nl, SSM_GROUPS, SSM_STATE)
    return {
        "x": nrm(ks[0], (BATCH, SEQ, d), 1.0),
        "ln_in_g": 1.0 + nrm(ks[1], (d,), 0.02),
        "ln_in_b": nrm(ks[2], (d,), 0.02),
        "w_in": nrm(ks[3], (nl, d, IN_WIDTH), d ** -0.5),
        "b_gate": nrm(ks[4], (nl, N_BRANCHES * d), 0.02),
        "lam_re": -0.5 + nrm(ks[5], g_shape, 0.01),
        "lam_im": math.pi * n_idx + nrm(ks[6], g_shape, 0.01),
        "log_dt": jax.random.uniform(ks[7], (nl, SSM_GROUPS), f32, math.log(DT_MIN), math.log(DT_MAX)),
        "b_re": nrm(ks[8], (nl, SSM_GROUPS, SSM_STATE, SSM_GROUP), (2 * SSM_GROUP) ** -0.5),
        "b_im": nrm(ks[9], (nl, SSM_GROUPS, SSM_STATE, SSM_GROUP), (2 * SSM_GROUP) ** -0.5),
        "c_re": nrm(ks[10], (nl, SSM_GROUPS, SSM_GROUP, SSM_STATE), 0.5),
        "c_im": nrm(ks[11], (nl, SSM_GROUPS, SSM_GROUP, SSM_STATE), 0.5),
        "d_skip": nrm(ks[12], (nl, SSM_GROUPS, SSM_GROUP), 1.0),
        "w_glu": nrm(ks[13], (nl, SSM_WIDTH, 2 * d), SSM_WIDTH ** -0.5),
        "w_attn_proj": nrm(ks[14], (nl, ATTN_WIDTH, d), ATTN_WIDTH ** -0.5),
        "w_o": nrm(ks[15], (nl, d, d), DEEPNORM_BETA * d ** -0.5),
        "ln1_g": 1.0 + nrm(ks[16], (nl, d), 0.02),
        "ln1_b": nrm(ks[17], (nl, d), 0.02),
        "w_router": nrm(ks[18], (nl, d, N_EXPERTS), d ** -0.5),
        "b_router": nrm(ks[19], (nl, N_EXPERTS), 0.01),
        "w_up": nrm(ks[20], (nl, N_EXPERTS, d, 2 * D_FF), d ** -0.5),
        "b_up": nrm(ks[21], (nl, N_EXPERTS, 2 * D_FF), 0.02),
        "w_down": nrm(ks[22], (nl, N_EXPERTS, D_FF, d), DEEPNORM_BETA * D_FF ** -0.5),
        "b_down": nrm(ks[23], (nl, N_EXPERTS, d), 0.02),
        "ln2_g": 1.0 + nrm(ks[24], (nl, d), 0.02),
        "ln2_b": nrm(ks[25], (nl, d), 0.02),
    }


def reference(x, ln_in_g, ln_in_b, w_in, b_gate, lam_re, lam_im, log_dt, b_re, b_im, c_re, c_im, d_skip, w_glu, w_attn_proj, w_o, ln1_g, ln1_b, w_router, b_router, w_up, b_up, w_down, b_down, ln2_g, ln2_b):
    bsz, seq, _ = x.shape
    split_points = np.cumsum(np.array(IN_SIZES))[:-1].tolist()
    h = layer_norm(x, ln_in_g, ln_in_b)
    for l in range(DEPTH):
        proj = h @ w_in[l]
        u, q, k, v, q_idx, k_idx, w_idx, gate_pre = jnp.split(proj, split_points, axis=-1)
        y_ssm = s5_branch(u, lam_re[l], lam_im[l], log_dt[l], b_re[l], b_im[l], c_re[l], c_im[l], d_skip[l], w_glu[l])
        y_att = dsa_branch(q.reshape(bsz, seq, N_HEADS, HEAD_DIM),
                           k.reshape(bsz, seq, N_HEADS, HEAD_DIM),
                           v.reshape(bsz, seq, N_HEADS, HEAD_DIM),
                           q_idx.reshape(bsz, seq, IDX_HEADS, IDX_DIM),
                           k_idx, w_idx) @ w_attn_proj[l]
        g_ssm, g_att = jnp.split(jax.nn.sigmoid(gate_pre + b_gate[l]), N_BRANCHES, axis=-1)
        mix = (g_ssm * y_ssm + g_att * y_att) @ w_o[l]
        h = layer_norm(DEEPNORM_ALPHA * h + mix, ln1_g[l], ln1_b[l])
        ffn = moe_ffn(h, w_router[l], b_router[l], w_up[l], b_up[l], w_down[l], b_down[l])
        h = layer_norm(DEEPNORM_ALPHA * h + ffn, ln2_g[l], ln2_b[l])
    return h
```

```cpp
#include <hip/hip_runtime.h>
#include <hip/hip_cooperative_groups.h>
#include <cstdio>
#include <cstdint>

namespace pg8 {
#define PG8_LAS __attribute__((address_space(3)))
typedef unsigned short bf16_t;
typedef short bf16x8 __attribute__((ext_vector_type(8)));
typedef float f32x4 __attribute__((ext_vector_type(4)));
typedef unsigned u32x4 __attribute__((ext_vector_type(4)));
constexpr int BM = 256, BK = 64, HALF = 128, HTB = HALF * BK * 2, STAGE_BYTES = 8 * HTB, NXCD = 8, WGM = 8;

__host__ __device__ __forceinline__ int lds_byte(int r, int c) { const int st = (r >> 4) * 2 + (c >> 5), rr = r & 15, cc = c & 31, ob = rr * 64 + cc * 2; return st * 1024 + (ob ^ (((ob >> 9) & 1) << 5)); }
__host__ __device__ __forceinline__ void stage_rc(int b, int& R, int& C) { const int st = b / 1024, sb = b % 1024, swz = sb ^ (((sb >> 9) & 1) << 5); R = (st >> 1) * 16 + swz / 64; C = (st & 1) * 32 + (swz % 64) / 2; }
__host__ __device__ __forceinline__ int perm32(int rho) { const int n = rho >> 4, i = rho & 15; return 8 * (i >> 2) + 4 * n + (i & 3); }

struct Unit { int pm, pn, pb, e; };
struct Gemm { const bf16_t* A; const bf16_t* Bt; int M, N, K; const PG8_LAS int* tokl; };

struct StaticOrder {
    int nM, nN, nwg, G, c;
    __host__ __device__ void init(int M, int N, int G_, int c_) { nM = M / BM; nN = N / BM; nwg = nM * nN; G = G_; c = c_; }
    __host__ __device__ bool next(int i, Unit& u) const {
        const long L = (long)i * G + c; if (L >= nwg) return false;
        int wgid = (int)L; { const int q = nwg / NXCD, r = nwg % NXCD, xcd = wgid % NXCD, off = wgid / NXCD; wgid = (xcd < r ? xcd * (q + 1) : r * (q + 1) + (xcd - r) * q) + off; }
        const int nig = WGM * nN, gid = wgid / nig, fm = gid * WGM, gsz = (nM - fm) < WGM ? (nM - fm) : WGM;
        u.pm = fm + ((wgid % nig) % gsz); u.pn = (wgid % nig) / gsz; u.pb = u.pn; u.e = 0; return true;
    }
    __device__ __forceinline__ void a_ready(const Unit&) const {}
    __device__ __forceinline__ void done(const Unit&) const {}
};
struct OneUnit {
    Unit u; bool have;
    __device__ __forceinline__ bool next(int i, Unit& o) const { if (i != 0 || !have) return false; o = u; return true; }
    __device__ __forceinline__ void a_ready(const Unit&) const {}
    __device__ __forceinline__ void done(const Unit&) const {}
};
struct MoeOrder {
    int nunits, nN, G, c; const PG8_LAS int* tile_e;
    __device__ __forceinline__ bool next(int i, Unit& u) const {
        const long L = (long)i * G + c; if (L >= nunits) return false;
        int wgid = (int)L; { const int q = nunits / NXCD, r = nunits % NXCD, xcd = wgid % NXCD, off = wgid / NXCD; wgid = (xcd < r ? xcd * (q + 1) : r * (q + 1) + (xcd - r) * q) + off; }
        const int tile = wgid / nN, pn = wgid % nN; u.pm = tile; u.pn = pn; u.e = tile_e[tile]; u.pb = u.e * nN + pn; return true;
    }
    __device__ __forceinline__ void a_ready(const Unit&) const {}
    __device__ __forceinline__ void done(const Unit&) const {}
};

typedef float f32x2_cv __attribute__((ext_vector_type(2))); typedef __bf16 bf16x2_cv __attribute__((ext_vector_type(2)));
__device__ __forceinline__ unsigned cvt_pk_bf16(float lo, float hi) { const f32x2_cv v = {lo, hi}; const bf16x2_cv b = __builtin_convertvector(v, bf16x2_cv); return __builtin_bit_cast(unsigned, b); }

template <class Epi, class Sched, bool ALIGN_EPI = false, bool SP2 = false, bool GATHER = false>
__device__ __forceinline__ void gemm_phase(PG8_LAS unsigned char* lds, const Gemm g, const Sched& S, const Epi& E) {
    const int tid = threadIdx.x, wid = __builtin_amdgcn_readfirstlane(tid >> 6), lane = tid & 63, wr = wid >> 2, wc = wid & 3, fr = lane & 15, fq = lane >> 4;
    const int K = g.K, nt = K / BK;
    unsigned voffA[2], voffB[2];
#pragma unroll
    for (int i = 0; i < 2; ++i) { int R, C; stage_rc(tid * 16 + i * 8192, R, C); const int Rb = Epi::PERM ? ((R & ~31) + perm32(R & 31)) : R;
        voffA[i] = (unsigned)(R * K + C) * 2u; voffB[i] = (unsigned)(Rb * K + C) * 2u; }
    unsigned vg[2][2] = {{0u, 0u}, {0u, 0u}}, vn[2][2] = {{0u, 0u}, {0u, 0u}}, v2[2][2] = {{0u, 0u}, {0u, 0u}};
    auto tok_offs = [&](int slot, unsigned (&vo)[2][2]) {
#pragma unroll
        for (int h = 0; h < 2; ++h)
#pragma unroll
            for (int i = 0; i < 2; ++i) { int R, C; stage_rc(tid * 16 + i * 8192, R, C); vo[h][i] = (unsigned)(g.tokl[slot * 256 + h * HALF + R] * K + C) * 2u; } };
    const size_t kstep = (size_t)(BK * 2);
    const size_t hstep = (size_t)HALF * K * 2;
    const size_t tstep = 2 * hstep;
    const unsigned ldsw = (unsigned)wid * 1024u;
    const int aoff = lds_byte(wr * 64 + fr, fq * 8), boff = lds_byte(wc * 32 + fr, fq * 8);
#define PG8_SA(b, h) (((b) * 2 + (h)) * HTB)
#define PG8_SB(b, h) ((4 + (b) * 2 + (h)) * HTB)
#define PG8_STAGE(bufoff, gbase, voff) do { _Pragma("unroll") for (int _i = 0; _i < 2; ++_i) \
        __builtin_amdgcn_global_load_lds((const unsigned*)((const char*)(gbase) + (voff)[_i]), (PG8_LAS unsigned*)(lds + (bufoff) + ldsw + _i * 8192), 16, 0, 0); } while (0)
#define PG8_STAGEA(bufoff, gbase, h, vo) do { if constexpr (GATHER) { _Pragma("unroll") for (int _i = 0; _i < 2; ++_i) \
        __builtin_amdgcn_global_load_lds((const unsigned*)((const char*)(gbase) + (vo)[h][_i]), (PG8_LAS unsigned*)(lds + (bufoff) + ldsw + _i * 8192), 16, 0, 0); } \
        else { PG8_STAGE(bufoff, (const char*)(gbase) + (h) * hstep, voffA); } } while (0)
#define PG8_LDA(dst, b, h) do { _Pragma("unroll") for (int m = 0; m < 4; ++m) _Pragma("unroll") for (int k = 0; k < 2; ++k) dst[m][k] = *(const PG8_LAS bf16x8*)(lds + PG8_SA(b, h) + aoff + m * 2048 + k * 1024); } while (0)
#define PG8_LDB(dst, b, h) do { _Pragma("unroll") for (int n = 0; n < 2; ++n) _Pragma("unroll") for (int k = 0; k < 2; ++k) dst[n][k] = *(const PG8_LAS bf16x8*)(lds + PG8_SB(b, h) + boff + n * 2048 + k * 1024); } while (0)
#define PG8_MMA(ai, bj, At, Bt) do { __builtin_amdgcn_s_setprio(1); _Pragma("unroll") for (int m = 0; m < 4; ++m) _Pragma("unroll") for (int n = 0; n < 2; ++n) _Pragma("unroll") for (int k = 0; k < 2; ++k) \
        acc[ai][bj][m][n] = __builtin_amdgcn_mfma_f32_16x16x32_bf16(Bt[n][k], At[m][k], acc[ai][bj][m][n], 0, 0, 0); __builtin_amdgcn_s_setprio(0); } while (0)
#define PG8_WAIT_V(n) asm volatile("s_waitcnt vmcnt(" #n ")" ::: "memory")
#define PG8_WAIT_L(n) asm volatile("s_waitcnt lgkmcnt(" #n ")" ::: "memory")
#define PG8_BAR __builtin_amdgcn_s_barrier()
#define PG8_SCHED __builtin_amdgcn_sched_barrier(0)
    Unit cur, nxt; int ui = 0;
    if (!S.next(0, cur)) return;
    f32x4 acc[2][2][4][2];
#pragma unroll
    for (int a = 0; a < 2; ++a)
#pragma unroll
        for (int b = 0; b < 2; ++b)
#pragma unroll
            for (int m = 0; m < 4; ++m)
#pragma unroll
                for (int n = 0; n < 2; ++n) acc[a][b][m][n] = (f32x4){0.f, 0.f, 0.f, 0.f};
    bf16x8 At[4][2], B0[2][2], B1[2][2];
    const char* cA = (const char*)g.A + (GATHER ? (size_t)0 : (size_t)cur.pm * tstep); const char* cB = (const char*)g.Bt + (size_t)cur.pb * tstep;
    if constexpr (GATHER) tok_offs(0, vg);
    S.a_ready(cur);
    if constexpr (SP2) {
        PG8_STAGE(PG8_SB(0, 0), cB, voffB); PG8_STAGE(PG8_SB(0, 1), cB + hstep, voffB); PG8_STAGEA(PG8_SA(0, 0), cA, 0, vg); PG8_STAGEA(PG8_SA(0, 1), cA, 1, vg);
        if (wr == 1) PG8_BAR;
        PG8_WAIT_V(2); PG8_BAR;
        PG8_STAGE(PG8_SB(1, 0), cB + kstep, voffB); PG8_STAGEA(PG8_SA(1, 0), cA + kstep, 0, vg); PG8_STAGE(PG8_SB(1, 1), cB + hstep + kstep, voffB);
        PG8_WAIT_V(6); PG8_BAR;
    } else {
        PG8_STAGE(PG8_SB(0, 0), cB, voffB); PG8_STAGEA(PG8_SA(0, 0), cA, 0, vg); PG8_STAGE(PG8_SB(0, 1), cB + hstep, voffB); PG8_STAGEA(PG8_SA(0, 1), cA, 1, vg);
        if (wr == 1) PG8_BAR;
        PG8_WAIT_V(4); PG8_BAR;
        PG8_STAGE(PG8_SB(1, 0), cB + kstep, voffB); PG8_STAGEA(PG8_SA(1, 0), cA + kstep, 0, vg); PG8_STAGE(PG8_SB(1, 1), cB + hstep + kstep, voffB);
        PG8_WAIT_V(6); PG8_BAR;
    }
    for (;;) {
        const bool has_next = S.next(ui + 1, nxt);
        const char* nA = (has_next && !GATHER) ? (const char*)g.A + (size_t)nxt.pm * tstep : cA; const char* nB = has_next ? (const char*)g.Bt + (size_t)nxt.pb * tstep : cB;
        if constexpr (GATHER) { if (has_next) tok_offs(ui + 1, vn); }
        for (int t = 0; t < nt; t += 2) {
            const bool last = (t == nt - 2);
            const char* a1 = cA + (size_t)(t + 1) * kstep;
            const char* a2 = last ? nA : cA + (size_t)(t + 2) * kstep; const char* b2 = last ? nB : cB + (size_t)(t + 2) * kstep;
            const char* a3 = a2 + kstep; const char* b3 = b2 + kstep;
            if (last && has_next) S.a_ready(nxt);
            if constexpr (GATHER) { const bool un = last && has_next;
#pragma unroll
                for (int h = 0; h < 2; ++h)
#pragma unroll
                    for (int i = 0; i < 2; ++i) v2[h][i] = un ? vn[h][i] : vg[h][i]; }
            if constexpr (SP2) {
            PG8_LDB(B0, 0, 0); PG8_LDB(B1, 0, 1); PG8_SCHED; PG8_LDA(At, 0, 0); PG8_STAGEA(PG8_SA(1, 1), a1, 1, vg);
            PG8_WAIT_V(8); PG8_WAIT_L(0); PG8_BAR; PG8_MMA(0, 0, At, B0); PG8_MMA(0, 1, At, B1); PG8_BAR; PG8_SCHED;
            PG8_LDA(At, 0, 1); PG8_STAGE(PG8_SB(0, 0), b2, voffB); PG8_STAGE(PG8_SB(0, 1), b2 + hstep, voffB); PG8_STAGEA(PG8_SA(0, 0), a2, 0, v2);
            PG8_WAIT_V(8); PG8_WAIT_L(0); PG8_BAR; PG8_MMA(1, 0, At, B0); PG8_MMA(1, 1, At, B1); PG8_BAR; PG8_SCHED;
            PG8_LDB(B0, 1, 0); PG8_LDB(B1, 1, 1); PG8_SCHED; PG8_LDA(At, 1, 0); PG8_STAGEA(PG8_SA(0, 1), a2, 1, v2);
            PG8_WAIT_V(8); PG8_WAIT_L(0); PG8_BAR; PG8_MMA(0, 0, At, B0); PG8_MMA(0, 1, At, B1); PG8_BAR; PG8_SCHED;
            PG8_LDA(At, 1, 1); PG8_STAGE(PG8_SB(1, 0), b3, voffB); PG8_STAGE(PG8_SB(1, 1), b3 + hstep, voffB); PG8_STAGEA(PG8_SA(1, 0), a3, 0, v2);
            PG8_WAIT_V(8); PG8_WAIT_L(0); PG8_BAR; PG8_MMA(1, 0, At, B0); PG8_MMA(1, 1, At, B1); PG8_BAR; PG8_SCHED;
            } else {
            PG8_LDB(B0, 0, 0); PG8_SCHED; PG8_LDA(At, 0, 0); PG8_STAGEA(PG8_SA(1, 1), a1, 1, vg);
            PG8_WAIT_L(8); PG8_BAR; PG8_WAIT_L(0); PG8_MMA(0, 0, At, B0); PG8_BAR; PG8_SCHED;
            PG8_LDB(B1, 0, 1); PG8_STAGE(PG8_SB(0, 0), b2, voffB);
            PG8_BAR; PG8_WAIT_L(0); PG8_MMA(0, 1, At, B1); PG8_BAR;
            PG8_LDA(At, 0, 1); PG8_STAGEA(PG8_SA(0, 0), a2, 0, v2);
            PG8_BAR; PG8_WAIT_L(0); PG8_MMA(1, 0, At, B0); PG8_BAR; PG8_SCHED;
            PG8_STAGE(PG8_SB(0, 1), b2 + hstep, voffB);
            PG8_WAIT_V(6); PG8_BAR; PG8_MMA(1, 1, At, B1); PG8_BAR;
            PG8_LDB(B0, 1, 0); PG8_SCHED; PG8_LDA(At, 1, 0); PG8_STAGEA(PG8_SA(0, 1), a2, 1, v2);
            PG8_WAIT_L(8); PG8_BAR; PG8_WAIT_L(0); PG8_MMA(0, 0, At, B0); PG8_BAR; PG8_SCHED;
            PG8_LDB(B1, 1, 1); PG8_STAGE(PG8_SB(1, 0), b3, voffB);
            PG8_BAR; PG8_WAIT_L(0); PG8_MMA(0, 1, At, B1); PG8_BAR;
            PG8_LDA(At, 1, 1); PG8_STAGEA(PG8_SA(1, 0), a3, 0, v2);
            PG8_BAR; PG8_WAIT_L(0); PG8_MMA(1, 0, At, B0); PG8_BAR; PG8_SCHED;
            PG8_STAGE(PG8_SB(1, 1), b3 + hstep, voffB);
            PG8_WAIT_V(6); PG8_BAR; PG8_MMA(1, 1, At, B1); PG8_BAR;
            }
        }
        if constexpr (ALIGN_EPI) { if (wr == 0) PG8_BAR; }
        E(acc, cur, wr, wc, fr, fq); S.done(cur);
        if (!has_next) break;
#pragma unroll
        for (int a = 0; a < 2; ++a)
#pragma unroll
            for (int b = 0; b < 2; ++b)
#pragma unroll
                for (int m = 0; m < 4; ++m)
#pragma unroll
                    for (int n = 0; n < 2; ++n) acc[a][b][m][n] = (f32x4){0.f, 0.f, 0.f, 0.f};
        cur = nxt; cA = nA; cB = nB; ++ui;
        if constexpr (GATHER) {
#pragma unroll
            for (int h = 0; h < 2; ++h)
#pragma unroll
                for (int i = 0; i < 2; ++i) vg[h][i] = vn[h][i]; }
        if constexpr (ALIGN_EPI) { if (wr == 1) PG8_BAR; }
    }
    PG8_WAIT_V(0);
    if constexpr (!ALIGN_EPI) { if (wr == 0) PG8_BAR; }
    PG8_BAR;
#undef PG8_SA
#undef PG8_SB
#undef PG8_STAGE
#undef PG8_STAGEA
#undef PG8_LDA
#undef PG8_LDB
#undef PG8_MMA
#undef PG8_WAIT_V
#undef PG8_WAIT_L
#undef PG8_BAR
#undef PG8_SCHED
}
}


#include <hip/hip_bf16.h>
namespace attn_body {
using bf16=__hip_bfloat16;
using bf16x8=__attribute__((ext_vector_type(8)))short;
using s16x4=__attribute__((ext_vector_type(4)))short;
using f32x16=__attribute__((ext_vector_type(16)))float;
using u32x4=__attribute__((ext_vector_type(4)))unsigned;
constexpr int BATCH=2,NHEAD=8,SEQ=8192,D=64,DM=NHEAD*D;
constexpr int NW=8,QBLK=32,QB=QBLK*NW,KVBLK=64,NQB=SEQ/QB;
__device__ __forceinline__ int crow(int r,int hi){return (r&3)+8*(r>>2)+4*hi;}
#define SBAR() __builtin_amdgcn_sched_barrier(0)
constexpr int NSLOT=3, SLOTB=8192;
constexpr int LDS_K=0, LDS_V=NSLOT*SLOTB, LDS_WS=2*NSLOT*SLOTB, LDS_OST=LDS_WS+NW*64*4, LDS_BYTES=LDS_OST+NW*4096;
__device__ __forceinline__ void glds16(const void*gsrc,unsigned lds_dst){unsigned keep;
  asm volatile("s_mov_b32 %0, m0\n\ts_mov_b32 m0, %2\n\ts_nop 0\n\tglobal_load_lds_dwordx4 %1, off\n\ts_mov_b32 m0, %0":"=&s"(keep):"v"(gsrc),"s"(lds_dst):"memory");}
__device__ __forceinline__ float max3f(float a,float b,float c){float r;asm("v_max3_f32 %0, %1, %2, %3":"=v"(r):"v"(a),"v"(b),"v"(c));return r;}
__device__ __forceinline__ float max2f(float a,float b){float r;asm("v_max_f32_e32 %0, %1, %2":"=v"(r):"v"(a),"v"(b));return r;}
__device__ __forceinline__ float fadd_s(float a,float b){float r;asm("v_add_f32_e32 %0, %1, %2":"=v"(r):"v"(a),"v"(b));return r;}
__device__ __forceinline__ float fsub_s(float a,float b){float r;asm("v_sub_f32_e32 %0, %1, %2":"=v"(r):"v"(a),"v"(b));return r;}
typedef float f32x2_t __attribute__((ext_vector_type(2))); typedef __bf16 bf16x2_t __attribute__((ext_vector_type(2)));
__device__ __forceinline__ unsigned cvtpk_s(float lo,float hi){f32x2_t v={lo,hi};bf16x2_t b=__builtin_convertvector(v,bf16x2_t);return __builtin_bit_cast(unsigned,b);}
#define WAIT_BAR(N) asm volatile("s_waitcnt vmcnt(" #N ") lgkmcnt(0)\n\ts_barrier":::"memory")
__device__ __forceinline__ void qkt(f32x16&p0,f32x16&p1,const char*Kslot,const bf16x8*qr,const f32x16&negm,int r32,int hi){
  const char*kb=Kslot+hi*1024+r32*16;
  #pragma unroll
  for(int d0=0;d0<4;++d0){
    const bf16x8 b0=*reinterpret_cast<const bf16x8*>(kb+d0*2048);
    const bf16x8 b1=*reinterpret_cast<const bf16x8*>(kb+d0*2048+512);
    if(d0==0){p0=__builtin_amdgcn_mfma_f32_32x32x16_bf16(b0,qr[0],negm,0,0,0);p1=__builtin_amdgcn_mfma_f32_32x32x16_bf16(b1,qr[0],negm,0,0,0);}
    else{p0=__builtin_amdgcn_mfma_f32_32x32x16_bf16(b0,qr[d0],p0,0,0,0);p1=__builtin_amdgcn_mfma_f32_32x32x16_bf16(b1,qr[d0],p1,0,0,0);}}
}
typedef __attribute__((address_space(3))) const char* lds_cptr;
typedef short v4i16_t __attribute__((ext_vector_type(4)));
__device__ __forceinline__ void kload8(bf16x8*kf,lds_cptr kp){
  kf[0]=*(const __attribute__((address_space(3))) bf16x8*)(kp);      kf[1]=*(const __attribute__((address_space(3))) bf16x8*)(kp+512);
  kf[2]=*(const __attribute__((address_space(3))) bf16x8*)(kp+2048); kf[3]=*(const __attribute__((address_space(3))) bf16x8*)(kp+2560);
  kf[4]=*(const __attribute__((address_space(3))) bf16x8*)(kp+4096); kf[5]=*(const __attribute__((address_space(3))) bf16x8*)(kp+4608);
  kf[6]=*(const __attribute__((address_space(3))) bf16x8*)(kp+6144); kf[7]=*(const __attribute__((address_space(3))) bf16x8*)(kp+6656);
}
__device__ __forceinline__ void kload2(bf16x8*kf,lds_cptr kp,int j){ kf[2*j]=*(const __attribute__((address_space(3))) bf16x8*)(kp+j*2048); kf[2*j+1]=*(const __attribute__((address_space(3))) bf16x8*)(kp+j*2048+512); }
__device__ __forceinline__ s16x4 vtr(lds_cptr p){ return __builtin_bit_cast(s16x4,__builtin_amdgcn_ds_read_tr16_b64_v4i16((__attribute__((address_space(3))) v4i16_t*)p)); }
__device__ __forceinline__ float rowmax(const f32x16&p0,const f32x16&p1){
  float a=max3f(p0[0],p0[1],p1[0]),b=max3f(p0[2],p0[3],p1[1]);a=max3f(a,p1[2],p1[3]);
  #pragma unroll
  for(int r=4;r<16;r+=4){a=max3f(a,p0[r],p0[r+1]);b=max3f(b,p0[r+2],p0[r+3]);a=max3f(a,p1[r],p1[r+1]);b=max3f(b,p1[r+2],p1[r+3]);}
  const float m=max2f(a,b);
  auto rr=__builtin_amdgcn_permlane32_swap(__float_as_uint(m),__float_as_uint(m),false,false);
  return max2f(__uint_as_float(rr[0]),__uint_as_float(rr[1]));
}
__device__ __forceinline__ void pv(f32x16*o,int vb,bf16x8 pa0,bf16x8 pa1,bf16x8 pa2,bf16x8 pa3){
  #pragma unroll
  for(int d0=0;d0<2;++d0){s16x4 lo[4],hi[4];
    #pragma unroll
    for(int ks=0;ks<4;++ks){
      asm volatile("ds_read_b64_tr_b16 %0,%1 offset:%c2":"=&v"(lo[ks]):"v"(vb),"i"(d0*4096+ks*1024):"memory");
      asm volatile("ds_read_b64_tr_b16 %0,%1 offset:%c2":"=&v"(hi[ks]):"v"(vb),"i"(d0*4096+ks*1024+512):"memory");}
    asm volatile("s_waitcnt lgkmcnt(0)":::"memory");SBAR();
    #define PK(k) (bf16x8){lo[k][0],lo[k][1],lo[k][2],lo[k][3],hi[k][0],hi[k][1],hi[k][2],hi[k][3]}
    o[d0]=__builtin_amdgcn_mfma_f32_32x32x16_bf16(pa0,PK(0),o[d0],0,0,0);
    o[d0]=__builtin_amdgcn_mfma_f32_32x32x16_bf16(pa1,PK(1),o[d0],0,0,0);
    o[d0]=__builtin_amdgcn_mfma_f32_32x32x16_bf16(pa2,PK(2),o[d0],0,0,0);
    o[d0]=__builtin_amdgcn_mfma_f32_32x32x16_bf16(pa3,PK(3),o[d0],0,0,0);
    #undef PK
  }
}
__device__ __forceinline__ float bfi_f(unsigned m,float x,float y){float r;asm("v_bfi_b32 %0, %1, %2, %3":"=v"(r):"v"(m),"v"(x),"v"(y));return r;}
__device__ __forceinline__ void maskalibi(f32x16&c0,f32x16&c1,unsigned mk,float s2){
  float ninf=-INFINITY; asm volatile("":"+v"(ninf));
  #pragma unroll
  for(int r=0;r<16;++r){ const float kr=(float)((r&3)+8*(r>>2));
    const float a=__builtin_fmaf(s2,kr,c0[r]), b=__builtin_fmaf(s2,kr+32.f,c1[r]);
    const unsigned m0=(unsigned)__builtin_amdgcn_sbfe((int)mk,r,1), m1=(unsigned)__builtin_amdgcn_sbfe((int)mk,16+r,1);
    c0[r]=bfi_f(m0,a,ninf); c1[r]=bfi_f(m1,b,ninf); }
}
#ifndef ATTN_STORE16
#define ATTN_STORE16(p,v) (*(u32x4*)(p)=(v))
#endif
template<int THRL> __device__ __forceinline__ void attn_unit(int b,int h,int qb,int TOFF,int NTP,bool PART,const bf16*Q,const bf16*__restrict__ K,const bf16*__restrict__ V,bf16*O,bf16*OP,float*LSE,const unsigned*MK,float kmax2,char*shm){
  const int tid=threadIdx.x,lane=tid&63,r32=lane&31,hi=lane>>5; const int wid=__builtin_amdgcn_readfirstlane(tid>>6);
  const long rowbase=(long)b*SEQ; const int q0=qb*QB;
  const bf16*Qw=Q+(rowbase+q0+wid*QBLK)*DM+h*D;
  const bf16*Kh=K+rowbase*DM+h*D,*Vh=V+rowbase*DM+h*D;
  const unsigned lds0=(unsigned)(uintptr_t)shm;
  float*wsf=(float*)(shm+LDS_WS)+wid*64;
  const bf16*ksrc=Kh+(long)lane*DM+wid*8;
  const bf16*vsrc=Vh+(long)(16*(wid&3)+(lane>>2))*DM+(wid>>2)*32+(lane&3)*8;
  const unsigned kdst=lds0+LDS_K+wid*1024, vdst=lds0+LDS_V+wid*1024;
  const int NT=(q0+QB)/KVBLK;
  #define PT(t) (NT-1-TOFF-(t))
  #define DMA_K(t,slot) glds16(ksrc+(long)PT(t)*KVBLK*DM,(unsigned)__builtin_amdgcn_readfirstlane(kdst+(slot)))
  #define DMA_V(t,slot) glds16(vsrc+(long)PT(t)*KVBLK*DM,(unsigned)__builtin_amdgcn_readfirstlane(vdst+(slot)))
  const int vb0=(int)(lds0+LDS_V)+((lane>>4)&1)*32+(lane&3)*8+(4*hi+((lane&15)>>2))*64;
  const char*Kbase=shm+LDS_K; bf16x8 kf[8];
  const lds_cptr shm3=(lds_cptr)shm; const lds_cptr kp0=shm3+LDS_K+hi*1024+r32*16; const lds_cptr vp0=shm3+LDS_V+((lane>>4)&1)*32+(lane&3)*8+(4*hi+((lane&15)>>2))*64;
  const float slope2=__builtin_amdgcn_exp2f(-(float)(h+1))*1.4426950408889634f;
  const float hib=slope2*4.f*(float)hi;
  const unsigned*mkp=MK+(((size_t)b*256+(size_t)(qb*8+wid))*128)*64+lane;
  #define MKLD(dst,t) asm volatile("global_load_dword %0, %1, off":"=v"(dst):"v"(mkp+(size_t)PT(t)*64):"memory")
  bf16x8 qr[4];
  #pragma unroll
  for(int d0=0;d0<4;++d0)qr[d0]=*reinterpret_cast<const bf16x8*>(&Qw[(long)r32*DM+d0*16+hi*8]);
  int NP;
  if(h==7){ NP=NT-TOFF; NP=NP>NTP?NTP:NP; }
  else { unsigned mw[8];
    #pragma unroll
    for(int j=0;j<8;++j)mw[j]=(j<NT)?mkp[(size_t)(NT-1-j)*64]:0u;
    float q2=0.f;
    #pragma unroll
    for(int d0=0;d0<4;++d0)
      #pragma unroll
      for(int i=0;i<8;++i){const float x=__builtin_bit_cast(float,(unsigned)(unsigned short)qr[d0][i]<<16);q2=__builtin_fmaf(x,x,q2);}
    q2+=__shfl_xor(q2,32);
    int best=-1;
    #pragma unroll
    for(int j=0;j<8;++j){ const unsigned w=mw[j]; if(w){ const int hb=31-__builtin_clz(w); const int pos=64*(NT-1-j)+32*(hb>>4)+crow(hb&15,hi); best=best>pos?best:pos; } }
    { const int ob=__shfl_xor(best,32); best=best>ob?best:ob; }
    const float need=(40.f+2.f*__builtin_sqrtf(q2*kmax2))/slope2;
    float kminf=best>=0?(float)best-need:-1.0e9f;
    #pragma unroll
    for(int o=1;o<32;o<<=1)kminf=__builtin_fminf(kminf,__shfl_xor(kminf,o));
    if(lane==0)wsf[0]=kminf;
    asm volatile("s_waitcnt lgkmcnt(0)\n\ts_barrier":::"memory");
    float km=((float*)(shm+LDS_WS))[0];
    #pragma unroll
    for(int w=1;w<8;++w)km=__builtin_fminf(km,((float*)(shm+LDS_WS))[w*64]);
    const int ptmin=km<=0.f?0:((int)km>>6);
    int NTE=NT-ptmin; NTE=(NTE+1)&~1; NTE=NTE<4?4:NTE; NTE=NTE>NT?NT:NTE;
    NP=NTE-TOFF; NP=NP>NTP?NTP:NP; if(NP>0&&NP<4)NP=4;
    NP=__builtin_amdgcn_readfirstlane(NP);
    asm volatile("s_waitcnt lgkmcnt(0)\n\ts_barrier":::"memory"); }
  if(NP<=0){ if(PART&&hi==0)LSE[wid*QBLK+r32]=-INFINITY; return; }
  unsigned mkA,mkB;
  MKLD(mkA,0); MKLD(mkB,1);
  DMA_K(0,0);DMA_V(0,0);DMA_K(1,SLOTB);
  float mhat=0.f,l_reg=0.f;f32x16 o[2];o[0]=f32x16{};o[1]=f32x16{};f32x16 negm=f32x16{};
  #define SETNEG(t) do{ const float lb_=slope2*(float)(64*PT(t)-q0)+hib-mhat; _Pragma("unroll") for(int r=0;r<16;++r)negm[r]=lb_; asm volatile("":"+v"(negm)); }while(0)
  SETNEG(0);
  bool resc=false;
  #define START(P0,P1) do{ const float rm=rowmax(P0,P1); resc=false; \
    { const float dl=max2f(rm,-16384.f); mhat=fadd_s(mhat,dl); \
      _Pragma("unroll") for(int r=0;r<16;++r){P0[r]=fsub_s(P0[r],dl);P1[r]=fsub_s(P1[r],dl);} } \
    _Pragma("unroll") for(int r=0;r<16;++r)P0[r]=__builtin_amdgcn_exp2f(P0[r]); }while(0)
  #define RESC() do{ if(resc){ asm volatile("s_waitcnt lgkmcnt(0)":::"memory"); \
      _Pragma("unroll") for(int d_=0;d_<2;++d_) _Pragma("unroll") for(int r=0;r<16;++r)o[d_][r]*=wsf[crow(r,hi)]; } }while(0)
  f32x16 pA0,pA1,pB0,pB1;
  int sl_prev=0,sl_cur=0,sl_next=SLOTB;
  #define ROT() do{sl_prev=sl_cur;sl_cur=sl_next;sl_next=(sl_next==(NSLOT-1)*SLOTB)?0:sl_next+SLOTB;}while(0)
  DMA_K(2,2*SLOTB);
  WAIT_BAR(3);
  asm volatile("":"+v"(mkA),"+v"(mkB));
  qkt(pA0,pA1,Kbase,qr,negm,r32,hi); maskalibi(pA0,pA1,mkA,slope2); asm volatile("s_nop 15\n\ts_nop 7":"+v"(pA0),"+v"(pA1));
  START(pA0,pA1);
  _Pragma("unroll") for(int r=0;r<16;++r)pA1[r]=__builtin_amdgcn_exp2f(pA1[r]);
  WAIT_BAR(0);
  DMA_K(3,0);DMA_V(1,SLOTB);
  ROT();
  kload8(kf,kp0+sl_cur);
  WAIT_BAR(2);
  s16x4 vlo[8],vhi[8]; u32x4 pw0,pw1,pw2,pw3;
  #define PKW(P,B) cvtpk_s(P[B],P[B+1])
  #define PAF(k) __builtin_bit_cast(bf16x8,pw##k)
  #define VFR(i) (bf16x8){vlo[i][0],vlo[i][1],vlo[i][2],vlo[i][3],vhi[i][0],vhi[i][1],vhi[i][2],vhi[i][3]}
  #define PIN(x) asm volatile("":"+v"(x))
  #define MX3(a,b,c) __builtin_fmaxf(__builtin_fmaxf((a),(b)),(c))
  #define GAPA(MF,A0,A1,A2,A3,W0,W1,PW) do{ MF; sacc+=A0; sacc+=A1; sacc+=A2; sacc+=A3; PIN(sacc); W0; W1; PIN(PW); SBAR(); }while(0)
  #define EX(v) __builtin_amdgcn_exp2f(v)
  #define GAPB(MF,X,B) do{ MF; X[B]=EX(X[B]); X[B+1]=EX(X[B+1]); X[B+2]=EX(X[B+2]); X[B+3]=EX(X[B+3]); PIN(X); SBAR(); }while(0)
  #define VRD(i) do{ vlo[i]=vtr(vp_+(((i)>>2)*4096+((i)&3)*1024)); vhi[i]=vtr(vp_+(((i)>>2)*4096+((i)&3)*1024+512)); }while(0)
  #define KRD(G,j) do{ if(G){ kload2(kf,kp0+sl_next,j); SBAR(); } }while(0)
  #define STEP(C0,C1,P0,P1,t,GK,GV,GL,MCUR,MNXT) do{ SBAR(); \
    SETNEG(t); \
    const lds_cptr vp_=vp0+sl_prev; \
    VRD(0); SBAR(); float sacc=(P0[0]+P0[1]); \
    GAPA(C0=__builtin_amdgcn_mfma_f32_32x32x16_bf16(kf[0],qr[0],negm,0,0,0), P0[2],P0[3],P0[4],P0[5],     pw0[0]=PKW(P0,0), pw0[1]=PKW(P0,2), pw0); \
    VRD(4); SBAR(); GAPA(C1=__builtin_amdgcn_mfma_f32_32x32x16_bf16(kf[1],qr[0],negm,0,0,0), P0[6],P0[7],P0[8],P0[9],     pw0[2]=PKW(P0,4), pw0[3]=PKW(P0,6), pw0); \
    VRD(1); SBAR(); GAPA(C0=__builtin_amdgcn_mfma_f32_32x32x16_bf16(kf[2],qr[1],C0,0,0,0),   P0[10],P0[11],P0[12],P0[13], pw1[0]=PKW(P0,8), pw1[1]=PKW(P0,10), pw1); \
    VRD(5); SBAR(); GAPA(C1=__builtin_amdgcn_mfma_f32_32x32x16_bf16(kf[3],qr[1],C1,0,0,0),   P0[14],P0[15],P1[0],P1[1],   pw1[2]=PKW(P0,12),pw1[3]=PKW(P0,14), pw1); \
    VRD(2); SBAR(); GAPA(C0=__builtin_amdgcn_mfma_f32_32x32x16_bf16(kf[4],qr[2],C0,0,0,0),   P1[2],P1[3],P1[4],P1[5],     pw2[0]=PKW(P1,0), pw2[1]=PKW(P1,2), pw2); \
    VRD(6); SBAR(); GAPA(C1=__builtin_amdgcn_mfma_f32_32x32x16_bf16(kf[5],qr[2],C1,0,0,0),   P1[6],P1[7],P1[8],P1[9],     pw2[2]=PKW(P1,4), pw2[3]=PKW(P1,6), pw2); \
    VRD(3); SBAR(); GAPA(C0=__builtin_amdgcn_mfma_f32_32x32x16_bf16(kf[6],qr[3],C0,0,0,0),   P1[10],P1[11],P1[12],P1[13], pw3[0]=PKW(P1,8), pw3[1]=PKW(P1,10), pw3); \
    VRD(7); SBAR(); GAPA(C1=__builtin_amdgcn_mfma_f32_32x32x16_bf16(kf[7],qr[3],C1,0,0,0),   P1[14],P1[15],0.f,0.f,       pw3[2]=PKW(P1,12),pw3[3]=PKW(P1,14), pw3); \
    l_reg+=sacc; \
    if(GV){MKLD(MNXT,(t)+1);} if(GK){DMA_K((t)+3,sl_cur);} if(GV){DMA_V((t)+1,sl_next);} \
    maskalibi(C0,C1,MCUR,slope2); \
    { float a=MX3(C0[0],C0[1],C1[0]),b=MX3(C0[2],C0[3],C1[1]); a=MX3(a,C1[2],C1[3]); \
      _Pragma("unroll") for(int r=4;r<16;r+=4){a=MX3(a,C0[r],C0[r+1]);b=MX3(b,C0[r+2],C0[r+3]);a=MX3(a,C1[r],C1[r+1]);b=MX3(b,C1[r+2],C1[r+3]);} \
      float rm=__builtin_fmaxf(a,b); { auto rr=__builtin_amdgcn_permlane32_swap(__float_as_uint(rm),__float_as_uint(rm),false,false); rm=__builtin_fmaxf(__uint_as_float(rr[0]),__uint_as_float(rr[1])); } \
      resc=false; \
      if(__builtin_expect(__any(rm>(float)THRL),0)){ const float dl=__builtin_fmaxf(rm,0.f); mhat+=dl; \
        _Pragma("unroll") for(int r=0;r<16;++r){C0[r]-=dl;C1[r]-=dl;} \
        const float f=__builtin_amdgcn_exp2f(-dl); l_reg*=f; if(hi==0)wsf[r32]=f; resc=true; } } \
    SBAR(); \
    GAPB(o[0]=__builtin_amdgcn_mfma_f32_32x32x16_bf16(PAF(0),VFR(0),o[0],0,0,0), C0,0); \
    GAPB(o[1]=__builtin_amdgcn_mfma_f32_32x32x16_bf16(PAF(0),VFR(4),o[1],0,0,0), C0,4); \
    KRD(GL,0); GAPB(o[0]=__builtin_amdgcn_mfma_f32_32x32x16_bf16(PAF(1),VFR(1),o[0],0,0,0), C0,8); \
    KRD(GL,1); GAPB(o[1]=__builtin_amdgcn_mfma_f32_32x32x16_bf16(PAF(1),VFR(5),o[1],0,0,0), C0,12); \
    KRD(GL,2); GAPB(o[0]=__builtin_amdgcn_mfma_f32_32x32x16_bf16(PAF(2),VFR(2),o[0],0,0,0), C1,0); \
    KRD(GL,3); GAPB(o[1]=__builtin_amdgcn_mfma_f32_32x32x16_bf16(PAF(2),VFR(6),o[1],0,0,0), C1,4); \
    GAPB(o[0]=__builtin_amdgcn_mfma_f32_32x32x16_bf16(PAF(3),VFR(3),o[0],0,0,0), C1,8); \
    GAPB(o[1]=__builtin_amdgcn_mfma_f32_32x32x16_bf16(PAF(3),VFR(7),o[1],0,0,0), C1,12); \
    }while(0)
  int t=1;
  for(;t+5<NP;t+=2){
    STEP(pB0,pB1,pA0,pA1,t,true,true,true,mkB,mkA);     WAIT_BAR(2); PIN(mkA); RESC(); ROT();
    STEP(pA0,pA1,pB0,pB1,t+1,true,true,true,mkA,mkB);   WAIT_BAR(2); PIN(mkB); RESC(); ROT();
  }
  #define ENDW(tt) do{ if((tt)+3<NP){WAIT_BAR(2);} else if((tt)+2<NP){WAIT_BAR(1);} else {WAIT_BAR(0);} }while(0)
  for(;t+1<NP;t+=2){
    STEP(pB0,pB1,pA0,pA1,t,(t+3<NP),(t+1<NP),(t+1<NP),mkB,mkA);       ENDW(t);   PIN(mkA); RESC(); ROT();
    STEP(pA0,pA1,pB0,pB1,t+1,(t+4<NP),(t+2<NP),(t+2<NP),mkA,mkB);     ENDW(t+1); PIN(mkB); RESC(); ROT();
  }
  STEP(pB0,pB1,pA0,pA1,NP-1,false,false,false,mkB,mkA); RESC();
  { float sacc=pB0[0]+pB0[1]; _Pragma("unroll") for(int r=2;r<16;++r)sacc+=pB0[r]; _Pragma("unroll") for(int r=0;r<16;++r)sacc+=pB1[r]; l_reg+=sacc;
    pw0=(u32x4){PKW(pB0,0),PKW(pB0,2),PKW(pB0,4),PKW(pB0,6)};pw1=(u32x4){PKW(pB0,8),PKW(pB0,10),PKW(pB0,12),PKW(pB0,14)};pw2=(u32x4){PKW(pB1,0),PKW(pB1,2),PKW(pB1,4),PKW(pB1,6)};pw3=(u32x4){PKW(pB1,8),PKW(pB1,10),PKW(pB1,12),PKW(pB1,14)};
    SBAR(); pv(o,vb0+sl_cur,PAF(0),PAF(1),PAF(2),PAF(3)); }
  #undef PKW
  #undef PAF
  #undef VFR
  #undef PIN
  #undef MX3
  #undef GAPA
  #undef GAPB
  #undef EX
  #undef VRD
  #undef KRD
  #undef STEP
  #undef ENDW
  {auto rr=__builtin_amdgcn_permlane32_swap(__float_as_uint(l_reg),__float_as_uint(l_reg),false,false);l_reg=__uint_as_float(rr[0])+__uint_as_float(rr[1]);}
  if(hi==0)wsf[32+r32]=l_reg;asm volatile("s_waitcnt lgkmcnt(0)":::"memory");
  if(PART&&hi==0)LSE[wid*QBLK+r32]=l_reg>0.f?mhat+__builtin_amdgcn_logf(l_reg):-INFINITY;
  float rli[16];
  #pragma unroll
  for(int r=0;r<16;++r){const float lv=wsf[32+crow(r,hi)];rli[r]=lv>0.f?__builtin_amdgcn_rcpf(lv):0.f;}
  bf16*Ow=PART?OP+(long)(wid*QBLK)*D:O+(rowbase+q0+wid*QBLK)*DM+h*D; const long opitch=PART?D:DM;
  { bf16*stg=(bf16*)(shm+LDS_OST)+wid*2048;
    #pragma unroll
    for(int r=0;r<16;++r){const int orow=crow(r,hi);
      #pragma unroll
      for(int d0=0;d0<2;++d0)stg[orow*64+d0*32+r32]=__float2bfloat16(o[d0][r]*rli[r]);}
    asm volatile("s_waitcnt lgkmcnt(0)":::"memory");
    #pragma unroll
    for(int i=0;i<4;++i){const int row=i*8+(lane>>3),ch=lane&7; const u32x4 v=*(const u32x4*)(stg+row*64+ch*8); ATTN_STORE16(Ow+(long)row*opitch+ch*8,v);} }
  asm volatile("s_waitcnt lgkmcnt(0)\n\ts_barrier":::"memory");
  #undef DMA_K
  #undef DMA_V
  #undef START
  #undef RESC
  #undef ROT
  #undef PT
  #undef MKLD
  #undef SETNEG
}
constexpr int ATTN_LDS_BYTES=LDS_BYTES;
#undef SBAR
#undef WAIT_BAR
}

constexpr int NWAVES = 8, NTHR = 512;
constexpr int BATCH = 2, SEQ = 8192, D = 1024, T = BATCH * SEQ;
constexpr int SSMW = 512, NG = 32, GP = 16, NS = 64;
constexpr int NH = 8, HD = 64, AW = 512, TOPK = 256;
constexpr int NE = 32, FF = 1024;
constexpr int IN_W = 4680, IN_WP = 4864;
constexpr int CH = 64, NCH = SEQ / CH;
constexpr float LN_EPS = 1e-5f;
constexpr float ALPHA = 1.189207115002721f;
constexpr float LOG2E = 1.4426950408889634f;
constexpr int MOE_ROWS = T * 4 + NE * 256;
constexpr int MOE_TILES = MOE_ROWS / 256;

constexpr size_t MiB = 1u << 20;
constexpr size_t WS_CTL = 0, CTL_ZERO_BYTES = 1 * MiB;
constexpr size_t WS_WIN = 2 * MiB;
constexpr size_t WS_WGLU = 12 * MiB;
constexpr size_t WS_WAP = 14 * MiB;
constexpr size_t WS_WO = 15 * MiB;
constexpr size_t WS_WUP = 18 * MiB;
constexpr size_t WS_WDN = 146 * MiB;
constexpr size_t WS_XN = 210 * MiB;
constexpr size_t WS_H = 242 * MiB;
constexpr size_t WS_U = 306 * MiB;
constexpr size_t WS_Q = 322 * MiB, WS_K = 338 * MiB, WS_V = 354 * MiB, WS_QI = 370 * MiB;
constexpr size_t WS_KI = 386 * MiB;
constexpr size_t WS_WI = 388 * MiB;
constexpr size_t WS_G = 390 * MiB;
constexpr size_t WS_YG = 454 * MiB;
constexpr size_t WS_O = 470 * MiB;
constexpr size_t WS_Z = 486 * MiB;
constexpr size_t WS_MIX = 518 * MiB;
constexpr size_t WS_S5 = 582 * MiB;
constexpr size_t WS_RT = 592 * MiB;
constexpr size_t WS_XG = 596 * MiB;
constexpr size_t WS_HH = 740 * MiB;
constexpr size_t WS_MASK = 884 * MiB;
constexpr size_t WS_WRF = 900 * MiB;
constexpr size_t WS_S5T = 902 * MiB, S5T_STRIDE = 589824;
constexpr size_t WS_S5A = 920 * MiB;
constexpr size_t WS_S5E = 921 * MiB;
constexpr size_t WS_BASE = 922 * MiB;
constexpr size_t WS_END = 923 * MiB;
constexpr int CW_CNT = 64;
constexpr int CW_CUR = 128;
constexpr int CW_KMAX = 256;
constexpr int CW_ATTQ = 512;
constexpr int CW_GLUQ = 1280;
constexpr int CW_CVQ = 1344;
constexpr int CW_CVU = 1408;
constexpr int CW_BAR = 4096;

constexpr int RING_BYTES = 131072;
constexpr int MISC_OFF = RING_BYTES;
constexpr int LDS_BYTES = 147456;

#define GAS __attribute__((address_space(1)))
#define LAS __attribute__((address_space(3)))
typedef unsigned short bf16;
typedef unsigned v4u __attribute__((ext_vector_type(4)));
typedef unsigned v2u __attribute__((ext_vector_type(2)));
typedef float f32x4 __attribute__((ext_vector_type(4)));
typedef short bf16x8 __attribute__((ext_vector_type(8)));
#define LDS_WAIT() asm volatile("s_waitcnt lgkmcnt(0)" ::: "memory")
#define VM_WAIT() asm volatile("s_waitcnt vmcnt(0)" ::: "memory")
__device__ __forceinline__ unsigned pk2(float lo, float hi) { return pg8::cvt_pk_bf16(lo, hi); }
__device__ __forceinline__ unsigned f2bf(float f) { return pg8::cvt_pk_bf16(f, 0.f) & 0xffffu; }
__device__ __forceinline__ float bf2f(unsigned short h) { return __builtin_bit_cast(float, (unsigned)h << 16); }
__device__ __forceinline__ float bflo(unsigned w) { return __builtin_bit_cast(float, w << 16); }
__device__ __forceinline__ float bfhi(unsigned w) { return __builtin_bit_cast(float, w & 0xffff0000u); }
__device__ __forceinline__ float sigmoidf_(float x) { return __builtin_amdgcn_rcpf(1.0f + __builtin_amdgcn_exp2f(-1.4426950408889634f * x)); }
__device__ __forceinline__ float wave_sum(float v) {
#pragma unroll
    for (int o = 1; o < 64; o <<= 1) v += __shfl_xor(v, o);
    return v;
}
__device__ __forceinline__ float wave_max(float v) {
#pragma unroll
    for (int o = 1; o < 64; o <<= 1) v = fmaxf(v, __shfl_xor(v, o));
    return v;
}


typedef GAS unsigned gu32;
#define XB_TMO      128
#define XB_XCNT(j)  (256  + 64 * (j))
#define XB_XSUB(j)  (1280 + 64 * (j))
#define XB_XGEN(j)  (2304 + 64 * (j))
#define XB_TOP      3328
#define XB_TOPGEN   3392
#define XCD_BAR_WORDS 3456
#define XB_SPIN_CAP (1u << 22)
__device__ __forceinline__ unsigned xb_ld(unsigned* p)              { return __hip_atomic_load(p, __ATOMIC_RELAXED, __HIP_MEMORY_SCOPE_AGENT); }
__device__ __forceinline__ unsigned xb_add(unsigned* p, unsigned v) { return __hip_atomic_fetch_add(p, v, __ATOMIC_RELAXED, __HIP_MEMORY_SCOPE_AGENT); }
__device__ __forceinline__ unsigned xb_xcc_id() { return (unsigned)__builtin_amdgcn_s_getreg((3 << 11) | 20) & 0xFu; }
#define XB_SPIN(cond, bar) do { unsigned _sp = 0; while (cond) { __builtin_amdgcn_s_sleep(1); \
    if ((++_sp & 255u) == 0u) { if (xb_ld(&(bar)[XB_TMO])) break; if (_sp > XB_SPIN_CAP) { atomicAdd(&(bar)[XB_TMO], 1u); break; } } } } while (0)
struct XcdBarrier { unsigned* bar; unsigned x; volatile LAS unsigned* st; };
__device__ __forceinline__ XcdBarrier xcd_barrier_post(unsigned* bar, volatile LAS unsigned* st) {
    XcdBarrier b; b.bar = bar; b.x = xb_xcc_id(); b.st = st;
    if (threadIdx.x == 0) (void)xb_add(&bar[XB_XCNT(b.x)], 1u);
    return b;
}
__device__ __forceinline__ void xcd_barrier_complete(unsigned* bar, unsigned x, unsigned& nloc, unsigned& nx) {
    const unsigned G = gridDim.x * gridDim.y * gridDim.z;
    unsigned sum, cnt, mine, sp = 0u;
    for (;;) {
        sum = 0u; cnt = 0u; mine = 0u;
#pragma unroll
        for (unsigned j = 0; j < 16; ++j) { const unsigned c = xb_ld(&bar[XB_XCNT(j)]); sum += c; cnt += (c > 0u) ? 1u : 0u; mine = (j == x) ? c : mine; }
        if (sum == G) break;
        __builtin_amdgcn_s_sleep(1);
        if ((++sp & 255u) == 0u) { if (xb_ld(&bar[XB_TMO])) break; if (sp > XB_SPIN_CAP) { atomicAdd(&bar[XB_TMO], 1u); break; } }
    }
    nloc = mine > 0u ? mine : 1u; nx = cnt > 0u ? cnt : 1u;
}
__device__ __forceinline__ void xcd_barrier(const XcdBarrier& b) {
    asm volatile("s_waitcnt vmcnt(0)" ::: "memory");
    __syncthreads();
    if (threadIdx.x == 0) {
        unsigned* bar = b.bar;
        __builtin_amdgcn_s_waitcnt(0);
        unsigned nloc = b.st[0], nx = b.st[1];
        if (nloc == 0u) { xcd_barrier_complete(bar, b.x, nloc, nx); b.st[0] = nloc; b.st[1] = nx; }
        const unsigned old = xb_add(&bar[XB_XSUB(b.x)], 1u);
        const unsigned gen = old / nloc;
        if (old + 1u == (gen + 1u) * nloc) {
            __builtin_amdgcn_fence(__ATOMIC_RELEASE, "agent");
            asm volatile("s_waitcnt vmcnt(0)" ::: "memory");
            const unsigned og = xb_add(&bar[XB_TOP], 1u);
            const unsigned tg = og / nx;
            if (og + 1u == (tg + 1u) * nx) xb_add(&bar[XB_TOPGEN], 1u);
            else XB_SPIN(xb_ld(&bar[XB_TOPGEN]) == tg, bar);
            __builtin_amdgcn_fence(__ATOMIC_ACQUIRE, "agent");
            xb_add(&bar[XB_XGEN(b.x)], 1u);
            asm volatile("s_waitcnt vmcnt(0)" ::: "memory");
        } else {
            XB_SPIN(xb_ld(&bar[XB_XGEN(b.x)]) == gen, bar);
            __builtin_amdgcn_fence(__ATOMIC_ACQUIRE, "agent");
            asm volatile("s_waitcnt vmcnt(0)" ::: "memory");
        }
    }
    __syncthreads();
}

struct Args { const float* in[26]; float* out; unsigned char* ws; int ph_lo, ph_hi; };
struct Frame {
    LAS unsigned char* lds;
    int tid, lane, wave, vcu, G;
    unsigned char* ws;
};

__device__ __forceinline__ int colmap(int kind, int np, int halfn) {
    if (kind == 0) return np;
    if (kind == 1) { if (np < 2560) return np; if (np < 4608) return np + 72; if (np < 4680) return np - 2048; return -1; }
    const int j = np >> 8, c = np & 255; return c < 128 ? 128 * j + c : halfn + 128 * j + (c - 128);
}
__device__ __forceinline__ void p0_transpose_item(const float* W, int K, int Nsrc, int Ndst, int kind, bf16* WT, LAS float* scr, int item, int lane) {
    const int nblk = Ndst / 64, kb = item / nblk, nb = item % nblk, k0 = 64 * kb, n0 = 64 * nb;
    const int n4 = (lane & 15) * 4, col = colmap(kind, n0 + n4, Nsrc / 2);
    f32x4 vv[16];
#pragma unroll
    for (int i = 0; i < 16; ++i) { const int kk = 4 * i + (lane >> 4);
        vv[i] = col >= 0 ? __builtin_nontemporal_load((const f32x4*)(W + (size_t)(k0 + kk) * Nsrc + col)) : (f32x4){0.f, 0.f, 0.f, 0.f}; }
#pragma unroll
    for (int i = 0; i < 16; ++i) { const int kk = 4 * i + (lane >> 4); const f32x4 v = vv[i];
        LAS float* d = scr + kk * 65 + n4; d[0] = v[0]; d[1] = v[1]; d[2] = v[2]; d[3] = v[3]; }
    LDS_WAIT(); asm volatile("" ::: "memory");
    const int c = lane & 7;
#pragma unroll
    for (int j = 0; j < 8; ++j) { const int n = (lane >> 3) + 8 * j; const LAS float* sp = scr + (8 * c) * 65 + n;
        v4u o; o.x = pk2(sp[0 * 65], sp[1 * 65]); o.y = pk2(sp[2 * 65], sp[3 * 65]); o.z = pk2(sp[4 * 65], sp[5 * 65]); o.w = pk2(sp[6 * 65], sp[7 * 65]);
        *(GAS v4u*)(WT + (size_t)(n0 + n) * K + k0 + 8 * c) = o; }
    LDS_WAIT(); asm volatile("" ::: "memory");
}
__device__ __forceinline__ void ln_row(int lane, const float* arow, float ascale, const float* addrow, const float* g, const float* b, float* of32, bf16* obf, f32x4 (&v)[4], const bf16* arow_bf = nullptr, const bf16* add_bf = nullptr) {
    const GAS f32x4* xr = (const GAS f32x4*)arow + lane; float s = 0.f;
#pragma unroll
    for (int j = 0; j < 4; ++j) { if (arow_bf) { const v2u w = ((const GAS v2u*)arow_bf + lane)[64 * j]; v[j] = (f32x4){bflo(w.x), bfhi(w.x), bflo(w.y), bfhi(w.y)} * ascale; } else v[j] = xr[64 * j] * ascale; if (addrow) v[j] += ((const GAS f32x4*)addrow + lane)[64 * j];
        if (add_bf) { const v2u w2 = ((const GAS v2u*)add_bf + lane)[64 * j]; v[j] += (f32x4){bflo(w2.x), bfhi(w2.x), bflo(w2.y), bfhi(w2.y)}; } s += (v[j].x + v[j].y) + (v[j].z + v[j].w); }
    const float mean = wave_sum(s) * (1.f / D); float s2 = 0.f;
#pragma unroll
    for (int j = 0; j < 4; ++j) { v[j] = v[j] - mean; s2 += (v[j].x * v[j].x + v[j].y * v[j].y) + (v[j].z * v[j].z + v[j].w * v[j].w); }
    const float rstd = 1.f / sqrtf(wave_sum(s2) * (1.f / D) + LN_EPS);
#pragma unroll
    for (int j = 0; j < 4; ++j) { const f32x4 gg = ((const GAS f32x4*)g + lane)[64 * j], bb = ((const GAS f32x4*)b + lane)[64 * j]; v[j] = v[j] * rstd * gg + bb;
        if (of32) ((GAS f32x4*)of32 + lane)[64 * j] = v[j];
        if (obf) ((GAS v2u*)obf + lane)[64 * j] = (v2u){pk2(v[j].x, v[j].y), pk2(v[j].z, v[j].w)}; }
}
__device__ __forceinline__ void ln0_rows4(int lane, const float* x, size_t m0, size_t mstride, const float* g, const float* b, bf16* XN) {
    f32x4 v[4][4];
#pragma unroll
    for (int r = 0; r < 4; ++r)
#pragma unroll
        for (int j = 0; j < 4; ++j) v[r][j] = __builtin_nontemporal_load((const f32x4*)(x + (m0 + r * mstride) * D) + lane + 64 * j);
    f32x4 gg[4], bb[4];
#pragma unroll
    for (int j = 0; j < 4; ++j) { gg[j] = ((const GAS f32x4*)g + lane)[64 * j]; bb[j] = ((const GAS f32x4*)b + lane)[64 * j]; }
    float s[4], q[4];
#pragma unroll
    for (int r = 0; r < 4; ++r) { s[r] = 0.f;
#pragma unroll
        for (int j = 0; j < 4; ++j) s[r] += (v[r][j].x + v[r][j].y) + (v[r][j].z + v[r][j].w); }
#pragma unroll
    for (int o = 1; o < 64; o <<= 1)
#pragma unroll
        for (int r = 0; r < 4; ++r) s[r] += __shfl_xor(s[r], o);
#pragma unroll
    for (int r = 0; r < 4; ++r) { const float mean = s[r] * (1.f / D); q[r] = 0.f;
#pragma unroll
        for (int j = 0; j < 4; ++j) { v[r][j] = v[r][j] - mean; q[r] += (v[r][j].x * v[r][j].x + v[r][j].y * v[r][j].y) + (v[r][j].z * v[r][j].z + v[r][j].w * v[r][j].w); } }
#pragma unroll
    for (int o = 1; o < 64; o <<= 1)
#pragma unroll
        for (int r = 0; r < 4; ++r) q[r] += __shfl_xor(q[r], o);
#pragma unroll
    for (int r = 0; r < 4; ++r) { const float rstd = 1.f / sqrtf(q[r] * (1.f / D) + LN_EPS);
#pragma unroll
        for (int j = 0; j < 4; ++j) { const f32x4 y = v[r][j] * rstd * gg[j] + bb[j];
            ((GAS v2u*)(XN + (m0 + r * mstride) * D) + lane)[64 * j] = (v2u){pk2(y.x, y.y), pk2(y.z, y.w)}; } }
}
__device__ __forceinline__ void s5_tables(Frame& F, const Args& a, int g, int part);
__device__ __forceinline__ void p0_prologue(Frame& F, const Args& a) {
    LAS float* scr = (LAS float*)(F.lds + F.wave * 16640);
    const int gw = F.vcu * NWAVES + F.wave, NGW = F.G * NWAVES;
    constexpr int I_IN = (D / 64) * (IN_WP / 64), I_GLU = (SSMW / 64) * (2048 / 64), I_AP = (AW / 64) * (D / 64), I_O = (D / 64) * (D / 64);
    constexpr int NITEMS = I_IN + I_GLU + I_AP + I_O;
    for (int u = F.vcu; u < NG * 8; u += F.G) s5_tables(F, a, u >> 3, u & 7);
    for (int it = gw; it < NITEMS; it += NGW) {
        int r = it;
        if (r < I_IN) { p0_transpose_item(a.in[3], D, IN_W, IN_WP, 1, (bf16*)(F.ws + WS_WIN), scr, r, F.lane); continue; } r -= I_IN;
        if (r < I_GLU) { p0_transpose_item(a.in[13], SSMW, 2048, 2048, 2, (bf16*)(F.ws + WS_WGLU), scr, r, F.lane); continue; } r -= I_GLU;
        if (r < I_AP) { p0_transpose_item(a.in[14], AW, D, D, 0, (bf16*)(F.ws + WS_WAP), scr, r, F.lane); continue; } r -= I_AP;
        p0_transpose_item(a.in[15], D, D, D, 0, (bf16*)(F.ws + WS_WO), scr, r, F.lane);
    }
    for (int i = gw * 64 + F.lane; i < 128 * 64; i += NGW * 64) { const int t = i >> 6, l = i & 63; const float* wr = a.in[18] + (size_t)(8 * t + 4 * (l >> 5)) * NE + (l & 31);
        ((f32x4*)(F.ws + WS_WRF))[i] = (f32x4){wr[0], wr[NE], wr[2 * NE], wr[3 * NE]}; }
    for (int m = gw; m + 3 * NGW < T; m += 4 * NGW) ln0_rows4(F.lane, a.in[0], (size_t)m, (size_t)NGW, a.in[1], a.in[2], (bf16*)(F.ws + WS_XN));
}

using pg8::Unit; using pg8::HALF; using pg8::BM;
__device__ __forceinline__ v4u pack8(const f32x4 a, const f32x4 b) { v4u w; w.x = pg8::cvt_pk_bf16(a[0], a[1]); w.y = pg8::cvt_pk_bf16(a[2], a[3]); w.z = pg8::cvt_pk_bf16(b[0], b[1]); w.w = pg8::cvt_pk_bf16(b[2], b[3]); return w; }
struct EpiIn {
    static constexpr bool PERM = true;
    unsigned char* ws; const float* b_gate;
    __device__ __forceinline__ void operator()(const f32x4 (&acc)[2][2][4][2], const Unit& u, int wr, int wc, int fr, int fq) const {
        const int row0 = u.pm * BM + wr * 64 + fr, pn = u.pn;
        if (pn < 10) {
            const int t = pn >> 1; bf16* base = (bf16*)(ws + WS_U + (size_t)t * 16 * MiB); const float sc = (t == 1) ? 0.125f * LOG2E : 1.f;
            const int col0 = (pn & 1) * 256 + wc * 32 + 8 * fq;
#pragma unroll
            for (int ai = 0; ai < 2; ++ai)
#pragma unroll
                for (int m = 0; m < 4; ++m) { bf16* rowp = base + (size_t)(row0 + ai * HALF + m * 16) * 512 + col0;
#pragma unroll
                    for (int bj = 0; bj < 2; ++bj) *(v4u*)(rowp + bj * HALF) = pack8(acc[ai][bj][m][0] * sc, acc[ai][bj][m][1] * sc); }
        } else if (pn < 18) {
            bf16* base = (bf16*)(ws + WS_G); const int col0 = (pn - 10) * 256 + wc * 32 + 8 * fq;
            f32x4 bv[2][2];
#pragma unroll
            for (int bj = 0; bj < 2; ++bj)
#pragma unroll
                for (int n = 0; n < 2; ++n) bv[bj][n] = *(const f32x4*)(b_gate + col0 + bj * HALF + 4 * n) * (-LOG2E);
#pragma unroll
            for (int ai = 0; ai < 2; ++ai)
#pragma unroll
                for (int m = 0; m < 4; ++m) { bf16* rowp = base + (size_t)(row0 + ai * HALF + m * 16) * 2048 + col0;
#pragma unroll
                    for (int bj = 0; bj < 2; ++bj) { f32x4 v0, v1;
#pragma unroll
                        for (int i = 0; i < 4; ++i) { v0[i] = __builtin_amdgcn_rcpf(1.0f + __builtin_amdgcn_exp2f(__builtin_fmaf(acc[ai][bj][m][0][i], -LOG2E, bv[bj][0][i])));
                                                      v1[i] = __builtin_amdgcn_rcpf(1.0f + __builtin_amdgcn_exp2f(__builtin_fmaf(acc[ai][bj][m][1][i], -LOG2E, bv[bj][1][i]))); }
                        *(v4u*)(rowp + bj * HALF) = pack8(v0, v1); } }
        } else {
            if (wc < 2) {
                bf16* base = (bf16*)(ws + WS_KI); const int col0 = wc * 32 + 8 * fq;
#pragma unroll
                for (int ai = 0; ai < 2; ++ai)
#pragma unroll
                    for (int m = 0; m < 4; ++m) *(v4u*)(base + (size_t)(row0 + ai * HALF + m * 16) * 64 + col0) = pack8(acc[ai][0][m][0], acc[ai][0][m][1]);
            } else if (wc == 2 && fq == 0) {
                float* base = (float*)(ws + WS_WI);
#pragma unroll
                for (int ai = 0; ai < 2; ++ai)
#pragma unroll
                    for (int m = 0; m < 4; ++m) { float* p = base + (size_t)(row0 + ai * HALF + m * 16) * 8; *(f32x4*)p = acc[ai][0][m][0]; *(f32x4*)(p + 4) = acc[ai][0][m][1]; }
            }
        }
    }
};
struct EpiGlu {
    static constexpr bool PERM = true;
    unsigned char* ws;
    __device__ __forceinline__ void operator()(const f32x4 (&acc)[2][2][4][2], const Unit& u, int wr, int wc, int fr, int fq) const {
        const int row0 = u.pm * BM + wr * 64 + fr, col0 = u.pn * 128 + wc * 32 + 8 * fq;
        const bf16* G = (const bf16*)(ws + WS_G); bf16* Z = (bf16*)(ws + WS_Z);
#pragma unroll
        for (int ai = 0; ai < 2; ++ai)
#pragma unroll
            for (int m = 0; m < 4; ++m) { const size_t r = (size_t)(row0 + ai * HALF + m * 16);
                const v4u gw = *(const v4u*)(G + r * 2048 + col0);
                const float gs[8] = {bflo(gw.x), bfhi(gw.x), bflo(gw.y), bfhi(gw.y), bflo(gw.z), bfhi(gw.z), bflo(gw.w), bfhi(gw.w)};
                f32x4 o0, o1;
#pragma unroll
                for (int i = 0; i < 4; ++i) { o0[i] = gs[i] * acc[ai][0][m][0][i] * sigmoidf_(acc[ai][1][m][0][i]); o1[i] = gs[4 + i] * acc[ai][0][m][1][i] * sigmoidf_(acc[ai][1][m][1][i]); }
                *(v4u*)(Z + r * 1024 + col0) = pack8(o0, o1); }
    }
};
struct EpiAtt {
    static constexpr bool PERM = true;
    unsigned char* ws;
    __device__ __forceinline__ void operator()(const f32x4 (&acc)[2][2][4][2], const Unit& u, int wr, int wc, int fr, int fq) const {
        const int row0 = u.pm * BM + wr * 64 + fr, col0 = u.pn * 256 + wc * 32 + 8 * fq;
        const bf16* G = (const bf16*)(ws + WS_G); bf16* Z = (bf16*)(ws + WS_Z);
#pragma unroll
        for (int ai = 0; ai < 2; ++ai)
#pragma unroll
            for (int m = 0; m < 4; ++m) { const size_t r = (size_t)(row0 + ai * HALF + m * 16);
#pragma unroll
                for (int bj = 0; bj < 2; ++bj) { const int c = col0 + bj * HALF;
                    const v4u gw = *(const v4u*)(G + r * 2048 + 1024 + c); const v4u zw = *(const v4u*)(Z + r * 1024 + c);
                    const float gs[8] = {bflo(gw.x), bfhi(gw.x), bflo(gw.y), bfhi(gw.y), bflo(gw.z), bfhi(gw.z), bflo(gw.w), bfhi(gw.w)};
                    const float zs[8] = {bflo(zw.x), bfhi(zw.x), bflo(zw.y), bfhi(zw.y), bflo(zw.z), bfhi(zw.z), bflo(zw.w), bfhi(zw.w)};
                    f32x4 o0, o1;
#pragma unroll
                    for (int i = 0; i < 4; ++i) { o0[i] = zs[i] + gs[i] * acc[ai][bj][m][0][i]; o1[i] = zs[4 + i] + gs[4 + i] * acc[ai][bj][m][1][i]; }
                    *(v4u*)(Z + r * 1024 + c) = pack8(o0, o1); } }
    }
};
struct EpiF32 {
    static constexpr bool PERM = false;
    float* C; int ldc;
    __device__ __forceinline__ void operator()(const f32x4 (&acc)[2][2][4][2], const Unit& u, int wr, int wc, int fr, int fq) const {
        const int row0 = u.pm * BM + wr * 64 + fr, col0 = u.pn * BM + wc * 32 + 4 * fq;
#pragma unroll
        for (int ai = 0; ai < 2; ++ai)
#pragma unroll
            for (int m = 0; m < 4; ++m) { float* rowp = C + (size_t)(row0 + ai * HALF + m * 16) * ldc + col0;
#pragma unroll
                for (int bj = 0; bj < 2; ++bj)
#pragma unroll
                    for (int n = 0; n < 2; ++n) *(f32x4*)(rowp + bj * HALF + n * 16) = acc[ai][bj][m][n]; }
    }
};
struct EpiMix {
    static constexpr bool PERM = true;
    bf16* C;
    __device__ __forceinline__ void operator()(const f32x4 (&acc)[2][2][4][2], const Unit& u, int wr, int wc, int fr, int fq) const {
        const int row0 = u.pm * BM + wr * 64 + fr, col0 = u.pn * BM + wc * 32 + 8 * fq;
#pragma unroll
        for (int ai = 0; ai < 2; ++ai)
#pragma unroll
            for (int m = 0; m < 4; ++m) { bf16* rowp = C + (size_t)(row0 + ai * HALF + m * 16) * D + col0;
#pragma unroll
                for (int bj = 0; bj < 2; ++bj) *(v4u*)(rowp + bj * HALF) = pack8(acc[ai][bj][m][0], acc[ai][bj][m][1]); }
    }
};
struct EpiSwiglu {
    static constexpr bool PERM = true;
    unsigned char* ws; const float* b_up;
    __device__ __forceinline__ void operator()(const f32x4 (&acc)[2][2][4][2], const Unit& u, int wr, int wc, int fr, int fq) const {
        const int row0 = u.pm * BM + wr * 64 + fr, cl = wc * 32 + 8 * fq, col0 = u.pn * 128 + cl;
        const float* bg = b_up + (size_t)u.e * 2048 + u.pn * 128 + cl; const float* bl = bg + 1024;
        bf16* HHp = (bf16*)(ws + WS_HH);
        f32x4 bgv[2], blv[2];
#pragma unroll
        for (int n = 0; n < 2; ++n) { bgv[n] = *(const f32x4*)(bg + 4 * n); blv[n] = *(const f32x4*)(bl + 4 * n) + 1.0f; }
#pragma unroll
        for (int ai = 0; ai < 2; ++ai)
#pragma unroll
            for (int m = 0; m < 4; ++m) { const size_t r = (size_t)(row0 + ai * HALF + m * 16);
                f32x4 o[2];
#pragma unroll
                for (int n = 0; n < 2; ++n)
#pragma unroll
                    for (int i = 0; i < 4; ++i) { float hg = acc[ai][0][m][n][i] + bgv[n][i], hl = acc[ai][1][m][n][i] + blv[n][i];
                        hg = fminf(hg, 7.0f); hl = __builtin_amdgcn_fmed3f(hl, -6.0f, 8.0f);
                        o[n][i] = hl * (hg * __builtin_amdgcn_rcpf(1.0f + __builtin_amdgcn_exp2f(hg * (-1.702f * 1.4426950408889634f)))); }
                *(v4u*)(HHp + r * 1024 + col0) = pack8(o[0], o[1]); }
    }
};
struct EpiDown {
    static constexpr bool PERM = true;
    unsigned char* ws; const float* b_down; const float* row_gate;
    __device__ __forceinline__ void operator()(const f32x4 (&acc)[2][2][4][2], const Unit& u, int wr, int wc, int fr, int fq) const {
        const int row0 = u.pm * BM + wr * 64 + fr, col0 = u.pn * 256 + wc * 32 + 8 * fq;
        const float* bd = b_down + (size_t)u.e * 1024 + col0; bf16* Y = (bf16*)(ws + WS_XG);
        f32x4 bv[2][2];
#pragma unroll
        for (int bj = 0; bj < 2; ++bj)
#pragma unroll
            for (int n = 0; n < 2; ++n) bv[bj][n] = *(const f32x4*)(bd + bj * HALF + 4 * n);
#pragma unroll
        for (int ai = 0; ai < 2; ++ai)
#pragma unroll
            for (int m = 0; m < 4; ++m) { const size_t r = (size_t)(row0 + ai * HALF + m * 16); const float gt = row_gate[r];
#pragma unroll
                for (int bj = 0; bj < 2; ++bj) *(v4u*)(Y + r * 1024 + col0 + bj * HALF) = pack8((acc[ai][bj][m][0] + bv[bj][0]) * gt, (acc[ai][bj][m][1] + bv[bj][1]) * gt); }
    }
};

struct S5Lane { float ar, ai; float br[GP], bi[GP]; };
__device__ __forceinline__ void s5_lane_setup(const Args& a, int g, int n, S5Lane& L) {
    const float lr = a.in[5][g * NS + n], li = a.in[6][g * NS + n], dt = expf(a.in[7][g]);
    const float er = expf(lr * dt); L.ar = er * cosf(li * dt); L.ai = er * sinf(li * dt);
    const float nr = L.ar - 1.f, ni = L.ai, den = lr * lr + li * li; const float fr_ = (nr * lr + ni * li) / den, fi_ = (ni * lr - nr * li) / den;
#pragma unroll
    for (int p = 0; p < GP; ++p) { const float b_r = a.in[8][(g * NS + n) * GP + p], b_i = a.in[9][(g * NS + n) * GP + p]; L.br[p] = fr_ * b_r - fi_ * b_i; L.bi[p] = fr_ * b_i + fi_ * b_r; }
}
__device__ __forceinline__ float gelu_tanh(float x) { const float t = 0.7978845608028654f * (x + 0.044715f * x * x * x); const float e = __builtin_amdgcn_exp2f(2.885390081777927f * t); return x * (1.f - __builtin_amdgcn_rcpf(e + 1.f)); }
__device__ __forceinline__ void s5_tables(Frame& F, const Args& a, int g, int part) {
    typedef float f32x2 __attribute__((ext_vector_type(2)));
    LAS f32x2* pwr = (LAS f32x2*)F.lds;
    LAS f32x2* bbl = (LAS f32x2*)(F.lds + 33280);
    LAS f32x2* ccl = (LAS f32x2*)(F.lds + 33280 + 8192);
    const int tid = F.tid;
    __syncthreads();
    if (tid < 64) { S5Lane L; s5_lane_setup(a, g, tid, L);
#pragma unroll
        for (int p = 0; p < GP; ++p) bbl[tid * GP + p] = (f32x2){L.br[p], L.bi[p]};
        float pr = 1.f, pi = 0.f;
        for (int m = 0; m <= 64; ++m) { pwr[m * 64 + tid] = (f32x2){pr, pi}; const float nr = pr * L.ar - pi * L.ai, ni = pr * L.ai + pi * L.ar; pr = nr; pi = ni; }
        if (part == 0) { const f32x2 a64 = pwr[64 * 64 + tid]; float qr = a64.x, qi = a64.y;
            ((f32x2*)(F.ws + WS_S5A))[g * 64 + tid] = a64;
#pragma unroll
            for (int k = 0; k < 5; ++k) { const float nr = qr * qr - qi * qi, ni = 2.f * qr * qi; qr = nr; qi = ni; }
            ((f32x2*)(F.ws + WS_S5A + 16384))[g * 64 + tid] = (f32x2){qr, qi}; } }
    for (int e = tid; e < GP * NS; e += NTHR) ccl[e] = (f32x2){a.in[10][(size_t)g * GP * NS + e], a.in[11][(size_t)g * GP * NS + e]};
    __syncthreads();
    unsigned char* base = F.ws + WS_S5T + (size_t)g * S5T_STRIDE;
    for (int e = part * 2048 + tid; e < (part + 1) * 2048; e += NTHR) {
        const int lane = e & 63, jp = (e >> 6) & 63, rt = e >> 12, r = lane & 31, h = lane >> 5, n = (32 * rt + r) & 63, ri = rt >> 1;
        const f32x2 pw = pwr[(63 - jp) * 64 + n]; float v[8];
#pragma unroll
        for (int jj = 0; jj < 8; ++jj) { const f32x2 b = bbl[n * GP + 8 * h + jj]; v[jj] = ri == 0 ? pw.x * b.x - pw.y * b.y : pw.x * b.y + pw.y * b.x; }
        ((v4u*)base)[e] = (v4u){pk2(v[0], v[1]), pk2(v[2], v[3]), pk2(v[4], v[5]), pk2(v[6], v[7])}; }
    for (int e = part * 2048 + tid; e < (part + 1) * 2048; e += NTHR) {
        const int lane = e & 63, ks = (e >> 6) & 7, i = e >> 9, r = lane & 31, h = lane >> 5, lp = 2 * i + (r >> 4), pp = r & 15; float v[8];
#pragma unroll
        for (int jj = 0; jj < 8; ++jj) { const int comp = 16 * ks + 8 * h + jj, ri = comp >> 6, n = comp & 63;
            const f32x2 c = ccl[pp * NS + n]; const f32x2 pw = pwr[(lp + 1) * 64 + n];
            v[jj] = ri == 0 ? c.x * pw.x - c.y * pw.y : -(c.x * pw.y + c.y * pw.x); }
        ((v4u*)(base + 262144))[e] = (v4u){pk2(v[0], v[1]), pk2(v[2], v[3]), pk2(v[4], v[5]), pk2(v[6], v[7])}; }
    for (int e = part * 2080 + tid; e < (part + 1) * 2080; e += NTHR) {
        const int blk = e >> 8, po = (e >> 4) & 15, pi = e & 15; float acc = 0.f;
        if (blk > 0) { const int m = blk - 1;
            for (int n = 0; n < NS; ++n) { const f32x2 c = ccl[po * NS + n], pw = pwr[m * 64 + n], b = bbl[n * GP + pi];
                const float tr = pw.x * b.x - pw.y * b.y, ti = pw.x * b.y + pw.y * b.x; acc += c.x * tr - c.y * ti; }
            if (m == 0 && po == pi) acc += a.in[12][g * GP + po]; }
        ((bf16*)(base + 524288))[e] = (bf16)f2bf(acc); }
    __syncthreads();
}
namespace s5 {
using bf16x8 = __attribute__((ext_vector_type(8))) short;
using f32x16 = __attribute__((ext_vector_type(16))) float;
typedef float f32x2 __attribute__((ext_vector_type(2)));
constexpr int CSTR = 2064;
constexpr int U_OFF = 0, KF_OFF = 32 * CSTR, SLOC_OFF = KF_OFF + 33280, TMP_OFF = SLOC_OFF + 128 * 33 * 4;
__device__ __forceinline__ int crow(int r, int hi) { return (r & 3) + 8 * (r >> 2) + 4 * hi; }
__device__ __forceinline__ void phase_a(Frame& F) {
    const int v = F.vcu, b = v >> 7, g = (v >> 2) & 31, seg = v & 3, tid = F.tid, lane = F.lane, wave = F.wave;
    LAS unsigned char* lds = F.lds; const unsigned char* tb = F.ws + WS_S5T + (size_t)g * S5T_STRIDE;
    const bf16* U = (const bf16*)(F.ws + WS_U) + ((size_t)b * SEQ + (size_t)seg * 2048) * SSMW + g * GP;
#pragma unroll
    for (int i = 0; i < 8; ++i) { const int pc = tid + NTHR * i, tk = pc >> 1, hf = pc & 1;
        *(LAS v4u*)(lds + U_OFF + (tk >> 6) * CSTR + (tk & 63) * 32 + hf * 16) = *(const v4u*)(U + (size_t)tk * SSMW + hf * 8); }
    for (int pc = tid; pc < 2080; pc += NTHR) *(LAS v4u*)(lds + KF_OFF + pc * 16) = ((const v4u*)(tb + 524288))[pc];
    bf16x8 wa[32];
    { const bf16x8* wsf = (const bf16x8*)tb + (size_t)((wave & 3) * 64 + (wave >> 2) * 32) * 64 + lane;
#pragma unroll
      for (int jj = 0; jj < 32; ++jj) wa[jj] = wsf[jj * 64]; }
    __syncthreads();
    { const int rt = wave & 3, kh = wave >> 2; f32x16 acc = {};
      const LAS unsigned char* ub = lds + U_OFF + (lane & 31) * CSTR + (lane >> 5) * 16 + kh * 32 * 32;
#pragma unroll
      for (int jj = 0; jj < 32; ++jj) acc = __builtin_amdgcn_mfma_f32_32x32x16_bf16(wa[jj], *(const LAS bf16x8*)(ub + jj * 32), acc, 0, 0, 0);
      LAS float* tmp = (LAS float*)(lds + TMP_OFF); LAS float* sloc = (LAS float*)(lds + SLOC_OFF);
      if (kh == 1) {
#pragma unroll
          for (int r = 0; r < 16; ++r) tmp[(rt * 16 + r) * 64 + lane] = acc[r]; }
      __syncthreads();
      if (kh == 0) {
#pragma unroll
          for (int r = 0; r < 16; ++r) sloc[(32 * rt + crow(r, lane >> 5)) * 33 + (lane & 31)] = acc[r] + tmp[(rt * 16 + r) * 64 + lane]; }
      __syncthreads(); }
    if (tid < 64) { const f32x2 a64 = ((const f32x2*)(F.ws + WS_S5A))[g * 64 + tid]; const LAS float* sloc = (const LAS float*)(lds + SLOC_OFF); float zr = 0.f, zi = 0.f;
        for (int c = 0; c < 32; ++c) { const float lr = sloc[tid * 33 + c], li = sloc[(64 + tid) * 33 + c]; const float nr = a64.x * zr - a64.y * zi + lr, ni = a64.x * zi + a64.y * zr + li; zr = nr; zi = ni; }
        ((f32x2*)(F.ws + WS_S5E))[(size_t)v * 64 + tid] = (f32x2){zr, zi}; }
}
__device__ __forceinline__ void phase_b(Frame& F) {
    const int v = F.vcu, b = v >> 7, g = (v >> 2) & 31, seg = v & 3, tid = F.tid, lane = F.lane, wave = F.wave;
    LAS unsigned char* lds = F.lds; const unsigned char* tb = F.ws + WS_S5T + (size_t)g * S5T_STRIDE;
    bf16x8 wy[4][8];
    { const bf16x8* wyf0 = (const bf16x8*)(tb + 262144) + lane;
#pragma unroll
      for (int q = 0; q < 4; ++q) { const int i = q == 0 ? wave : q == 1 ? 15 - wave : q == 2 ? 16 + wave : 31 - wave;
#pragma unroll
          for (int ks = 0; ks < 8; ++ks) wy[q][ks] = wyf0[(size_t)(i * 8 + ks) * 64]; } }
    if (tid < 64) { const f32x2 a64 = ((const f32x2*)(F.ws + WS_S5A))[g * 64 + tid], aS = ((const f32x2*)(F.ws + WS_S5A + 16384))[g * 64 + tid];
        const LAS float* sloc = (const LAS float*)(lds + SLOC_OFF); LAS bf16* sinb = (LAS bf16*)(lds + TMP_OFF);
        float sr = 0.f, si = 0.f;
        for (int j = 0; j < seg; ++j) { const f32x2 e = ((const f32x2*)(F.ws + WS_S5E))[(size_t)(v - seg + j) * 64 + tid]; const float nr = aS.x * sr - aS.y * si + e.x, ni = aS.x * si + aS.y * sr + e.y; sr = nr; si = ni; }
        const int n = tid, ore = (((n >> 4) * 64 + ((n >> 3) & 1) * 32) * 8) + (n & 7), oim = ore + 4 * 64 * 8;
        for (int c = 0; c < 32; ++c) { sinb[ore + c * 8] = (bf16)f2bf(sr); sinb[oim + c * 8] = (bf16)f2bf(si);
            const float lr = sloc[n * 33 + c], li = sloc[(64 + n) * 33 + c]; const float nr = a64.x * sr - a64.y * si + lr, ni = a64.x * si + a64.y * sr + li; sr = nr; si = ni; } }
    __syncthreads();
    const int r32 = lane & 31, h = lane >> 5;
    const LAS unsigned char* ub = lds + U_OFF + r32 * CSTR + h * 16; const LAS unsigned char* kfb = lds + KF_OFF + r32 * 32 + h * 16; const LAS bf16x8* sb = (const LAS bf16x8*)(lds + TMP_OFF) + lane;
    bf16* YG = (bf16*)(F.ws + WS_YG) + ((size_t)b * SEQ + (size_t)seg * 2048 + (size_t)r32 * 64) * SSMW + g * GP + 4 * h;
#pragma unroll
    for (int q = 0; q < 4; ++q) { const int i = q == 0 ? wave : q == 1 ? 15 - wave : q == 2 ? 16 + wave : 31 - wave;
        f32x16 acc = {};
#pragma unroll
        for (int ks = 0; ks < 8; ++ks) acc = __builtin_amdgcn_mfma_f32_32x32x16_bf16(wy[q][ks], sb[ks * 64], acc, 0, 0, 0);
        const int nj = 2 * i + 2;
#pragma unroll 2
        for (int j = 0; j < nj; ++j) acc = __builtin_amdgcn_mfma_f32_32x32x16_bf16(*(const LAS bf16x8*)(kfb + (2 * i - j + 1) * 512), *(const LAS bf16x8*)(ub + j * 32), acc, 0, 0, 0);
#pragma unroll
        for (int k = 0; k < 4; ++k) { const int tok = 2 * i + (k >> 1), pc = (k & 1) * 8;
            const float o0 = gelu_tanh(acc[4 * k]), o1 = gelu_tanh(acc[4 * k + 1]), o2 = gelu_tanh(acc[4 * k + 2]), o3 = gelu_tanh(acc[4 * k + 3]);
            *(v2u*)(YG + (size_t)tok * SSMW + pc) = (v2u){pk2(o0, o1), pk2(o2, o3)}; } }
    __syncthreads();
}
}

namespace idx {
using bf16x8 = __attribute__((ext_vector_type(8))) short;
using f32x16 = __attribute__((ext_vector_type(16))) float;
constexpr int CAPT = 16, CAPQ = 96, CREF = 64;
constexpr int QF_OFF = 65536, CTOT_OFF = 131072, PFX_OFF = CTOT_OFF + 2048, NEED_OFF = PFX_OFF + 128, OFLAG_OFF = NEED_OFF + 128, RFLAG_OFF = OFLAG_OFF + 4;
__device__ __forceinline__ unsigned key32(float x) { const unsigned u = __builtin_bit_cast(unsigned, x); return u ^ ((unsigned)((int)u >> 31) | 0x80000000u); }
__device__ __forceinline__ int crow(int r, int hi) { return (r & 3) + 8 * (r >> 2) + 4 * hi; }
__device__ __forceinline__ void load_k(bf16x8 (&kf)[4], const unsigned short* KI, size_t row, int hi) {
#pragma unroll
    for (int ks = 0; ks < 4; ++ks) kf[ks] = *(const bf16x8*)(KI + row * 64 + ks * 16 + hi * 8);
}
__device__ __forceinline__ void score_tile(float (&sc)[16], const bf16x8 (&kf)[4], const LAS unsigned char* qfl  , const float (&wh)[8]) {
    bf16x8 fq[3][4]; f32x16 aclin, ac[2];
#pragma unroll
    for (int st = 0; st <= 10; ++st) {
        if (st <= 8) { const int li = st == 0 ? 8 : st - 1;
#pragma unroll
            for (int ks = 0; ks < 4; ++ks) fq[st % 3][ks] = *(const LAS bf16x8*)(qfl + (li * 4 + ks) * 1024); }
        if (st >= 1 && st <= 9) { const int it = st - 1; f32x16 a = {};
#pragma unroll
            for (int ks = 0; ks < 4; ++ks) a = __builtin_amdgcn_mfma_f32_32x32x16_bf16(kf[ks], fq[it % 3][ks], a, 0, 0, 0);
            if (it == 0) aclin = a; else ac[it & 1] = a; }
        if (st >= 3) { const int it = st - 2;
#pragma unroll
            for (int r = 0; r < 16; ++r) { sc[r] = __builtin_fmaf(wh[it - 1], __builtin_fabsf(ac[it & 1][r]), it == 1 ? aclin[r] : sc[r]); asm volatile("" : "+v"(sc[r])); } }
        __builtin_amdgcn_sched_barrier(0);
    }
}
template <int PASS, bool DIAG> __device__ __forceinline__ void hist_tile(const float (&sc)[16], unsigned hbase  , unsigned pfx, int q, int hi) {
    constexpr int SH = PASS == 0 ? 22 : PASS == 1 ? 11 : 0, SHP = PASS == 1 ? 22 : 11;
#pragma unroll
    for (int r = 0; r < 16; ++r) { const unsigned u = key32(sc[r]);
        bool ok = !DIAG || crow(r, hi) <= q; if (PASS > 0) ok = ok && ((u >> SHP) == pfx);
        if (PASS == 0) { if (ok) { const unsigned ad = hbase + ((u >> 23) << 7); const unsigned val = ((u >> 22) & 1u) * 0xffffu + 1u;
                                   __hip_atomic_fetch_add((LAS unsigned*)(uintptr_t)ad, val, __ATOMIC_RELAXED, __HIP_MEMORY_SCOPE_WORKGROUP); } }
        else if (__any(ok)) { if (ok) { const unsigned bin = (u >> SH) & 2047u; const unsigned ad = hbase + ((bin >> 1) << 7); const unsigned val = (bin & 1u) * 0xffffu + 1u;
                                   __hip_atomic_fetch_add((LAS unsigned*)(uintptr_t)ad, val, __ATOMIC_RELAXED, __HIP_MEMORY_SCOPE_WORKGROUP); } } }
}
__device__ __forceinline__ float lin_x(float s, float aq) { return __builtin_fmaf(s, aq, __builtin_amdgcn_fmed3f(__builtin_fmaf(s, aq * 16.0f, 512.0f), 384.0f, 640.0f)); }
__device__ __forceinline__ unsigned lin_bin(float s, float aq) { return (unsigned)__builtin_amdgcn_fmed3f(lin_x(s, aq), 0.0f, 1023.0f); }
__device__ __forceinline__ unsigned sub_bin(float s, float aq, unsigned bn) { return (unsigned)__builtin_amdgcn_fmed3f((lin_x(s, aq) - (float)bn) * 2048.0f, 0.0f, 2047.0f); }
template <bool REF> __device__ __forceinline__ unsigned cls_id(float s, float aq) { const unsigned bn = lin_bin(s, aq); if constexpr (REF) return (bn << 11) | sub_bin(s, aq, bn); else return bn; }
template <bool DIAG> __device__ __forceinline__ void hist_tile_sub(const float (&sc)[16], unsigned hbase, unsigned pfx, float aq, int q, int hi) {
#pragma unroll
    for (int r = 0; r < 16; ++r) { const unsigned bn = lin_bin(sc[r], aq); const bool ok = (!DIAG || crow(r, hi) <= q) && bn == pfx;
        if (__any(ok)) { if (ok) { const unsigned sb = sub_bin(sc[r], aq, bn); const unsigned ad = hbase + ((sb >> 1) << 7); const unsigned val = (sb & 1u) * 0xffffu + 1u;
            __hip_atomic_fetch_add((LAS unsigned*)(uintptr_t)ad, val, __ATOMIC_RELAXED, __HIP_MEMORY_SCOPE_WORKGROUP); } } }
}
template <bool DIAG> __device__ __forceinline__ void hist_tile_lin(const float (&sc)[16], unsigned hbase, float aq, int q, int hi) {
#pragma unroll
    for (int r = 0; r < 16; ++r) { const unsigned bn = lin_bin(sc[r], aq);
        if (!DIAG || crow(r, hi) <= q) { const unsigned ad = hbase + ((bn >> 1) << 7); const unsigned val = (bn & 1u) * 0xffffu + 1u;
            __hip_atomic_fetch_add((LAS unsigned*)(uintptr_t)ad, val, __ATOMIC_RELAXED, __HIP_MEMORY_SCOPE_WORKGROUP); } }
}
template <int PASS> __device__ __forceinline__ void scan_hist(LAS unsigned char* lds, int tid, int lane, int wave) {
    constexpr int NB = PASS == 0 ? 1024 : 2048, NBITS = PASS == 0 ? 10 : 11, NCH = NB / 128;
    LAS unsigned* hist = (LAS unsigned*)lds; LAS unsigned* ctot = (LAS unsigned*)(lds + CTOT_OFF); LAS unsigned* PFX = (LAS unsigned*)(lds + PFX_OFF); LAS unsigned* NEED = (LAS unsigned*)(lds + NEED_OFF);
    { const int q = lane & 31, c = 2 * wave + (lane >> 5);
      if (c < NCH) { unsigned tot = 0u;
#pragma unroll 8
          for (int i = 0; i < 64; ++i) { const unsigned d = hist[(c * 64 + i) * 32 + q]; tot += (d & 0xffffu) + (d >> 16); }
          ctot[c * 32 + q] = tot; }
      __syncthreads(); }
    if (tid < 32) { const int q = tid; const unsigned need = PASS == 0 ? (unsigned)TOPK : NEED[q]; unsigned cum = 0u; int cs = 0; bool found = false;
#pragma unroll
        for (int c = NCH - 1; c >= 0; --c) { const unsigned t = ctot[c * 32 + q]; if (!found) { if (cum + t >= need) { found = true; cs = c; } else cum += t; } }
        int bin = 0; unsigned rem = 1u, pop = 0u; bool f2 = false;
        for (int i = 63; i >= 0; --i) { const unsigned d = hist[(cs * 64 + i) * 32 + q]; const unsigned hi16 = d >> 16, lo16 = d & 0xffffu;
            if (!f2) { if (cum + hi16 >= need) { f2 = true; bin = (cs * 64 + i) * 2 + 1; rem = need - cum; pop = hi16; } else cum += hi16; }
            if (!f2) { if (cum + lo16 >= need) { f2 = true; bin = (cs * 64 + i) * 2; rem = need - cum; pop = lo16; } else cum += lo16; } }
        const unsigned pf = PASS == 0 ? 0u : PFX[q];
        PFX[q] = (pf << NBITS) | (unsigned)bin; NEED[q] = rem;
        if (PASS == 0 && pop > (unsigned)CREF) *(LAS unsigned*)(lds + RFLAG_OFF) = 1u; }
    __syncthreads();
}
__device__ __forceinline__ void zero_hist(LAS unsigned char* lds, int tid, int n16  ) {
    const f32x4 z = {0.f, 0.f, 0.f, 0.f};
    for (int i = 0; i < n16; ++i) *(LAS f32x4*)(lds + (size_t)(i * NTHR + tid) * 16) = z;
    __syncthreads();
}
__device__ __forceinline__ void pass0(LAS unsigned char* lds, const unsigned short* KI, float* SC, size_t krow0, int qgb, const float (&wh)[8], float aq, int tid, int lane, int wave) {
    const int q = lane & 31, hi = lane >> 5;
    zero_hist(lds, tid, 8);
    const LAS unsigned char* qfl = lds + QF_OFF + lane * 16; const unsigned hbase = (unsigned)(uintptr_t)lds + 4u * (unsigned)q;
    bf16x8 kf[4], kn[4];
    if (wave <= qgb) load_k(kf, KI, krow0 + (size_t)wave * 32 + q, hi);
    for (int kt32 = wave; kt32 <= qgb; kt32 += 8) {
        const int ktn = kt32 + 8 <= qgb ? kt32 + 8 : kt32;
        load_k(kn, KI, krow0 + (size_t)ktn * 32 + q, hi);
        float sc[16]; score_tile(sc, kf, qfl, wh);
        float* st = SC + (size_t)kt32 * 1024 + lane;
#pragma unroll
        for (int r = 0; r < 16; ++r) st[r * 64] = sc[r];
        if (kt32 == qgb) hist_tile_lin<true>(sc, hbase, aq, q, hi); else hist_tile_lin<false>(sc, hbase, aq, q, hi);
#pragma unroll
        for (int ks = 0; ks < 4; ++ks) kf[ks] = kn[ks];
    }
    __syncthreads();
    scan_hist<0>(lds, tid, lane, wave);
}
__device__ __forceinline__ void load_sc(float (&sc)[16], const float* SC, int kt32, int lane) {
    const float* st = SC + (size_t)kt32 * 1024 + lane;
#pragma unroll
    for (int r = 0; r < 16; ++r) sc[r] = st[r * 64];
}
template <int PASS> __device__ __forceinline__ void stream_pass(LAS unsigned char* lds, const float* SC, int qgb, int tid, int lane, int wave) {
    const int q = lane & 31, hi = lane >> 5;
    zero_hist(lds, tid, 16);
    const unsigned pfx = ((LAS unsigned*)(lds + PFX_OFF))[q]; const unsigned hbase = (unsigned)(uintptr_t)lds + 4u * (unsigned)q;
    float sc[16], sn[16];
    if (wave <= qgb) load_sc(sc, SC, wave, lane);
    for (int kt32 = wave; kt32 <= qgb; kt32 += 8) {
        const int ktn = kt32 + 8 <= qgb ? kt32 + 8 : kt32;
        load_sc(sn, SC, ktn, lane);
        if (kt32 == qgb) hist_tile<PASS, true>(sc, hbase, pfx, q, hi); else hist_tile<PASS, false>(sc, hbase, pfx, q, hi);
#pragma unroll
        for (int r = 0; r < 16; ++r) sc[r] = sn[r];
    }
    __syncthreads();
    scan_hist<PASS>(lds, tid, lane, wave);
}
__device__ __forceinline__ void refine_pass(LAS unsigned char* lds, const float* SC, int qgb, float aq, int tid, int lane, int wave) {
    const int q = lane & 31, hi = lane >> 5;
    zero_hist(lds, tid, 16);
    const unsigned pfx = ((LAS unsigned*)(lds + PFX_OFF))[q]; const unsigned hbase = (unsigned)(uintptr_t)lds + 4u * (unsigned)q;
    float sc[16], sn[16];
    if (wave <= qgb) load_sc(sc, SC, wave, lane);
    for (int kt32 = wave; kt32 <= qgb; kt32 += 8) {
        const int ktn = kt32 + 8 <= qgb ? kt32 + 8 : kt32;
        load_sc(sn, SC, ktn, lane);
        if (kt32 == qgb) hist_tile_sub<true>(sc, hbase, pfx, aq, q, hi); else hist_tile_sub<false>(sc, hbase, pfx, aq, q, hi);
#pragma unroll
        for (int r = 0; r < 16; ++r) sc[r] = sn[r];
    }
    __syncthreads();
    scan_hist<1>(lds, tid, lane, wave);
}
template <bool REF> __device__ __forceinline__ void fused_last(LAS unsigned char* lds, unsigned char* ws, const float* SC, unsigned* MK, int b, int qgb, int nout, float aq, int tid, int lane, int wave) {
    const int q = lane & 31, hi = lane >> 5;
    LAS unsigned* cu = (LAS unsigned*)lds; LAS unsigned* cp = cu + NTHR * CAPT; LAS unsigned* pcnt = cp + NTHR * CAPT; LAS unsigned* Lu = pcnt + NTHR; LAS unsigned* Lp = Lu + 32 * CAPQ;
    LAS unsigned* oflag = (LAS unsigned*)(lds + OFLAG_OFF);
    const unsigned pfx = ((LAS unsigned*)(lds + PFX_OFF))[q]; unsigned pc = 0u;
    float sa[16], sb[16], na[16], nb[16]; unsigned word = 0u;
    auto tile = [&](const float (&sc)[16], int kt64, int p) { const int kt32 = 2 * kt64 + p;
        if (kt32 <= qgb) {
#pragma unroll
            for (int r = 0; r < 16; ++r) { const bool causal = kt32 < qgb || crow(r, hi) <= q; const unsigned cls = cls_id<REF>(sc[r], aq);
                word |= ((causal && cls >= pfx) ? 1u : 0u) << (16 * p + r);
                if (causal && cls == pfx) { if (pc < (unsigned)CAPT) { cu[pc * NTHR + tid] = key32(sc[r]); cp[pc * NTHR + tid] = ((unsigned)kt64 << 6) | ((unsigned)hi << 5) | (unsigned)(16 * p + r); } ++pc; } } } };
    auto clampt = [&](int kt32) { return kt32 <= qgb ? kt32 : qgb; };
    if (wave < nout) { load_sc(sa, SC, clampt(2 * wave), lane); load_sc(sb, SC, clampt(2 * wave + 1), lane); }
    for (int kt64 = wave; kt64 < nout; kt64 += 8) { const int kn = kt64 + 8 < nout ? kt64 + 8 : kt64;
        load_sc(na, SC, clampt(2 * kn), lane); load_sc(nb, SC, clampt(2 * kn + 1), lane);
        word = 0u; tile(sa, kt64, 0); tile(sb, kt64, 1);
        MK[(size_t)kt64 * 64] = word;
#pragma unroll
        for (int r = 0; r < 16; ++r) { sa[r] = na[r]; sb[r] = nb[r]; } }
    pcnt[tid] = pc;
    asm volatile("s_waitcnt vmcnt(0)" ::: "memory");
    __syncthreads();
    const int sl = 2 * wave + hi; unsigned cq = 0u, off = 0u;
#pragma unroll
    for (int s2 = 0; s2 < 16; ++s2) { const unsigned cn = pcnt[(s2 >> 1) * 64 + (s2 & 1) * 32 + q]; cq += cn; off += s2 < sl ? cn : 0u; }
    if (pc > (unsigned)CAPT || cq > (unsigned)CAPQ) oflag[0] = 1u;
    else for (unsigned i = 0; i < pc; ++i) { Lu[q * CAPQ + off + i] = cu[i * NTHR + tid]; Lp[q * CAPQ + off + i] = cp[i * NTHR + tid]; }
    __syncthreads();
    const unsigned need = ((LAS unsigned*)(lds + NEED_OFF))[q];
    if (oflag[0] == 0u && cq > need && (unsigned)sl < cq) { unsigned um[CAPQ / 16], rk[CAPQ / 16];
#pragma unroll
        for (int k = 0; k < CAPQ / 16; ++k) { const unsigned i = (unsigned)(sl + 16 * k); um[k] = i < cq ? Lu[q * CAPQ + i] : 0xffffffffu; rk[k] = 0u; }
#pragma unroll 4
        for (unsigned j = 0; j < cq; ++j) { const unsigned v = Lu[q * CAPQ + j];
#pragma unroll
            for (int k = 0; k < CAPQ / 16; ++k) rk[k] += v > um[k] ? 1u : 0u; }
        unsigned* mkq = (unsigned*)(ws + WS_MASK) + (((size_t)b * 256 + (size_t)qgb) * 128) * 64 + q;
#pragma unroll
        for (int k = 0; k < CAPQ / 16; ++k) { const unsigned i = (unsigned)(sl + 16 * k);
            if (i < cq && rk[k] >= need) { const unsigned ps = Lp[q * CAPQ + i]; atomicAnd(mkq + (size_t)(ps >> 6) * 64 + ((ps >> 5) & 1u) * 32, ~(1u << (ps & 31u))); } } }
    asm volatile("s_waitcnt vmcnt(0)" ::: "memory");
    __syncthreads();
}
__device__ __forceinline__ void unit(LAS unsigned char* lds, unsigned char* ws, int b, int qgb, int tid, int lane, int wave) {
    const unsigned short* QI = (const unsigned short*)(ws + WS_QI); const unsigned short* KI = (const unsigned short*)(ws + WS_KI); const float* WI = (const float*)(ws + WS_WI);
    unsigned* MK = (unsigned*)(ws + WS_MASK) + (((size_t)b * 256 + (size_t)qgb) * 128) * 64 + lane;
    float* SC = (float*)(ws + WS_XG) + ((size_t)b * 32896 + (size_t)(qgb * (qgb + 1) / 2)) * 1024;
    const int q = lane & 31, hi = lane >> 5; const size_t qrow = (size_t)b * SEQ + (size_t)qgb * 32 + q, krow0 = (size_t)b * SEQ;
    const int nout = 4 * (qgb >> 3) + 4;
    if (qgb < 8) {
        for (int kt64 = wave; kt64 < nout; kt64 += 8) { unsigned word = 0u;
#pragma unroll
            for (int p = 0; p < 2; ++p) { const int kt32 = 2 * kt64 + p;
#pragma unroll
                for (int r = 0; r < 16; ++r) { const bool s = kt32 < qgb || (kt32 == qgb && crow(r, hi) <= q); word |= (s ? 1u : 0u) << (16 * p + r); } }
            MK[(size_t)kt64 * 64] = word; }
        return;
    }
    float wh[8];
#pragma unroll
    for (int h = 0; h < 8; ++h) wh[h] = WI[qrow * 8 + h] * (0.5f * 0.04419417382415922f);
#pragma unroll
    for (int ks = 0; ks < 4; ++ks) *(LAS bf16x8*)(lds + QF_OFF + (wave * 4 + ks) * 1024 + lane * 16) = *(const bf16x8*)(QI + qrow * 512 + wave * 64 + ks * 16 + hi * 8);
    __syncthreads();
    if (tid < 256) { const int ks = tid >> 6; float lin[8] = {0.f, 0.f, 0.f, 0.f, 0.f, 0.f, 0.f, 0.f};
#pragma unroll
        for (int h = 0; h < 8; ++h) { const bf16x8 f = *(const LAS bf16x8*)(lds + QF_OFF + (h * 4 + ks) * 1024 + lane * 16);
#pragma unroll
            for (int j = 0; j < 8; ++j) lin[j] = __builtin_fmaf(wh[h], bf2f((unsigned short)f[j]), lin[j]); }
        *(LAS v4u*)(lds + QF_OFF + (32 + ks) * 1024 + lane * 16) = (v4u){pk2(lin[0], lin[1]), pk2(lin[2], lin[3]), pk2(lin[4], lin[5]), pk2(lin[6], lin[7])}; }
    if (tid == 0) { *(LAS unsigned*)(lds + OFLAG_OFF) = 0u; *(LAS unsigned*)(lds + RFLAG_OFF) = 0u; }
    float aq; { float wn = 0.f;
#pragma unroll
        for (int h = 0; h < 8; ++h) wn = __builtin_fmaf(wh[h], wh[h], wn);
        aq = wn > 1e-30f ? 8.0f * __builtin_amdgcn_rsqf(wn) : 0.0f; }
    pass0(lds, KI, SC, krow0, qgb, wh, aq, tid, lane, wave);
    if (*(LAS unsigned*)(lds + RFLAG_OFF) != 0u) { refine_pass(lds, SC, qgb, aq, tid, lane, wave); fused_last<true>(lds, ws, SC, MK, b, qgb, nout, aq, tid, lane, wave); }
    else fused_last<false>(lds, ws, SC, MK, b, qgb, nout, aq, tid, lane, wave);
    { LAS unsigned* oflag = (LAS unsigned*)(lds + OFLAG_OFF);
      if (oflag[0] != 0u) {
          stream_pass<0>(lds, SC, qgb, tid, lane, wave);
          stream_pass<1>(lds, SC, qgb, tid, lane, wave);
          stream_pass<2>(lds, SC, qgb, tid, lane, wave);
          const unsigned thr = ((LAS unsigned*)(lds + PFX_OFF))[q];
          for (int kt64 = wave; kt64 < nout; kt64 += 8) { unsigned word = 0u;
#pragma unroll
              for (int p = 0; p < 2; ++p) { const int kt32 = 2 * kt64 + p;
                  if (kt32 <= qgb) { float sc[16]; load_sc(sc, SC, kt32, lane);
#pragma unroll
                      for (int r = 0; r < 16; ++r) { const bool sel = (kt32 < qgb || crow(r, hi) <= q) && key32(sc[r]) >= thr; word |= (sel ? 1u : 0u) << (16 * p + r); } } }
              MK[(size_t)kt64 * 64] = word; } } }
    __syncthreads();
}
}
__device__ __forceinline__ void indexer_phase(Frame& F) {
    for (int v = F.vcu; v < 256; v += F.G) {
        idx::unit(F.lds, F.ws, 0, v, F.tid, F.lane, F.wave);
        idx::unit(F.lds, F.ws, 1, 255 - v, F.tid, F.lane, F.wave);
    }
}
__device__ __forceinline__ void kmax_phase(Frame& F) {
    LAS float* red = (LAS float*)(F.lds + MISC_OFF + 3072);
    for (int v = F.vcu; v < 256; v += F.G) { const int bh = v >> 4, part = v & 15;
        const bf16* kr = (const bf16*)(F.ws + WS_K) + ((size_t)(bh >> 3) * SEQ + (size_t)part * 512 + F.tid) * 512 + (bh & 7) * 64; float ss = 0.f;
#pragma unroll
        for (int c = 0; c < 8; ++c) { const v4u w = *(const v4u*)(kr + 8 * c); const float x[8] = {bflo(w.x), bfhi(w.x), bflo(w.y), bfhi(w.y), bflo(w.z), bfhi(w.z), bflo(w.w), bfhi(w.w)};
#pragma unroll
            for (int i = 0; i < 8; ++i) ss = __builtin_fmaf(x[i], x[i], ss); }
        ss = wave_max(ss);
        __syncthreads();
        if (F.lane == 0) red[F.wave] = ss;
        __syncthreads();
        if (F.tid == 0) { float m = red[0];
#pragma unroll
            for (int w = 1; w < 8; ++w) m = fmaxf(m, red[w]);
            atomicMax((unsigned*)(F.ws + WS_CTL) + CW_KMAX + bh, __builtin_bit_cast(unsigned, m)); } }
}
constexpr size_t WS_OPART = WS_XG;
constexpr size_t WS_LSE = WS_XG + 64 * MiB;
__device__ __forceinline__ void attn_item(int i, int pr, int& h, int& qb, int& toff, int& ntp, bool& part) {
    const int hs = i / 48, r = i % 48; h = pr == 0 ? 7 : pr == 1 ? 6 : pr == 2 ? (hs == 0 ? 5 : 3) : (hs == 0 ? 4 : 3 - hs);
    if (r < 32) { qb = 31 - (r >> 1); part = true; if ((r & 1) == 0) { toff = 0; ntp = 64; } else { toff = 64; ntp = 4 * (qb + 1) - 64; } }
    else { qb = 47 - r; part = false; toff = 0; ntp = 4 * (qb + 1); }
}
__device__ __forceinline__ int attn_cost(int i, int pr) {
    int h, qb, toff, ntp; bool part; attn_item(i, pr, h, qb, toff, ntp, part);
    const int cap = h == 7 ? 128 : h == 6 ? 116 : h == 5 ? 62 : h == 4 ? 36 : h == 3 ? 22 : h == 2 ? 16 : h == 1 ? 12 : 10;
    const int lim = 4 * (qb + 1) < cap ? 4 * (qb + 1) : cap, c = lim - toff;
    return c <= 0 ? 0 : (c > ntp ? ntp : c);
}
__device__ __forceinline__ bool conv_up_tickets(Frame& F, const float* wup, int n) {
    volatile LAS int* qs = (volatile LAS int*)(F.lds + MISC_OFF + 3072); LAS float* scr = (LAS float*)(F.lds + F.wave * 16640);
    for (int k = 0; k < n; ++k) {
        __syncthreads();
        if (F.tid == 0) qs[2] = (int)atomicAdd((unsigned*)(F.ws + WS_CTL) + CW_CVU, 1u);
        __syncthreads();
        const int u = qs[2];
        if (u >= NE * 512 / NWAVES) return false;
        const int item = u * NWAVES + F.wave, e = item >> 9;
        p0_transpose_item(wup + (size_t)e * D * 2048, D, 2048, 2048, 2, (bf16*)(F.ws + WS_WUP) + (size_t)e * 2048 * D, scr, item & 511, F.lane);
    }
    return true;
}
__device__ __forceinline__ void attn_phase(Frame& F, unsigned char* lds_generic, const float* wup) {
    volatile LAS int* qs = (volatile LAS int*)(F.lds + MISC_OFF + 3072); volatile LAS int* ord = qs + 16;
    const float* kmx = (const float*)((unsigned*)(F.ws + WS_CTL) + CW_KMAX);
    __syncthreads();
    const int NI = ((F.vcu >> 5) & 3) < 2 ? 48 : ((F.vcu >> 5) & 3) == 2 ? 96 : 192;
    if (F.tid == 0) { qs[0] = NI; qs[1] = -1; }
    __syncthreads();
    for (;;) {
        const int u = qs[0]; int st = qs[1];
        __syncthreads();
        if (u >= NI) {
            ++st; if (st >= 1) break;
            const int y = (((F.vcu >> 5) & 7) + st) & 7, pr = y & 3;
            { volatile LAS int* cst = ord + 192;
              if (F.tid < NI) cst[F.tid] = attn_cost(F.tid, pr);
              __syncthreads();
              if (F.tid < NI) { const int c = cst[F.tid]; int rank = 0;
                  for (int j = 0; j < NI; ++j) { const int cj = cst[j]; rank += (cj > c || (cj == c && j < F.tid)) ? 1 : 0; }
                  ord[rank] = F.tid; } }
            if (F.tid == 0) { qs[0] = (int)atomicAdd((unsigned*)(F.ws + WS_CTL) + CW_ATTQ + 64 * y, 1u); qs[1] = st; }
            __syncthreads();
            continue; }
        const int y = (((F.vcu >> 5) & 7) + st) & 7, b = y >> 2;
        int nxt = 0; if (F.tid == 0) nxt = (int)atomicAdd((unsigned*)(F.ws + WS_CTL) + CW_ATTQ + 64 * y, 1u);
        int h, qb, toff, ntp; bool part; attn_item(ord[u], y & 3, h, qb, toff, ntp, part);
        const size_t piece = ((size_t)((b * 8 + h) * 32 + qb)) * 2 + (toff ? 1 : 0);
        attn_body::attn_unit<8>(b, h, qb, toff, ntp, part, (const attn_body::bf16*)(F.ws + WS_Q), (const attn_body::bf16*)(F.ws + WS_K), (const attn_body::bf16*)(F.ws + WS_V),
                                (attn_body::bf16*)(F.ws + WS_O), (attn_body::bf16*)(F.ws + WS_OPART) + piece * 256 * 64, (float*)(F.ws + WS_LSE) + piece * 256,
                                (const unsigned*)(F.ws + WS_MASK), kmx[b * 8 + h], (char*)lds_generic);
        if (F.tid == 0) qs[0] = nxt;
        __syncthreads();
    }
    for (;;) {
        if (F.tid == 0) qs[0] = (int)atomicAdd((unsigned*)(F.ws + WS_CTL) + CW_GLUQ, 1u);
        __syncthreads();
        const int u = qs[0];
        __syncthreads();
        if (u >= 512) break;
        pg8::Gemm g{(const bf16*)(F.ws + WS_YG), (const bf16*)(F.ws + WS_WGLU), T, 2048, SSMW}; pg8::OneUnit S{{u >> 3, u & 7, u & 7, 0}, true};
        EpiGlu E{F.ws}; pg8::gemm_phase<EpiGlu, pg8::OneUnit, false, true>(F.lds, g, S, E);
        (void)conv_up_tickets(F, wup, 4);
    }
    while (conv_up_tickets(F, wup, 4)) {}
}
__device__ __forceinline__ void attn_merge(Frame& F) {
    const int gt = F.vcu * NTHR + F.tid, NGT = F.G * NTHR;
    const bf16* OPp = (const bf16*)(F.ws + WS_OPART); const float* LS = (const float*)(F.ws + WS_LSE); bf16* O = (bf16*)(F.ws + WS_O);
    constexpr int NIT = 16 * 16 * 256 * 8;
    for (int i0 = gt; i0 < NIT; i0 += 4 * NGT) {
        float l0[4], l1[4]; size_t p0[4]; int row[4], ch[4], qb[4], bh[4];
#pragma unroll
        for (int k = 0; k < 4; ++k) { const int i = i0 + k * NGT < NIT ? i0 + k * NGT : i0;
            ch[k] = i & 7; row[k] = (i >> 3) & 255; qb[k] = 16 + ((i >> 11) & 15); bh[k] = i >> 15; p0[k] = ((size_t)(bh[k] * 32 + qb[k])) * 2;
            l0[k] = LS[p0[k] * 256 + row[k]]; l1[k] = LS[(p0[k] + 1) * 256 + row[k]]; }
        v4u a[4], c[4]; float f0[4], f1[4];
#pragma unroll
        for (int k = 0; k < 4; ++k) { const float mx = fmaxf(l0[k], l1[k]), w0 = exp2f(l0[k] - mx), w1 = exp2f(l1[k] - mx), inv = 1.f / (w0 + w1); f0[k] = w0 * inv; f1[k] = w1 * inv;
            a[k] = (v4u){0u, 0u, 0u, 0u}; c[k] = (v4u){0u, 0u, 0u, 0u};
            if (w0 > 0.f) a[k] = *(const v4u*)(OPp + (p0[k] * 256 + row[k]) * 64 + ch[k] * 8);
            if (w1 > 0.f) c[k] = *(const v4u*)(OPp + ((p0[k] + 1) * 256 + row[k]) * 64 + ch[k] * 8); }
#pragma unroll
        for (int k = 0; k < 4; ++k) if (i0 + k * NGT < NIT) { v4u o;
            o.x = pk2(f0[k] * bflo(a[k].x) + f1[k] * bflo(c[k].x), f0[k] * bfhi(a[k].x) + f1[k] * bfhi(c[k].x)); o.y = pk2(f0[k] * bflo(a[k].y) + f1[k] * bflo(c[k].y), f0[k] * bfhi(a[k].y) + f1[k] * bfhi(c[k].y));
            o.z = pk2(f0[k] * bflo(a[k].z) + f1[k] * bflo(c[k].z), f0[k] * bfhi(a[k].z) + f1[k] * bfhi(c[k].z)); o.w = pk2(f0[k] * bflo(a[k].w) + f1[k] * bflo(c[k].w), f0[k] * bfhi(a[k].w) + f1[k] * bfhi(c[k].w));
            *(v4u*)(O + ((size_t)(bh[k] >> 3) * SEQ + (size_t)qb[k] * 256 + row[k]) * 512 + (bh[k] & 7) * 64 + ch[k] * 8) = o; }
    }
}

__device__ __forceinline__ void ln1_router(Frame& F, const Args& a) {
    typedef float f32x16 __attribute__((ext_vector_type(16)));
    constexpr int RS = 1028;
    LAS float* tile = (LAS float*)F.lds; LAS float* part = (LAS float*)F.lds; LAS float* lg = (LAS float*)(F.lds + 32768);
    const int lane = F.lane, wave = F.wave, tid = F.tid;
    float* H = (float*)(F.ws + WS_H); const float* MIX = (const float*)(F.ws + WS_MIX); bf16* XN = (bf16*)(F.ws + WS_XN);
    int* top_e = (int*)(F.ws + WS_RT); float* top_g = (float*)(F.ws + WS_RT + 256 * 1024);
    unsigned* cnt = (unsigned*)(F.ws + WS_CTL) + CW_CNT;
    const f32x4* WRF = (const f32x4*)(F.ws + WS_WRF); const float* br = a.in[19];
    LAS unsigned* lcnt = (LAS unsigned*)(F.lds + 132096);
    int* lrank = (int*)(F.ws + WS_RT + 512 * 1024);
    if (tid < NE) lcnt[tid] = 0u;
    __syncthreads();
    f32x4 wrf[16];
#pragma unroll
    for (int tt = 0; tt < 16; ++tt) wrf[tt] = WRF[(16 * wave + tt) * 64 + lane];
    for (int grp = F.vcu; grp < T / 32; grp += F.G) {
        {
          f32x4 v[4][4]; const size_t m0 = (size_t)grp * 32 + 4 * wave;
#pragma unroll
          for (int i = 0; i < 4; ++i)
#pragma unroll
              for (int j = 0; j < 4; ++j) { const v2u hw = ((const GAS v2u*)(XN + (m0 + i) * D) + lane)[64 * j], mw = ((const GAS v2u*)((const bf16*)MIX + (m0 + i) * D) + lane)[64 * j];
                  v[i][j] = (f32x4){bflo(hw.x), bfhi(hw.x), bflo(hw.y), bfhi(hw.y)} * ALPHA + (f32x4){bflo(mw.x), bfhi(mw.x), bflo(mw.y), bfhi(mw.y)}; }
          f32x4 gg[4], bb[4];
#pragma unroll
          for (int j = 0; j < 4; ++j) { gg[j] = ((const GAS f32x4*)a.in[16] + lane)[64 * j]; bb[j] = ((const GAS f32x4*)a.in[17] + lane)[64 * j]; }
          float sm[4], sq[4];
#pragma unroll
          for (int i = 0; i < 4; ++i) { sm[i] = 0.f;
#pragma unroll
              for (int j = 0; j < 4; ++j) sm[i] += (v[i][j].x + v[i][j].y) + (v[i][j].z + v[i][j].w); }
#pragma unroll
          for (int o = 1; o < 64; o <<= 1)
#pragma unroll
              for (int i = 0; i < 4; ++i) sm[i] += __shfl_xor(sm[i], o);
#pragma unroll
          for (int i = 0; i < 4; ++i) { const float mean = sm[i] * (1.f / D); sq[i] = 0.f;
#pragma unroll
              for (int j = 0; j < 4; ++j) { v[i][j] = v[i][j] - mean; sq[i] += (v[i][j].x * v[i][j].x + v[i][j].y * v[i][j].y) + (v[i][j].z * v[i][j].z + v[i][j].w * v[i][j].w); } }
#pragma unroll
          for (int o = 1; o < 64; o <<= 1)
#pragma unroll
              for (int i = 0; i < 4; ++i) sq[i] += __shfl_xor(sq[i], o);
#pragma unroll
          for (int i = 0; i < 4; ++i) { const float rstd = 1.f / sqrtf(sq[i] * (1.f / D) + LN_EPS); const int r = 4 * wave + i;
#pragma unroll
              for (int j = 0; j < 4; ++j) { const f32x4 y = v[i][j] * rstd * gg[j] + bb[j];
                  ((GAS v2u*)(XN + (m0 + i) * D) + lane)[64 * j] = (v2u){pk2(y.x, y.y), pk2(y.z, y.w)};
                  *(LAS f32x4*)(tile + r * RS + 256 * j + 4 * lane) = y; } } }
        __syncthreads();
        f32x16 acc = {};
#pragma unroll
        for (int tt = 0; tt < 16; ++tt) { const int t = 16 * wave + tt;
            const f32x4 bv = *(const LAS f32x4*)(tile + (lane & 31) * RS + 8 * t + 4 * (lane >> 5)); const f32x4 av = wrf[tt];
#pragma unroll
            for (int j = 0; j < 4; ++j) acc = __builtin_amdgcn_mfma_f32_32x32x2f32(av[j], bv[j], acc, 0, 0, 0); }
        __syncthreads();
#pragma unroll
        for (int r = 0; r < 16; ++r) part[wave * 1024 + r * 64 + lane] = acc[r];
        __syncthreads();
#pragma unroll
        for (int k = 0; k < 2; ++k) { const int idx = tid + 512 * k; float sum = 0.f;
#pragma unroll
            for (int w = 0; w < 8; ++w) sum += part[w * 1024 + idx];
            const int r = idx >> 6, l = idx & 63, e = (r & 3) + 8 * (r >> 2) + 4 * (l >> 5), row = l & 31;
            lg[row * 33 + e] = sum + br[e]; }
        __syncthreads();
        if (tid < 32) { const size_t m = (size_t)grp * 32 + tid; float tv[4] = {-INFINITY, -INFINITY, -INFINITY, -INFINITY}; int te[4] = {0, 0, 0, 0};
            for (int e = 0; e < NE; ++e) { const float x = lg[tid * 33 + e];
                if (x > tv[3]) { tv[3] = x; te[3] = e;
#pragma unroll
                    for (int k = 3; k > 0; --k) if (tv[k] > tv[k - 1]) { const float tf = tv[k]; tv[k] = tv[k - 1]; tv[k - 1] = tf; const int ti = te[k]; te[k] = te[k - 1]; te[k - 1] = ti; } } }
            const float e1 = __expf(tv[1] - tv[0]), e2 = __expf(tv[2] - tv[0]), e3 = __expf(tv[3] - tv[0]); const float inv = 1.f / (1.f + e1 + e2 + e3);
            *(int4*)(top_e + m * 4) = make_int4(te[0], te[1], te[2], te[3]); *(f32x4*)(top_g + m * 4) = (f32x4){inv, e1 * inv, e2 * inv, e3 * inv};
            int4 rk;
            rk.x = (int)atomicAdd((unsigned*)&lcnt[te[0]], 1u); rk.y = (int)atomicAdd((unsigned*)&lcnt[te[1]], 1u); rk.z = (int)atomicAdd((unsigned*)&lcnt[te[2]], 1u); rk.w = (int)atomicAdd((unsigned*)&lcnt[te[3]], 1u);
            *(int4*)(lrank + m * 4) = rk; }
        __syncthreads();
    }
    if (tid < NE) ((unsigned*)(F.ws + WS_BASE))[F.vcu * NE + tid] = atomicAdd(cnt + tid, lcnt[tid]);
}
__device__ __forceinline__ void moe_offsets(const unsigned* cnt, LAS int* pstart  , LAS int* tile_e  , int tid) {
    LAS int* cl = (LAS int*)((LAS unsigned char*)pstart + 12288);
    if (tid < NE) cl[tid] = (int)__hip_atomic_load(cnt + tid, __ATOMIC_RELAXED, __HIP_MEMORY_SCOPE_AGENT);
    __syncthreads();
    if (tid == 0) { int s = 0; for (int e = 0; e < NE; ++e) { pstart[e] = s; const int nt = (cl[e] + 255) >> 8; for (int t = 0; t < nt; ++t) tile_e[(s >> 8) + t] = e; s += nt << 8; } pstart[NE] = s; }
    __syncthreads();
}
__device__ __forceinline__ void moe_scatter(Frame& F) {
    LAS int* pstart = (LAS int*)(F.lds + MISC_OFF); LAS int* tile_e = pstart + 64;
    unsigned* ctl = (unsigned*)(F.ws + WS_CTL);
    moe_offsets(ctl + CW_CNT, pstart, tile_e, F.tid);
    const int gt = F.vcu * NTHR + F.tid, NGT = F.G * NTHR;
    const int* top_e = (const int*)(F.ws + WS_RT); const float* top_g = (const float*)(F.ws + WS_RT + 256 * 1024);
    int* slot_of = (int*)(F.ws + WS_RT + 512 * 1024); float* row_gate = (float*)(F.ws + WS_RT + 768 * 1024); int* row_tok = (int*)(F.ws + WS_RT + 1280 * 1024);
    for (int idx = gt; idx < T * 4; idx += NGT) { const int m = idx >> 2, e = top_e[idx], blk = (m >> 5) % F.G;
        const int slot = pstart[e] + (int)((const unsigned*)(F.ws + WS_BASE))[blk * NE + e] + slot_of[idx];
        slot_of[idx] = slot; row_gate[slot] = top_g[idx]; row_tok[slot] = m; }
    for (int idx = gt; idx < NE * 256; idx += NGT) { const int e = idx >> 8, sl = pstart[e] + (int)ctl[CW_CNT + e] + (idx & 255);
        if (sl < pstart[e + 1]) { row_tok[sl] = 0; row_gate[sl] = 0.f; } }
}
__device__ __forceinline__ void moe_combine(Frame& F, const Args& a) {
    const int gw = F.vcu * NWAVES + F.wave, NGW = F.G * NWAVES, lane = F.lane;
    const bf16* XNb = (const bf16*)(F.ws + WS_XN); const bf16* Y = (const bf16*)(F.ws + WS_XG); const int* slot_of = (const int*)(F.ws + WS_RT + 512 * 1024);
    f32x4 gg[4], bb[4];
#pragma unroll
    for (int j = 0; j < 4; ++j) { gg[j] = ((const GAS f32x4*)a.in[24] + lane)[64 * j]; bb[j] = ((const GAS f32x4*)a.in[25] + lane)[64 * j]; }
    for (int m = gw; m + NGW < T; m += 2 * NGW) {
        const int4 sa = *(const int4*)(slot_of + (size_t)m * 4), sb = *(const int4*)(slot_of + (size_t)(m + NGW) * 4);
        const int ss[2][4] = {{sa.x, sa.y, sa.z, sa.w}, {sb.x, sb.y, sb.z, sb.w}};
        v2u hw[2][4], yw[2][4][4];
#pragma unroll
        for (int t = 0; t < 2; ++t)
#pragma unroll
            for (int j = 0; j < 4; ++j) { hw[t][j] = ((const GAS v2u*)(XNb + (size_t)(m + t * NGW) * D) + lane)[64 * j];
#pragma unroll
                for (int k = 0; k < 4; ++k) yw[t][k][j] = ((const GAS v2u*)(Y + (size_t)ss[t][k] * D) + lane)[64 * j]; }
        f32x4 v[2][4]; float s[2], q[2];
#pragma unroll
        for (int t = 0; t < 2; ++t) { s[t] = 0.f;
#pragma unroll
            for (int j = 0; j < 4; ++j) { v[t][j] = (f32x4){bflo(hw[t][j].x), bfhi(hw[t][j].x), bflo(hw[t][j].y), bfhi(hw[t][j].y)} * ALPHA;
#pragma unroll
                for (int k = 0; k < 4; ++k) { const v2u w = yw[t][k][j]; v[t][j] += (f32x4){bflo(w.x), bfhi(w.x), bflo(w.y), bfhi(w.y)}; }
                s[t] += (v[t][j].x + v[t][j].y) + (v[t][j].z + v[t][j].w); } }
#pragma unroll
        for (int o = 1; o < 64; o <<= 1) { s[0] += __shfl_xor(s[0], o); s[1] += __shfl_xor(s[1], o); }
#pragma unroll
        for (int t = 0; t < 2; ++t) { const float mean = s[t] * (1.f / D); q[t] = 0.f;
#pragma unroll
            for (int j = 0; j < 4; ++j) { v[t][j] = v[t][j] - mean; q[t] += (v[t][j].x * v[t][j].x + v[t][j].y * v[t][j].y) + (v[t][j].z * v[t][j].z + v[t][j].w * v[t][j].w); } }
#pragma unroll
        for (int o = 1; o < 64; o <<= 1) { q[0] += __shfl_xor(q[0], o); q[1] += __shfl_xor(q[1], o); }
#pragma unroll
        for (int t = 0; t < 2; ++t) { const float rstd = 1.f / sqrtf(q[t] * (1.f / D) + LN_EPS);
#pragma unroll
            for (int j = 0; j < 4; ++j) ((GAS f32x4*)(a.out + (size_t)(m + t * NGW) * D) + lane)[64 * j] = v[t][j] * rstd * gg[j] + bb[j]; }
    }
}

constexpr int N_PHASES = 13;
__global__ void __launch_bounds__(NTHR, 2) fwd(Args args) {
    extern __shared__ __attribute__((aligned(16))) unsigned char lds[];
    Frame F; F.lds = (LAS unsigned char*)lds; F.tid = threadIdx.x; F.lane = F.tid & 63; F.wave = __builtin_amdgcn_readfirstlane(F.tid >> 6);
    F.G = gridDim.x; { const int bx = blockIdx.x; F.vcu = (F.G % 8 == 0) ? (bx % 8) * (F.G / 8) + bx / 8 : bx; }
    F.ws = args.ws;
    const int lo = args.ph_lo, hi = args.ph_hi;
    { volatile LAS unsigned* st0 = (volatile LAS unsigned*)(F.lds + LDS_BYTES - 16); if (F.tid < 2) st0[F.tid] = 0u; }
    __syncthreads();
    const XcdBarrier gbar = xcd_barrier_post((unsigned*)(F.ws + WS_CTL) + CW_BAR, (volatile LAS unsigned*)(F.lds + LDS_BYTES - 16));
#define GSYNC() xcd_barrier(gbar)
#define IN(k) (lo <= (k) && (k) < hi)
#define SEAM(k) do { if (IN(k) && IN((k) + 1)) GSYNC(); } while (0)
    if (IN(0)) p0_prologue(F, args);
    SEAM(0);
    if (IN(1)) { pg8::Gemm g{(const bf16*)(F.ws + WS_XN), (const bf16*)(F.ws + WS_WIN), T, IN_WP, D}; pg8::StaticOrder S; S.init(T, IN_WP, F.G, (int)blockIdx.x);
        EpiIn E{F.ws, args.in[4]}; pg8::gemm_phase<EpiIn, pg8::StaticOrder, true, true>(F.lds, g, S, E);
        if (F.G == 256 && blockIdx.x >= 192) (void)conv_up_tickets(F, args.in[20], 3); }
    SEAM(1);
    if (IN(2)) s5::phase_a(F);
    SEAM(2);
    if (IN(3)) s5::phase_b(F);
    if (IN(5)) { kmax_phase(F); indexer_phase(F); GSYNC(); attn_phase(F, lds, args.in[20]); GSYNC(); attn_merge(F); }
    SEAM(5);
    if (IN(6)) {
      for (int c = blockIdx.x; c < 256; c += F.G) {
        const bool have = true; const int pm = c >> 2, s = c & 3;
        { pg8::Gemm g{(const bf16*)(F.ws + WS_O), (const bf16*)(F.ws + WS_WAP), T, D, AW}; pg8::OneUnit S{{pm, s, s, 0}, have};
            EpiAtt E{F.ws}; pg8::gemm_phase<EpiAtt, pg8::OneUnit, false, true>(F.lds, g, S, E); }
      }
    }
    SEAM(6);
    if (IN(7)) { pg8::Gemm g{(const bf16*)(F.ws + WS_Z), (const bf16*)(F.ws + WS_WO), T, D, D}; pg8::StaticOrder S; S.init(T, D, F.G, (int)blockIdx.x);
        EpiMix E{(bf16*)(F.ws + WS_MIX)}; pg8::gemm_phase<EpiMix, pg8::StaticOrder, false, true>(F.lds, g, S, E); }
    SEAM(7);
    if (IN(8)) ln1_router(F, args);
    SEAM(8);
    if (IN(9)) moe_scatter(F);
    SEAM(9);
    if (IN(10) || IN(11)) {
        LAS int* pstart = (LAS int*)(F.lds + MISC_OFF); LAS int* tile_e = pstart + 64;
        __syncthreads();
        moe_offsets((unsigned*)(F.ws + WS_CTL) + CW_CNT, pstart, tile_e, F.tid);
        const int ntiles = pstart[NE] >> 8;
        if (IN(10)) { LAS int* tokl = (LAS int*)(F.lds + MISC_OFF + 1536); const int* row_tok = (const int*)(F.ws + WS_RT + 1280 * 1024);
            pg8::MoeOrder S{ntiles * 8, 8, F.G, (int)blockIdx.x, tile_e};
            for (int i = 0; i < 9; ++i) { pg8::Unit uu; if (S.next(i, uu) && F.tid < 256) tokl[i * 256 + F.tid] = row_tok[uu.pm * 256 + F.tid]; }
            __syncthreads();
            pg8::Gemm g{(const bf16*)(F.ws + WS_XN), (const bf16*)(F.ws + WS_WUP), MOE_ROWS, 2048, D, tokl};
            EpiSwiglu E{F.ws, args.in[21]}; pg8::gemm_phase<EpiSwiglu, pg8::MoeOrder, true, true, true>(F.lds, g, S, E);
            { volatile LAS int* qs = (volatile LAS int*)(F.lds + MISC_OFF + 3072); LAS float* scr = (LAS float*)(F.lds + F.wave * 16640);
              for (;;) {
                  if (F.tid == 0) qs[0] = (int)atomicAdd((unsigned*)(F.ws + WS_CTL) + CW_CVQ, 1u);
                  __syncthreads();
                  const int u = qs[0];
                  __syncthreads();
                  if (u >= NE * 256 / NWAVES) break;
                  const int item = u * NWAVES + F.wave, e = item >> 8;
                  p0_transpose_item(args.in[22] + (size_t)e * FF * D, FF, D, D, 0, (bf16*)(F.ws + WS_WDN) + (size_t)e * D * FF, scr, item & 255, F.lane); }
              __syncthreads();
              moe_offsets((unsigned*)(F.ws + WS_CTL) + CW_CNT, pstart, tile_e, F.tid); } }
        SEAM(10);
        if (IN(11)) { pg8::Gemm g{(const bf16*)(F.ws + WS_HH), (const bf16*)(F.ws + WS_WDN), MOE_ROWS, D, FF}; pg8::MoeOrder S{ntiles * 4, 4, F.G, (int)blockIdx.x, tile_e};
            EpiDown E{F.ws, args.in[23], (const float*)(F.ws + WS_RT + 768 * 1024)}; pg8::gemm_phase<EpiDown, pg8::MoeOrder, true, true>(F.lds, g, S, E); }
    }
    SEAM(11);
    if (IN(12)) moe_combine(F, args);
#undef IN
#undef SEAM
}

extern "C" void kernel_launch(void* const* d_in, const int* in_sizes, int n_in, void* d_out, int out_size, void* d_ws, size_t ws_size, hipStream_t stream) {
    static int grid = 0;
    if (grid == 0) {
        if (n_in != 26 || ws_size < WS_END) { fprintf(stderr, "kernel_launch: unexpected n_in %d / ws %zu\n", n_in, ws_size); grid = -1; return; }
        if (hipFuncSetAttribute((const void*)fwd, hipFuncAttributeMaxDynamicSharedMemorySize, LDS_BYTES) != hipSuccess) { fprintf(stderr, "hipFuncSetAttribute failed\n"); grid = -1; return; }
        int dev = 0, cus = 0, per_cu = 0;
        hipGetDevice(&dev); hipDeviceGetAttribute(&cus, hipDeviceAttributeMultiprocessorCount, dev);
        if (hipOccupancyMaxActiveBlocksPerMultiprocessor(&per_cu, (const void*)fwd, NTHR, LDS_BYTES) != hipSuccess || per_cu < 1) { fprintf(stderr, "occupancy query failed (%d)\n", per_cu); grid = -1; return; }
        grid = cus * per_cu; if (grid < 256) { fprintf(stderr, "needs 256 resident workgroups (have %d)\n", grid); grid = -1; return; } grid = 256;
        grid &= ~7; if (grid < 8) { grid = -1; return; }
    }
    if (grid < 0) return;
    (void)hipMemsetAsync((char*)d_ws + WS_CTL, 0, CTL_ZERO_BYTES, stream);
    Args a{};
    for (int i = 0; i < 26; ++i) a.in[i] = (const float*)d_in[i];
    a.out = (float*)d_out; a.ws = (unsigned char*)d_ws;
    a.ph_lo = 0; a.ph_hi = N_PHASES;
    void* kargs[] = {&a};
    hipError_t e = hipLaunchCooperativeKernel((const void*)fwd, dim3(grid), dim3(NTHR), kargs, LDS_BYTES, stream);
    if (e != hipSuccess) fprintf(stderr, "cooperative launch failed: %s (grid %d)\n", hipGetErrorString(e), grid);
}
```

```cpp
#include <hip/hip_runtime.h>
#include <hip/hip_cooperative_groups.h>
#include <cstdio>
#include <cstdint>

namespace pg8 {
#define PG8_LAS __attribute__((address_space(3)))
typedef unsigned short bf16_t;
typedef short bf16x8 __attribute__((ext_vector_type(8)));
typedef float f32x4 __attribute__((ext_vector_type(4)));
typedef unsigned u32x4 __attribute__((ext_vector_type(4)));
constexpr int BM = 256, BK = 64, HALF = 128, HTB = HALF * BK * 2, STAGE_BYTES = 8 * HTB, NXCD = 8, WGM = 8;

__host__ __device__ __forceinline__ int lds_byte(int r, int c) { const int st = (r >> 4) * 2 + (c >> 5), rr = r & 15, cc = c & 31, ob = rr * 64 + cc * 2; return st * 1024 + (ob ^ (((ob >> 9) & 1) << 5)); }
__host__ __device__ __forceinline__ void stage_rc(int b, int& R, int& C) { const int st = b / 1024, sb = b % 1024, swz = sb ^ (((sb >> 9) & 1) << 5); R = (st >> 1) * 16 + swz / 64; C = (st & 1) * 32 + (swz % 64) / 2; }
__host__ __device__ __forceinline__ int perm32(int rho) { const int n = rho >> 4, i = rho & 15; return 8 * (i >> 2) + 4 * n + (i & 3); }

struct Unit { int pm, pn, pb, e; };
struct Gemm { const bf16_t* A; const bf16_t* Bt; int M, N, K; const PG8_LAS int* tokl; };

struct StaticOrder {
    int nM, nN, nwg, G, c;
    __host__ __device__ void init(int M, int N, int G_, int c_) { nM = M / BM; nN = N / BM; nwg = nM * nN; G = G_; c = c_; }
    __host__ __device__ bool next(int i, Unit& u) const {
        const long L = (long)i * G + c; if (L >= nwg) return false;
        int wgid = (int)L; { const int q = nwg / NXCD, r = nwg % NXCD, xcd = wgid % NXCD, off = wgid / NXCD; wgid = (xcd < r ? xcd * (q + 1) : r * (q + 1) + (xcd - r) * q) + off; }
        const int nig = WGM * nN, gid = wgid / nig, fm = gid * WGM, gsz = (nM - fm) < WGM ? (nM - fm) : WGM;
        u.pm = fm + ((wgid % nig) % gsz); u.pn = (wgid % nig) / gsz; u.pb = u.pn; u.e = 0; return true;
    }
    __device__ __forceinline__ void a_ready(const Unit&) const {}
    __device__ __forceinline__ void done(const Unit&) const {}
};
struct OneUnit {
    Unit u; bool have;
    __device__ __forceinline__ bool next(int i, Unit& o) const { if (i != 0 || !have) return false; o = u; return true; }
    __device__ __forceinline__ void a_ready(const Unit&) const {}
    __device__ __forceinline__ void done(const Unit&) const {}
};
struct MoeOrder {
    int nunits, nN, G, c; const PG8_LAS int* tile_e;
    __device__ __forceinline__ bool next(int i, Unit& u) const {
        const long L = (long)i * G + c; if (L >= nunits) return false;
        int wgid = (int)L; { const int q = nunits / NXCD, r = nunits % NXCD, xcd = wgid % NXCD, off = wgid / NXCD; wgid = (xcd < r ? xcd * (q + 1) : r * (q + 1) + (xcd - r) * q) + off; }
        const int tile = wgid / nN, pn = wgid % nN; u.pm = tile; u.pn = pn; u.e = tile_e[tile]; u.pb = u.e * nN + pn; return true;
    }
    __device__ __forceinline__ void a_ready(const Unit&) const {}
    __device__ __forceinline__ void done(const Unit&) const {}
};

typedef float f32x2_cv __attribute__((ext_vector_type(2))); typedef __bf16 bf16x2_cv __attribute__((ext_vector_type(2)));
__device__ __forceinline__ unsigned cvt_pk_bf16(float lo, float hi) { const f32x2_cv v = {lo, hi}; const bf16x2_cv b = __builtin_convertvector(v, bf16x2_cv); return __builtin_bit_cast(unsigned, b); }

template <class Epi, class Sched, bool ALIGN_EPI = false, bool SP2 = false, bool GATHER = false>
__device__ __forceinline__ void gemm_phase(PG8_LAS unsigned char* lds, const Gemm g, const Sched& S, const Epi& E) {
    const int tid = threadIdx.x, wid = __builtin_amdgcn_readfirstlane(tid >> 6), lane = tid & 63, wr = wid >> 2, wc = wid & 3, fr = lane & 15, fq = lane >> 4;
    const int K = g.K, nt = K / BK;
    unsigned voffA[2], voffB[2];
#pragma unroll
    for (int i = 0; i < 2; ++i) { int R, C; stage_rc(tid * 16 + i * 8192, R, C); const int Rb = Epi::PERM ? ((R & ~31) + perm32(R & 31)) : R;
        voffA[i] = (unsigned)(R * K + C) * 2u; voffB[i] = (unsigned)(Rb * K + C) * 2u; }
    unsigned vg[2][2] = {{0u, 0u}, {0u, 0u}}, vn[2][2] = {{0u, 0u}, {0u, 0u}}, v2[2][2] = {{0u, 0u}, {0u, 0u}};
    auto tok_offs = [&](int slot, unsigned (&vo)[2][2]) {
#pragma unroll
        for (int h = 0; h < 2; ++h)
#pragma unroll
            for (int i = 0; i < 2; ++i) { int R, C; stage_rc(tid * 16 + i * 8192, R, C); vo[h][i] = (unsigned)(g.tokl[slot * 256 + h * HALF + R] * K + C) * 2u; } };
    const size_t kstep = (size_t)(BK * 2);
    const size_t hstep = (size_t)HALF * K * 2;
    const size_t tstep = 2 * hstep;
    const unsigned ldsw = (unsigned)wid * 1024u;
    const int aoff = lds_byte(wr * 64 + fr, fq * 8), boff = lds_byte(wc * 32 + fr, fq * 8);
#define PG8_SA(b, h) (((b) * 2 + (h)) * HTB)
#define PG8_SB(b, h) ((4 + (b) * 2 + (h)) * HTB)
#define PG8_STAGE(bufoff, gbase, voff) do { _Pragma("unroll") for (int _i = 0; _i < 2; ++_i) \
        __builtin_amdgcn_global_load_lds((const unsigned*)((const char*)(gbase) + (voff)[_i]), (PG8_LAS unsigned*)(lds + (bufoff) + ldsw + _i * 8192), 16, 0, 0); } while (0)
#define PG8_STAGEA(bufoff, gbase, h, vo) do { if constexpr (GATHER) { _Pragma("unroll") for (int _i = 0; _i < 2; ++_i) \
        __builtin_amdgcn_global_load_lds((const unsigned*)((const char*)(gbase) + (vo)[h][_i]), (PG8_LAS unsigned*)(lds + (bufoff) + ldsw + _i * 8192), 16, 0, 0); } \
        else { PG8_STAGE(bufoff, (const char*)(gbase) + (h) * hstep, voffA); } } while (0)
#define PG8_LDA(dst, b, h) do { _Pragma("unroll") for (int m = 0; m < 4; ++m) _Pragma("unroll") for (int k = 0; k < 2; ++k) dst[m][k] = *(const PG8_LAS bf16x8*)(lds + PG8_SA(b, h) + aoff + m * 2048 + k * 1024); } while (0)
#define PG8_LDB(dst, b, h) do { _Pragma("unroll") for (int n = 0; n < 2; ++n) _Pragma("unroll") for (int k = 0; k < 2; ++k) dst[n][k] = *(const PG8_LAS bf16x8*)(lds + PG8_SB(b, h) + boff + n * 2048 + k * 1024); } while (0)
#define PG8_MMA(ai, bj, At, Bt) do { __builtin_amdgcn_s_setprio(1); _Pragma("unroll") for (int m = 0; m < 4; ++m) _Pragma("unroll") for (int n = 0; n < 2; ++n) _Pragma("unroll") for (int k = 0; k < 2; ++k) \
        acc[ai][bj][m][n] = __builtin_amdgcn_mfma_f32_16x16x32_bf16(Bt[n][k], At[m][k], acc[ai][bj][m][n], 0, 0, 0); __builtin_amdgcn_s_setprio(0); } while (0)
#define PG8_WAIT_V(n) asm volatile("s_waitcnt vmcnt(" #n ")" ::: "memory")
#define PG8_WAIT_L(n) asm volatile("s_waitcnt lgkmcnt(" #n ")" ::: "memory")
#define PG8_BAR __builtin_amdgcn_s_barrier()
#define PG8_SCHED __builtin_amdgcn_sched_barrier(0)
    Unit cur, nxt; int ui = 0;
    if (!S.next(0, cur)) return;
    f32x4 acc[2][2][4][2];
#pragma unroll
    for (int a = 0; a < 2; ++a)
#pragma unroll
        for (int b = 0; b < 2; ++b)
#pragma unroll
            for (int m = 0; m < 4; ++m)
#pragma unroll
                for (int n = 0; n < 2; ++n) acc[a][b][m][n] = (f32x4){0.f, 0.f, 0.f, 0.f};
    bf16x8 At[4][2], B0[2][2], B1[2][2];
    const char* cA = (const char*)g.A + (GATHER ? (size_t)0 : (size_t)cur.pm * tstep); const char* cB = (const char*)g.Bt + (size_t)cur.pb * tstep;
    if constexpr (GATHER) tok_offs(0, vg);
    S.a_ready(cur);
    if constexpr (SP2) {
        PG8_STAGE(PG8_SB(0, 0), cB, voffB); PG8_STAGE(PG8_SB(0, 1), cB + hstep, voffB); PG8_STAGEA(PG8_SA(0, 0), cA, 0, vg); PG8_STAGEA(PG8_SA(0, 1), cA, 1, vg);
        if (wr == 1) PG8_BAR;
        PG8_WAIT_V(2); PG8_BAR;
        PG8_STAGE(PG8_SB(1, 0), cB + kstep, voffB); PG8_STAGEA(PG8_SA(1, 0), cA + kstep, 0, vg); PG8_STAGE(PG8_SB(1, 1), cB + hstep + kstep, voffB);
        PG8_WAIT_V(6); PG8_BAR;
    } else {
        PG8_STAGE(PG8_SB(0, 0), cB, voffB); PG8_STAGEA(PG8_SA(0, 0), cA, 0, vg); PG8_STAGE(PG8_SB(0, 1), cB + hstep, voffB); PG8_STAGEA(PG8_SA(0, 1), cA, 1, vg);
        if (wr == 1) PG8_BAR;
        PG8_WAIT_V(4); PG8_BAR;
        PG8_STAGE(PG8_SB(1, 0), cB + kstep, voffB); PG8_STAGEA(PG8_SA(1, 0), cA + kstep, 0, vg); PG8_STAGE(PG8_SB(1, 1), cB + hstep + kstep, voffB);
        PG8_WAIT_V(6); PG8_BAR;
    }
    for (;;) {
        const bool has_next = S.next(ui + 1, nxt);
        const char* nA = (has_next && !GATHER) ? (const char*)g.A + (size_t)nxt.pm * tstep : cA; const char* nB = has_next ? (const char*)g.Bt + (size_t)nxt.pb * tstep : cB;
        if constexpr (GATHER) { if (has_next) tok_offs(ui + 1, vn); }
        for (int t = 0; t < nt; t += 2) {
            const bool last = (t == nt - 2);
            const char* a1 = cA + (size_t)(t + 1) * kstep;
            const char* a2 = last ? nA : cA + (size_t)(t + 2) * kstep; const char* b2 = last ? nB : cB + (size_t)(t + 2) * kstep;
            const char* a3 = a2 + kstep; const char* b3 = b2 + kstep;
            if (last && has_next) S.a_ready(nxt);
            if constexpr (GATHER) { const bool un = last && has_next;
#pragma unroll
                for (int h = 0; h < 2; ++h)
#pragma unroll
                    for (int i = 0; i < 2; ++i) v2[h][i] = un ? vn[h][i] : vg[h][i]; }
            if constexpr (SP2) {
            PG8_LDB(B0, 0, 0); PG8_LDB(B1, 0, 1); PG8_SCHED; PG8_LDA(At, 0, 0); PG8_STAGEA(PG8_SA(1, 1), a1, 1, vg);
            PG8_WAIT_V(8); PG8_WAIT_L(0); PG8_BAR; PG8_MMA(0, 0, At, B0); PG8_MMA(0, 1, At, B1); PG8_BAR; PG8_SCHED;
            PG8_LDA(At, 0, 1); PG8_STAGE(PG8_SB(0, 0), b2, voffB); PG8_STAGE(PG8_SB(0, 1), b2 + hstep, voffB); PG8_STAGEA(PG8_SA(0, 0), a2, 0, v2);
            PG8_WAIT_V(8); PG8_WAIT_L(0); PG8_BAR; PG8_MMA(1, 0, At, B0); PG8_MMA(1, 1, At, B1); PG8_BAR; PG8_SCHED;
            PG8_LDB(B0, 1, 0); PG8_LDB(B1, 1, 1); PG8_SCHED; PG8_LDA(At, 1, 0); PG8_STAGEA(PG8_SA(0, 1), a2, 1, v2);
            PG8_WAIT_V(8); PG8_WAIT_L(0); PG8_BAR; PG8_MMA(0, 0, At, B0); PG8_MMA(0, 1, At, B1); PG8_BAR; PG8_SCHED;
            PG8_LDA(At, 1, 1); PG8_STAGE(PG8_SB(1, 0), b3, voffB); PG8_STAGE(PG8_SB(1, 1), b3 + hstep, voffB); PG8_STAGEA(PG8_SA(1, 0), a3, 0, v2);
            PG8_WAIT_V(8); PG8_WAIT_L(0); PG8_BAR; PG8_MMA(1, 0, At, B0); PG8_MMA(1, 1, At, B1); PG8_BAR; PG8_SCHED;
            } else {
            PG8_LDB(B0, 0, 0); PG8_SCHED; PG8_LDA(At, 0, 0); PG8_STAGEA(PG8_SA(1, 1), a1, 1, vg);
            PG8_WAIT_L(8); PG8_BAR; PG8_WAIT_L(0); PG8_MMA(0, 0, At, B0); PG8_BAR; PG8_SCHED;
            PG8_LDB(B1, 0, 1); PG8_STAGE(PG8_SB(0, 0), b2, voffB);
            PG8_BAR; PG8_WAIT_L(0); PG8_MMA(0, 1, At, B1); PG8_BAR;
            PG8_LDA(At, 0, 1); PG8_STAGEA(PG8_SA(0, 0), a2, 0, v2);
            PG8_BAR; PG8_WAIT_L(0); PG8_MMA(1, 0, At, B0); PG8_BAR; PG8_SCHED;
            PG8_STAGE(PG8_SB(0, 1), b2 + hstep, voffB);
            PG8_WAIT_V(6); PG8_BAR; PG8_MMA(1, 1, At, B1); PG8_BAR;
            PG8_LDB(B0, 1, 0); PG8_SCHED; PG8_LDA(At, 1, 0); PG8_STAGEA(PG8_SA(0, 1), a2, 1, v2);
            PG8_WAIT_L(8); PG8_BAR; PG8_WAIT_L(0); PG8_MMA(0, 0, At, B0); PG8_BAR; PG8_SCHED;
            PG8_LDB(B1, 1, 1); PG8_STAGE(PG8_SB(1, 0), b3, voffB);
            PG8_BAR; PG8_WAIT_L(0); PG8_MMA(0, 1, At, B1); PG8_BAR;
            PG8_LDA(At, 1, 1); PG8_STAGEA(PG8_SA(1, 0), a3, 0, v2);
            PG8_BAR; PG8_WAIT_L(0); PG8_MMA(1, 0, At, B0); PG8_BAR; PG8_SCHED;
            PG8_STAGE(PG8_SB(1, 1), b3 + hstep, voffB);
            PG8_WAIT_V(6); PG8_BAR; PG8_MMA(1, 1, At, B1); PG8_BAR;
            }
        }
        if constexpr (ALIGN_EPI) { if (wr == 0) PG8_BAR; }
        E(acc, cur, wr, wc, fr, fq); S.done(cur);
        if (!has_next) break;
#pragma unroll
        for (int a = 0; a < 2; ++a)
#pragma unroll
            for (int b = 0; b < 2; ++b)
#pragma unroll
                for (int m = 0; m < 4; ++m)
#pragma unroll
                    for (int n = 0; n < 2; ++n) acc[a][b][m][n] = (f32x4){0.f, 0.f, 0.f, 0.f};
        cur = nxt; cA = nA; cB = nB; ++ui;
        if constexpr (GATHER) {
#pragma unroll
            for (int h = 0; h < 2; ++h)
#pragma unroll
                for (int i = 0; i < 2; ++i) vg[h][i] = vn[h][i]; }
        if constexpr (ALIGN_EPI) { if (wr == 1) PG8_BAR; }
    }
    PG8_WAIT_V(0);
    if constexpr (!ALIGN_EPI) { if (wr == 0) PG8_BAR; }
    PG8_BAR;
#undef PG8_SA
#undef PG8_SB
#undef PG8_STAGE
#undef PG8_STAGEA
#undef PG8_LDA
#undef PG8_LDB
#undef PG8_MMA
#undef PG8_WAIT_V
#undef PG8_WAIT_L
#undef PG8_BAR
#undef PG8_SCHED
}
}


#include <hip/hip_bf16.h>
namespace attn_body {
using bf16=__hip_bfloat16;
using bf16x8=__attribute__((ext_vector_type(8)))short;
using s16x4=__attribute__((ext_vector_type(4)))short;
using f32x16=__attribute__((ext_vector_type(16)))float;
using u32x4=__attribute__((ext_vector_type(4)))unsigned;
constexpr int BATCH=2,NHEAD=8,SEQ=8192,D=64,DM=NHEAD*D;
constexpr int NW=8,QBLK=32,QB=QBLK*NW,KVBLK=64,NQB=SEQ/QB;
__device__ __forceinline__ int crow(int r,int hi){return (r&3)+8*(r>>2)+4*hi;}
#define SBAR() __builtin_amdgcn_sched_barrier(0)
constexpr int NSLOT=3, SLOTB=8192;
constexpr int LDS_K=0, LDS_V=NSLOT*SLOTB, LDS_WS=2*NSLOT*SLOTB, LDS_OST=LDS_WS+NW*64*4, LDS_BYTES=LDS_OST+NW*4096;
__device__ __forceinline__ void glds16(const void*gsrc,unsigned lds_dst){unsigned keep;
  asm volatile("s_mov_b32 %0, m0\n\ts_mov_b32 m0, %2\n\ts_nop 0\n\tglobal_load_lds_dwordx4 %1, off\n\ts_mov_b32 m0, %0":"=&s"(keep):"v"(gsrc),"s"(lds_dst):"memory");}
__device__ __forceinline__ float max3f(float a,float b,float c){float r;asm("v_max3_f32 %0, %1, %2, %3":"=v"(r):"v"(a),"v"(b),"v"(c));return r;}
__device__ __forceinline__ float max2f(float a,float b){float r;asm("v_max_f32_e32 %0, %1, %2":"=v"(r):"v"(a),"v"(b));return r;}
__device__ __forceinline__ float fadd_s(float a,float b){float r;asm("v_add_f32_e32 %0, %1, %2":"=v"(r):"v"(a),"v"(b));return r;}
__device__ __forceinline__ float fsub_s(float a,float b){float r;asm("v_sub_f32_e32 %0, %1, %2":"=v"(r):"v"(a),"v"(b));return r;}
typedef float f32x2_t __attribute__((ext_vector_type(2))); typedef __bf16 bf16x2_t __attribute__((ext_vector_type(2)));
__device__ __forceinline__ unsigned cvtpk_s(float lo,float hi){f32x2_t v={lo,hi};bf16x2_t b=__builtin_convertvector(v,bf16x2_t);return __builtin_bit_cast(unsigned,b);}
#define WAIT_BAR(N) asm volatile("s_waitcnt vmcnt(" #N ") lgkmcnt(0)\n\ts_barrier":::"memory")
__device__ __forceinline__ void qkt(f32x16&p0,f32x16&p1,const char*Kslot,const bf16x8*qr,const f32x16&negm,int r32,int hi){
  const char*kb=Kslot+hi*1024+r32*16;
  #pragma unroll
  for(int d0=0;d0<4;++d0){
    const bf16x8 b0=*reinterpret_cast<const bf16x8*>(kb+d0*2048);
    const bf16x8 b1=*reinterpret_cast<const bf16x8*>(kb+d0*2048+512);
    if(d0==0){p0=__builtin_amdgcn_mfma_f32_32x32x16_bf16(b0,qr[0],negm,0,0,0);p1=__builtin_amdgcn_mfma_f32_32x32x16_bf16(b1,qr[0],negm,0,0,0);}
    else{p0=__builtin_amdgcn_mfma_f32_32x32x16_bf16(b0,qr[d0],p0,0,0,0);p1=__builtin_amdgcn_mfma_f32_32x32x16_bf16(b1,qr[d0],p1,0,0,0);}}
}
typedef __attribute__((address_space(3))) const char* lds_cptr;
typedef short v4i16_t __attribute__((ext_vector_type(4)));
__device__ __forceinline__ void kload8(bf16x8*kf,lds_cptr kp){
  kf[0]=*(const __attribute__((address_space(3))) bf16x8*)(kp);      kf[1]=*(const __attribute__((address_space(3))) bf16x8*)(kp+512);
  kf[2]=*(const __attribute__((address_space(3))) bf16x8*)(kp+2048); kf[3]=*(const __attribute__((address_space(3))) bf16x8*)(kp+2560);
  kf[4]=*(const __attribute__((address_space(3))) bf16x8*)(kp+4096); kf[5]=*(const __attribute__((address_space(3))) bf16x8*)(kp+4608);
  kf[6]=*(const __attribute__((address_space(3))) bf16x8*)(kp+6144); kf[7]=*(const __attribute__((address_space(3))) bf16x8*)(kp+6656);
}
__device__ __forceinline__ void kload2(bf16x8*kf,lds_cptr kp,int j){ kf[2*j]=*(const __attribute__((address_space(3))) bf16x8*)(kp+j*2048); kf[2*j+1]=*(const __attribute__((address_space(3))) bf16x8*)(kp+j*2048+512); }
__device__ __forceinline__ s16x4 vtr(lds_cptr p){ return __builtin_bit_cast(s16x4,__builtin_amdgcn_ds_read_tr16_b64_v4i16((__attribute__((address_space(3))) v4i16_t*)p)); }
__device__ __forceinline__ float rowmax(const f32x16&p0,const f32x16&p1){
  float a=max3f(p0[0],p0[1],p1[0]),b=max3f(p0[2],p0[3],p1[1]);a=max3f(a,p1[2],p1[3]);
  #pragma unroll
  for(int r=4;r<16;r+=4){a=max3f(a,p0[r],p0[r+1]);b=max3f(b,p0[r+2],p0[r+3]);a=max3f(a,p1[r],p1[r+1]);b=max3f(b,p1[r+2],p1[r+3]);}
  const float m=max2f(a,b);
  auto rr=__builtin_amdgcn_permlane32_swap(__float_as_uint(m),__float_as_uint(m),false,false);
  return max2f(__uint_as_float(rr[0]),__uint_as_float(rr[1]));
}
__device__ __forceinline__ void pv(f32x16*o,int vb,bf16x8 pa0,bf16x8 pa1,bf16x8 pa2,bf16x8 pa3){
  #pragma unroll
  for(int d0=0;d0<2;++d0){s16x4 lo[4],hi[4];
    #pragma unroll
    for(int ks=0;ks<4;++ks){
      asm volatile("ds_read_b64_tr_b16 %0,%1 offset:%c2":"=&v"(lo[ks]):"v"(vb),"i"(d0*4096+ks*1024):"memory");
      asm volatile("ds_read_b64_tr_b16 %0,%1 offset:%c2":"=&v"(hi[ks]):"v"(vb),"i"(d0*4096+ks*1024+512):"memory");}
    asm volatile("s_waitcnt lgkmcnt(0)":::"memory");SBAR();
    #define PK(k) (bf16x8){lo[k][0],lo[k][1],lo[k][2],lo[k][3],hi[k][0],hi[k][1],hi[k][2],hi[k][3]}
    o[d0]=__builtin_amdgcn_mfma_f32_32x32x16_bf16(pa0,PK(0),o[d0],0,0,0);
    o[d0]=__builtin_amdgcn_mfma_f32_32x32x16_bf16(pa1,PK(1),o[d0],0,0,0);
    o[d0]=__builtin_amdgcn_mfma_f32_32x32x16_bf16(pa2,PK(2),o[d0],0,0,0);
    o[d0]=__builtin_amdgcn_mfma_f32_32x32x16_bf16(pa3,PK(3),o[d0],0,0,0);
    #undef PK
  }
}
__device__ __forceinline__ float bfi_f(unsigned m,float x,float y){float r;asm("v_bfi_b32 %0, %1, %2, %3":"=v"(r):"v"(m),"v"(x),"v"(y));return r;}
__device__ __forceinline__ void maskalibi(f32x16&c0,f32x16&c1,unsigned mk,float s2){
  float ninf=-INFINITY; asm volatile("":"+v"(ninf));
  #pragma unroll
  for(int r=0;r<16;++r){ const float kr=(float)((r&3)+8*(r>>2));
    const float a=__builtin_fmaf(s2,kr,c0[r]), b=__builtin_fmaf(s2,kr+32.f,c1[r]);
    const unsigned m0=(unsigned)__builtin_amdgcn_sbfe((int)mk,r,1), m1=(unsigned)__builtin_amdgcn_sbfe((int)mk,16+r,1);
    c0[r]=bfi_f(m0,a,ninf); c1[r]=bfi_f(m1,b,ninf); }
}
#ifndef ATTN_STORE16
#define ATTN_STORE16(p,v) (*(u32x4*)(p)=(v))
#endif
template<int THRL> __device__ __forceinline__ void attn_unit(int b,int h,int qb,int TOFF,int NTP,bool PART,const bf16*Q,const bf16*__restrict__ K,const bf16*__restrict__ V,bf16*O,bf16*OP,float*LSE,const unsigned*MK,float kmax2,char*shm){
  const int tid=threadIdx.x,lane=tid&63,r32=lane&31,hi=lane>>5; const int wid=__builtin_amdgcn_readfirstlane(tid>>6);
  const long rowbase=(long)b*SEQ; const int q0=qb*QB;
  const bf16*Qw=Q+(rowbase+q0+wid*QBLK)*DM+h*D;
  const bf16*Kh=K+rowbase*DM+h*D,*Vh=V+rowbase*DM+h*D;
  const unsigned lds0=(unsigned)(uintptr_t)shm;
  float*wsf=(float*)(shm+LDS_WS)+wid*64;
  const bf16*ksrc=Kh+(long)lane*DM+wid*8;
  const bf16*vsrc=Vh+(long)(16*(wid&3)+(lane>>2))*DM+(wid>>2)*32+(lane&3)*8;
  const unsigned kdst=lds0+LDS_K+wid*1024, vdst=lds0+LDS_V+wid*1024;
  const int NT=(q0+QB)/KVBLK;
  #define PT(t) (NT-1-TOFF-(t))
  #define DMA_K(t,slot) glds16(ksrc+(long)PT(t)*KVBLK*DM,(unsigned)__builtin_amdgcn_readfirstlane(kdst+(slot)))
  #define DMA_V(t,slot) glds16(vsrc+(long)PT(t)*KVBLK*DM,(unsigned)__builtin_amdgcn_readfirstlane(vdst+(slot)))
  const int vb0=(int)(lds0+LDS_V)+((lane>>4)&1)*32+(lane&3)*8+(4*hi+((lane&15)>>2))*64;
  const char*Kbase=shm+LDS_K; bf16x8 kf[8];
  const lds_cptr shm3=(lds_cptr)shm; const lds_cptr kp0=shm3+LDS_K+hi*1024+r32*16; const lds_cptr vp0=shm3+LDS_V+((lane>>4)&1)*32+(lane&3)*8+(4*hi+((lane&15)>>2))*64;
  const float slope2=__builtin_amdgcn_exp2f(-(float)(h+1))*1.4426950408889634f;
  const float hib=slope2*4.f*(float)hi;
  const unsigned*mkp=MK+(((size_t)b*256+(size_t)(qb*8+wid))*128)*64+lane;
  #define MKLD(dst,t) asm volatile("global_load_dword %0, %1, off":"=v"(dst):"v"(mkp+(size_t)PT(t)*64):"memory")
  bf16x8 qr[4];
  #pragma unroll
  for(int d0=0;d0<4;++d0)qr[d0]=*reinterpret_cast<const bf16x8*>(&Qw[(long)r32*DM+d0*16+hi*8]);
  int NP;
  if(h==7){ NP=NT-TOFF; NP=NP>NTP?NTP:NP; }
  else { unsigned mw[8];
    #pragma unroll
    for(int j=0;j<8;++j)mw[j]=(j<NT)?mkp[(size_t)(NT-1-j)*64]:0u;
    float q2=0.f;
    #pragma unroll
    for(int d0=0;d0<4;++d0)
      #pragma unroll
      for(int i=0;i<8;++i){const float x=__builtin_bit_cast(float,(unsigned)(unsigned short)qr[d0][i]<<16);q2=__builtin_fmaf(x,x,q2);}
    q2+=__shfl_xor(q2,32);
    int best=-1;
    #pragma unroll
    for(int j=0;j<8;++j){ const unsigned w=mw[j]; if(w){ const int hb=31-__builtin_clz(w); const int pos=64*(NT-1-j)+32*(hb>>4)+crow(hb&15,hi); best=best>pos?best:pos; } }
    { const int ob=__shfl_xor(best,32); best=best>ob?best:ob; }
    const float need=(40.f+2.f*__builtin_sqrtf(q2*kmax2))/slope2;
    float kminf=best>=0?(float)best-need:-1.0e9f;
    #pragma unroll
    for(int o=1;o<32;o<<=1)kminf=__builtin_fminf(kminf,__shfl_xor(kminf,o));
    if(lane==0)wsf[0]=kminf;
    asm volatile("s_waitcnt lgkmcnt(0)\n\ts_barrier":::"memory");
    float km=((float*)(shm+LDS_WS))[0];
    #pragma unroll
    for(int w=1;w<8;++w)km=__builtin_fminf(km,((float*)(shm+LDS_WS))[w*64]);
    const int ptmin=km<=0.f?0:((int)km>>6);
    int NTE=NT-ptmin; NTE=(NTE+1)&~1; NTE=NTE<4?4:NTE; NTE=NTE>NT?NT:NTE;
    NP=NTE-TOFF; NP=NP>NTP?NTP:NP; if(NP>0&&NP<4)NP=4;
    NP=__builtin_amdgcn_readfirstlane(NP);
    asm volatile("s_waitcnt lgkmcnt(0)\n\ts_barrier":::"memory"); }
  if(NP<=0){ if(PART&&hi==0)LSE[wid*QBLK+r32]=-INFINITY; return; }
  unsigned mkA,mkB;
  MKLD(mkA,0); MKLD(mkB,1);
  DMA_K(0,0);DMA_V(0,0);DMA_K(1,SLOTB);
  float mhat=0.f,l_reg=0.f;f32x16 o[2];o[0]=f32x16{};o[1]=f32x16{};f32x16 negm=f32x16{};
  #define SETNEG(t) do{ const float lb_=slope2*(float)(64*PT(t)-q0)+hib-mhat; _Pragma("unroll") for(int r=0;r<16;++r)negm[r]=lb_; asm volatile("":"+v"(negm)); }while(0)
  SETNEG(0);
  bool resc=false;
  #define START(P0,P1) do{ const float rm=rowmax(P0,P1); resc=false; \
    { const float dl=max2f(rm,-16384.f); mhat=fadd_s(mhat,dl); \
      _Pragma("unroll") for(int r=0;r<16;++r){P0[r]=fsub_s(P0[r],dl);P1[r]=fsub_s(P1[r],dl);} } \
    _Pragma("unroll") for(int r=0;r<16;++r)P0[r]=__builtin_amdgcn_exp2f(P0[r]); }while(0)
  #define RESC() do{ if(resc){ asm volatile("s_waitcnt lgkmcnt(0)":::"memory"); \
      _Pragma("unroll") for(int d_=0;d_<2;++d_) _Pragma("unroll") for(int r=0;r<16;++r)o[d_][r]*=wsf[crow(r,hi)]; } }while(0)
  f32x16 pA0,pA1,pB0,pB1;
  int sl_prev=0,sl_cur=0,sl_next=SLOTB;
  #define ROT() do{sl_prev=sl_cur;sl_cur=sl_next;sl_next=(sl_next==(NSLOT-1)*SLOTB)?0:sl_next+SLOTB;}while(0)
  DMA_K(2,2*SLOTB);
  WAIT_BAR(3);
  asm volatile("":"+v"(mkA),"+v"(mkB));
  qkt(pA0,pA1,Kbase,qr,negm,r32,hi); maskalibi(pA0,pA1,mkA,slope2); asm volatile("s_nop 15\n\ts_nop 7":"+v"(pA0),"+v"(pA1));
  START(pA0,pA1);
  _Pragma("unroll") for(int r=0;r<16;++r)pA1[r]=__builtin_amdgcn_exp2f(pA1[r]);
  WAIT_BAR(0);
  DMA_K(3,0);DMA_V(1,SLOTB);
  ROT();
  kload8(kf,kp0+sl_cur);
  WAIT_BAR(2);
  s16x4 vlo[8],vhi[8]; u32x4 pw0,pw1,pw2,pw3;
  #define PKW(P,B) cvtpk_s(P[B],P[B+1])
  #define PAF(k) __builtin_bit_cast(bf16x8,pw##k)
  #define VFR(i) (bf16x8){vlo[i][0],vlo[i][1],vlo[i][2],vlo[i][3],vhi[i][0],vhi[i][1],vhi[i][2],vhi[i][3]}
  #define PIN(x) asm volatile("":"+v"(x))
  #define MX3(a,b,c) __builtin_fmaxf(__builtin_fmaxf((a),(b)),(c))
  #define GAPA(MF,A0,A1,A2,A3,W0,W1,PW) do{ MF; sacc+=A0; sacc+=A1; sacc+=A2; sacc+=A3; PIN(sacc); W0; W1; PIN(PW); SBAR(); }while(0)
  #define EX(v) __builtin_amdgcn_exp2f(v)
  #define GAPB(MF,X,B) do{ MF; X[B]=EX(X[B]); X[B+1]=EX(X[B+1]); X[B+2]=EX(X[B+2]); X[B+3]=EX(X[B+3]); PIN(X); SBAR(); }while(0)
  #define VRD(i) do{ vlo[i]=vtr(vp_+(((i)>>2)*4096+((i)&3)*1024)); vhi[i]=vtr(vp_+(((i)>>2)*4096+((i)&3)*1024+512)); }while(0)
  #define KRD(G,j) do{ if(G){ kload2(kf,kp0+sl_next,j); SBAR(); } }while(0)
  #define STEP(C0,C1,P0,P1,t,GK,GV,GL,MCUR,MNXT) do{ SBAR(); \
    SETNEG(t); \
    const lds_cptr vp_=vp0+sl_prev; \
    VRD(0); SBAR(); float sacc=(P0[0]+P0[1]); \
    GAPA(C0=__builtin_amdgcn_mfma_f32_32x32x16_bf16(kf[0],qr[0],negm,0,0,0), P0[2],P0[3],P0[4],P0[5],     pw0[0]=PKW(P0,0), pw0[1]=PKW(P0,2), pw0); \
    VRD(4); SBAR(); GAPA(C1=__builtin_amdgcn_mfma_f32_32x32x16_bf16(kf[1],qr[0],negm,0,0,0), P0[6],P0[7],P0[8],P0[9],     pw0[2]=PKW(P0,4), pw0[3]=PKW(P0,6), pw0); \
    VRD(1); SBAR(); GAPA(C0=__builtin_amdgcn_mfma_f32_32x32x16_bf16(kf[2],qr[1],C0,0,0,0),   P0[10],P0[11],P0[12],P0[13], pw1[0]=PKW(P0,8), pw1[1]=PKW(P0,10), pw1); \
    VRD(5); SBAR(); GAPA(C1=__builtin_amdgcn_mfma_f32_32x32x16_bf16(kf[3],qr[1],C1,0,0,0),   P0[14],P0[15],P1[0],P1[1],   pw1[2]=PKW(P0,12),pw1[3]=PKW(P0,14), pw1); \
    VRD(2); SBAR(); GAPA(C0=__builtin_amdgcn_mfma_f32_32x32x16_bf16(kf[4],qr[2],C0,0,0,0),   P1[2],P1[3],P1[4],P1[5],     pw2[0]=PKW(P1,0), pw2[1]=PKW(P1,2), pw2); \
    VRD(6); SBAR(); GAPA(C1=__builtin_amdgcn_mfma_f32_32x32x16_bf16(kf[5],qr[2],C1,0,0,0),   P1[6],P1[7],P1[8],P1[9],     pw2[2]=PKW(P1,4), pw2[3]=PKW(P1,6), pw2); \
    VRD(3); SBAR(); GAPA(C0=__builtin_amdgcn_mfma_f32_32x32x16_bf16(kf[6],qr[3],C0,0,0,0),   P1[10],P1[11],P1[12],P1[13], pw3[0]=PKW(P1,8), pw3[1]=PKW(P1,10), pw3); \
    VRD(7); SBAR(); GAPA(C1=__builtin_amdgcn_mfma_f32_32x32x16_bf16(kf[7],qr[3],C1,0,0,0),   P1[14],P1[15],0.f,0.f,       pw3[2]=PKW(P1,12),pw3[3]=PKW(P1,14), pw3); \
    l_reg+=sacc; \
    if(GV){MKLD(MNXT,(t)+1);} if(GK){DMA_K((t)+3,sl_cur);} if(GV){DMA_V((t)+1,sl_next);} \
    maskalibi(C0,C1,MCUR,slope2); \
    { float a=MX3(C0[0],C0[1],C1[0]),b=MX3(C0[2],C0[3],C1[1]); a=MX3(a,C1[2],C1[3]); \
      _Pragma("unroll") for(int r=4;r<16;r+=4){a=MX3(a,C0[r],C0[r+1]);b=MX3(b,C0[r+2],C0[r+3]);a=MX3(a,C1[r],C1[r+1]);b=MX3(b,C1[r+2],C1[r+3]);} \
      float rm=__builtin_fmaxf(a,b); { auto rr=__builtin_amdgcn_permlane32_swap(__float_as_uint(rm),__float_as_uint(rm),false,false); rm=__builtin_fmaxf(__uint_as_float(rr[0]),__uint_as_float(rr[1])); } \
      resc=false; \
      if(__builtin_expect(__any(rm>(float)THRL),0)){ const float dl=__builtin_fmaxf(rm,0.f); mhat+=dl; \
        _Pragma("unroll") for(int r=0;r<16;++r){C0[r]-=dl;C1[r]-=dl;} \
        const float f=__builtin_amdgcn_exp2f(-dl); l_reg*=f; if(hi==0)wsf[r32]=f; resc=true; } } \
    SBAR(); \
    GAPB(o[0]=__builtin_amdgcn_mfma_f32_32x32x16_bf16(PAF(0),VFR(0),o[0],0,0,0), C0,0); \
    GAPB(o[1]=__builtin_amdgcn_mfma_f32_32x32x16_bf16(PAF(0),VFR(4),o[1],0,0,0), C0,4); \
    KRD(GL,0); GAPB(o[0]=__builtin_amdgcn_mfma_f32_32x32x16_bf16(PAF(1),VFR(1),o[0],0,0,0), C0,8); \
    KRD(GL,1); GAPB(o[1]=__builtin_amdgcn_mfma_f32_32x32x16_bf16(PAF(1),VFR(5),o[1],0,0,0), C0,12); \
    KRD(GL,2); GAPB(o[0]=__builtin_amdgcn_mfma_f32_32x32x16_bf16(PAF(2),VFR(2),o[0],0,0,0), C1,0); \
    KRD(GL,3); GAPB(o[1]=__builtin_amdgcn_mfma_f32_32x32x16_bf16(PAF(2),VFR(6),o[1],0,0,0), C1,4); \
    GAPB(o[0]=__builtin_amdgcn_mfma_f32_32x32x16_bf16(PAF(3),VFR(3),o[0],0,0,0), C1,8); \
    GAPB(o[1]=__builtin_amdgcn_mfma_f32_32x32x16_bf16(PAF(3),VFR(7),o[1],0,0,0), C1,12); \
    }while(0)
  int t=1;
  for(;t+5<NP;t+=2){
    STEP(pB0,pB1,pA0,pA1,t,true,true,true,mkB,mkA);     WAIT_BAR(2); PIN(mkA); RESC(); ROT();
    STEP(pA0,pA1,pB0,pB1,t+1,true,true,true,mkA,mkB);   WAIT_BAR(2); PIN(mkB); RESC(); ROT();
  }
  #define ENDW(tt) do{ if((tt)+3<NP){WAIT_BAR(2);} else if((tt)+2<NP){WAIT_BAR(1);} else {WAIT_BAR(0);} }while(0)
  for(;t+1<NP;t+=2){
    STEP(pB0,pB1,pA0,pA1,t,(t+3<NP),(t+1<NP),(t+1<NP),mkB,mkA);       ENDW(t);   PIN(mkA); RESC(); ROT();
    STEP(pA0,pA1,pB0,pB1,t+1,(t+4<NP),(t+2<NP),(t+2<NP),mkA,mkB);     ENDW(t+1); PIN(mkB); RESC(); ROT();
  }
  STEP(pB0,pB1,pA0,pA1,NP-1,false,false,false,mkB,mkA); RESC();
  { float sacc=pB0[0]+pB0[1]; _Pragma("unroll") for(int r=2;r<16;++r)sacc+=pB0[r]; _Pragma("unroll") for(int r=0;r<16;++r)sacc+=pB1[r]; l_reg+=sacc;
    pw0=(u32x4){PKW(pB0,0),PKW(pB0,2),PKW(pB0,4),PKW(pB0,6)};pw1=(u32x4){PKW(pB0,8),PKW(pB0,10),PKW(pB0,12),PKW(pB0,14)};pw2=(u32x4){PKW(pB1,0),PKW(pB1,2),PKW(pB1,4),PKW(pB1,6)};pw3=(u32x4){PKW(pB1,8),PKW(pB1,10),PKW(pB1,12),PKW(pB1,14)};
    SBAR(); pv(o,vb0+sl_cur,PAF(0),PAF(1),PAF(2),PAF(3)); }
  #undef PKW
  #undef PAF
  #undef VFR
  #undef PIN
  #undef MX3
  #undef GAPA
  #undef GAPB
  #undef EX
  #undef VRD
  #undef KRD
  #undef STEP
  #undef ENDW
  {auto rr=__builtin_amdgcn_permlane32_swap(__float_as_uint(l_reg),__float_as_uint(l_reg),false,false);l_reg=__uint_as_float(rr[0])+__uint_as_float(rr[1]);}
  if(hi==0)wsf[32+r32]=l_reg;asm volatile("s_waitcnt lgkmcnt(0)":::"memory");
  if(PART&&hi==0)LSE[wid*QBLK+r32]=l_reg>0.f?mhat+__builtin_amdgcn_logf(l_reg):-INFINITY;
  float rli[16];
  #pragma unroll
  for(int r=0;r<16;++r){const float lv=wsf[32+crow(r,hi)];rli[r]=lv>0.f?__builtin_amdgcn_rcpf(lv):0.f;}
  bf16*Ow=PART?OP+(long)(wid*QBLK)*D:O+(rowbase+q0+wid*QBLK)*DM+h*D; const long opitch=PART?D:DM;
  { bf16*stg=(bf16*)(shm+LDS_OST)+wid*2048;
    #pragma unroll
    for(int r=0;r<16;++r){const int orow=crow(r,hi);
      #pragma unroll
      for(int d0=0;d0<2;++d0)stg[orow*64+d0*32+r32]=__float2bfloat16(o[d0][r]*rli[r]);}
    asm volatile("s_waitcnt lgkmcnt(0)":::"memory");
    #pragma unroll
    for(int i=0;i<4;++i){const int row=i*8+(lane>>3),ch=lane&7; const u32x4 v=*(const u32x4*)(stg+row*64+ch*8); ATTN_STORE16(Ow+(long)row*opitch+ch*8,v);} }
  asm volatile("s_waitcnt lgkmcnt(0)\n\ts_barrier":::"memory");
  #undef DMA_K
  #undef DMA_V
  #undef START
  #undef RESC
  #undef ROT
  #undef PT
  #undef MKLD
  #undef SETNEG
}
constexpr int ATTN_LDS_BYTES=LDS_BYTES;
#undef SBAR
#undef WAIT_BAR
}

constexpr int NWAVES = 8, NTHR = 512;
constexpr int BATCH = 2, SEQ = 8192, D = 1024, T = BATCH * SEQ;
constexpr int SSMW = 512, NG = 32, GP = 16, NS = 64;
constexpr int NH = 8, HD = 64, AW = 512, TOPK = 256;
constexpr int NE = 32, FF = 1024;
constexpr int IN_W = 4680, IN_WP = 4864;
constexpr int CH = 64, NCH = SEQ / CH;
constexpr float LN_EPS = 1e-5f;
constexpr float ALPHA = 1.189207115002721f;
constexpr float LOG2E = 1.4426950408889634f;
constexpr int MOE_ROWS = T * 4 + NE * 256;
constexpr int MOE_TILES = MOE_ROWS / 256;

constexpr size_t MiB = 1u << 20;
constexpr size_t WS_CTL = 0, CTL_ZERO_BYTES = 1 * MiB;
constexpr size_t WS_WIN = 2 * MiB;
constexpr size_t WS_WGLU = 12 * MiB;
constexpr size_t WS_WAP = 14 * MiB;
constexpr size_t WS_WO = 15 * MiB;
constexpr size_t WS_WUP = 18 * MiB;
constexpr size_t WS_WDN = 146 * MiB;
constexpr size_t WS_XN = 210 * MiB;
constexpr size_t WS_H = 242 * MiB;
constexpr size_t WS_U = 306 * MiB;
constexpr size_t WS_Q = 322 * MiB, WS_K = 338 * MiB, WS_V = 354 * MiB, WS_QI = 370 * MiB;
constexpr size_t WS_KI = 386 * MiB;
constexpr size_t WS_WI = 388 * MiB;
constexpr size_t WS_G = 390 * MiB;
constexpr size_t WS_YG = 454 * MiB;
constexpr size_t WS_O = 470 * MiB;
constexpr size_t WS_Z = 486 * MiB;
constexpr size_t WS_MIX = 518 * MiB;
constexpr size_t WS_S5 = 582 * MiB;
constexpr size_t WS_RT = 592 * MiB;
constexpr size_t WS_XG = 596 * MiB;
constexpr size_t WS_HH = 740 * MiB;
constexpr size_t WS_MASK = 884 * MiB;
constexpr size_t WS_WRF = 900 * MiB;
constexpr size_t WS_S5T = 902 * MiB, S5T_STRIDE = 589824;
constexpr size_t WS_S5A = 920 * MiB;
constexpr size_t WS_S5E = 921 * MiB;
constexpr size_t WS_BASE = 922 * MiB;
constexpr size_t WS_END = 923 * MiB;
constexpr int CW_CNT = 64;
constexpr int CW_CUR = 128;
constexpr int CW_KMAX = 256;
constexpr int CW_ATTQ = 512;
constexpr int CW_GLUQ = 1280;
constexpr int CW_CVQ = 1344;
constexpr int CW_CVU = 1408;
constexpr int CW_BAR = 4096;

constexpr int RING_BYTES = 131072;
constexpr int MISC_OFF = RING_BYTES;
constexpr int LDS_BYTES = 147456;

#define GAS __attribute__((address_space(1)))
#define LAS __attribute__((address_space(3)))
typedef unsigned short bf16;
typedef unsigned v4u __attribute__((ext_vector_type(4)));
typedef unsigned v2u __attribute__((ext_vector_type(2)));
typedef float f32x4 __attribute__((ext_vector_type(4)));
typedef short bf16x8 __attribute__((ext_vector_type(8)));
#define LDS_WAIT() asm volatile("s_waitcnt lgkmcnt(0)" ::: "memory")
#define VM_WAIT() asm volatile("s_waitcnt vmcnt(0)" ::: "memory")
__device__ __forceinline__ unsigned pk2(float lo, float hi) { return pg8::cvt_pk_bf16(lo, hi); }
__device__ __forceinline__ unsigned f2bf(float f) { return pg8::cvt_pk_bf16(f, 0.f) & 0xffffu; }
__device__ __forceinline__ float bf2f(unsigned short h) { return __builtin_bit_cast(float, (unsigned)h << 16); }
__device__ __forceinline__ float bflo(unsigned w) { return __builtin_bit_cast(float, w << 16); }
__device__ __forceinline__ float bfhi(unsigned w) { return __builtin_bit_cast(float, w & 0xffff0000u); }
__device__ __forceinline__ float sigmoidf_(float x) { return __builtin_amdgcn_rcpf(1.0f + __builtin_amdgcn_exp2f(-1.4426950408889634f * x)); }
__device__ __forceinline__ float wave_sum(float v) {
#pragma unroll
    for (int o = 1; o < 64; o <<= 1) v += __shfl_xor(v, o);
    return v;
}
__device__ __forceinline__ float wave_max(float v) {
#pragma unroll
    for (int o = 1; o < 64; o <<= 1) v = fmaxf(v, __shfl_xor(v, o));
    return v;
}


typedef GAS unsigned gu32;
#define XB_TMO      128
#define XB_XCNT(j)  (256  + 64 * (j))
#define XB_XSUB(j)  (1280 + 64 * (j))
#define XB_XGEN(j)  (2304 + 64 * (j))
#define XB_TOP      3328
#define XB_TOPGEN   3392
#define XCD_BAR_WORDS 3456
#define XB_SPIN_CAP (1u << 22)
__device__ __forceinline__ unsigned xb_ld(unsigned* p)              { return __hip_atomic_load(p, __ATOMIC_RELAXED, __HIP_MEMORY_SCOPE_AGENT); }
__device__ __forceinline__ unsigned xb_add(unsigned* p, unsigned v) { return __hip_atomic_fetch_add(p, v, __ATOMIC_RELAXED, __HIP_MEMORY_SCOPE_AGENT); }
__device__ __forceinline__ unsigned xb_xcc_id() { return (unsigned)__builtin_amdgcn_s_getreg((3 << 11) | 20) & 0xFu; }
#define XB_SPIN(cond, bar) do { unsigned _sp = 0; while (cond) { __builtin_amdgcn_s_sleep(1); \
    if ((++_sp & 255u) == 0u) { if (xb_ld(&(bar)[XB_TMO])) break; if (_sp > XB_SPIN_CAP) { atomicAdd(&(bar)[XB_TMO], 1u); break; } } } } while (0)
struct XcdBarrier { unsigned* bar; unsigned x; volatile LAS unsigned* st; };
__device__ __forceinline__ XcdBarrier xcd_barrier_post(unsigned* bar, volatile LAS unsigned* st) {
    XcdBarrier b; b.bar = bar; b.x = xb_xcc_id(); b.st = st;
    if (threadIdx.x == 0) (void)xb_add(&bar[XB_XCNT(b.x)], 1u);
    return b;
}
__device__ __forceinline__ void xcd_barrier_complete(unsigned* bar, unsigned x, unsigned& nloc, unsigned& nx) {
    const unsigned G = gridDim.x * gridDim.y * gridDim.z;
    unsigned sum, cnt, mine, sp = 0u;
    for (;;) {
        sum = 0u; cnt = 0u; mine = 0u;
#pragma unroll
        for (unsigned j = 0; j < 16; ++j) { const unsigned c = xb_ld(&bar[XB_XCNT(j)]); sum += c; cnt += (c > 0u) ? 1u : 0u; mine = (j == x) ? c : mine; }
        if (sum == G) break;
        __builtin_amdgcn_s_sleep(1);
        if ((++sp & 255u) == 0u) { if (xb_ld(&bar[XB_TMO])) break; if (sp > XB_SPIN_CAP) { atomicAdd(&bar[XB_TMO], 1u); break; } }
    }
    nloc = mine > 0u ? mine : 1u; nx = cnt > 0u ? cnt : 1u;
}
__device__ __forceinline__ void xcd_barrier(const XcdBarrier& b) {
    asm volatile("s_waitcnt vmcnt(0)" ::: "memory");
    __syncthreads();
    if (threadIdx.x == 0) {
        unsigned* bar = b.bar;
        __builtin_amdgcn_s_waitcnt(0);
        unsigned nloc = b.st[0], nx = b.st[1];
        if (nloc == 0u) { xcd_barrier_complete(bar, b.x, nloc, nx); b.st[0] = nloc; b.st[1] = nx; }
        const unsigned old = xb_add(&bar[XB_XSUB(b.x)], 1u);
        const unsigned gen = old / nloc;
        if (old + 1u == (gen + 1u) * nloc) {
            __builtin_amdgcn_fence(__ATOMIC_RELEASE, "agent");
            asm volatile("s_waitcnt vmcnt(0)" ::: "memory");
            const unsigned og = xb_add(&bar[XB_TOP], 1u);
            const unsigned tg = og / nx;
            if (og + 1u == (tg + 1u) * nx) xb_add(&bar[XB_TOPGEN], 1u);
            else XB_SPIN(xb_ld(&bar[XB_TOPGEN]) == tg, bar);
            __builtin_amdgcn_fence(__ATOMIC_ACQUIRE, "agent");
            xb_add(&bar[XB_XGEN(b.x)], 1u);
            asm volatile("s_waitcnt vmcnt(0)" ::: "memory");
        } else {
            XB_SPIN(xb_ld(&bar[XB_XGEN(b.x)]) == gen, bar);
            __builtin_amdgcn_fence(__ATOMIC_ACQUIRE, "agent");
            asm volatile("s_waitcnt vmcnt(0)" ::: "memory");
        }
    }
    __syncthreads();
}

struct Args { const float* in[26]; float* out; unsigned char* ws; int ph_lo, ph_hi; };
struct Frame {
    LAS unsigned char* lds;
    int tid, lane, wave, vcu, G;
    unsigned char* ws;
};

__device__ __forceinline__ int colmap(int kind, int np, int halfn) {
    if (kind == 0) return np;
    if (kind == 1) { if (np < 2560) return np; if (np < 4608) return np + 72; if (np < 4680) return np - 2048; return -1; }
    const int j = np >> 8, c = np & 255; return c < 128 ? 128 * j + c : halfn + 128 * j + (c - 128);
}
__device__ __forceinline__ void p0_transpose_item(const float* W, int K, int Nsrc, int Ndst, int kind, bf16* WT, LAS float* scr, int item, int lane) {
    const int nblk = Ndst / 64, kb = item / nblk, nb = item % nblk, k0 = 64 * kb, n0 = 64 * nb;
    const int n4 = (lane & 15) * 4, col = colmap(kind, n0 + n4, Nsrc / 2);
    f32x4 vv[16];
#pragma unroll
    for (int i = 0; i < 16; ++i) { const int kk = 4 * i + (lane >> 4);
        vv[i] = col >= 0 ? __builtin_nontemporal_load((const f32x4*)(W + (size_t)(k0 + kk) * Nsrc + col)) : (f32x4){0.f, 0.f, 0.f, 0.f}; }
#pragma unroll
    for (int i = 0; i < 16; ++i) { const int kk = 4 * i + (lane >> 4); const f32x4 v = vv[i];
        LAS float* d = scr + kk * 65 + n4; d[0] = v[0]; d[1] = v[1]; d[2] = v[2]; d[3] = v[3]; }
    LDS_WAIT(); asm volatile("" ::: "memory");
    const int c = lane & 7;
#pragma unroll
    for (int j = 0; j < 8; ++j) { const int n = (lane >> 3) + 8 * j; const LAS float* sp = scr + (8 * c) * 65 + n;
        v4u o; o.x = pk2(sp[0 * 65], sp[1 * 65]); o.y = pk2(sp[2 * 65], sp[3 * 65]); o.z = pk2(sp[4 * 65], sp[5 * 65]); o.w = pk2(sp[6 * 65], sp[7 * 65]);
        *(GAS v4u*)(WT + (size_t)(n0 + n) * K + k0 + 8 * c) = o; }
    LDS_WAIT(); asm volatile("" ::: "memory");
}
__device__ __forceinline__ void ln_row(int lane, const float* arow, float ascale, const float* addrow, const float* g, const float* b, float* of32, bf16* obf, f32x4 (&v)[4], const bf16* arow_bf = nullptr, const bf16* add_bf = nullptr) {
    const GAS f32x4* xr = (const GAS f32x4*)arow + lane; float s = 0.f;
#pragma unroll
    for (int j = 0; j < 4; ++j) { if (arow_bf) { const v2u w = ((const GAS v2u*)arow_bf + lane)[64 * j]; v[j] = (f32x4){bflo(w.x), bfhi(w.x), bflo(w.y), bfhi(w.y)} * ascale; } else v[j] = xr[64 * j] * ascale; if (addrow) v[j] += ((const GAS f32x4*)addrow + lane)[64 * j];
        if (add_bf) { const v2u w2 = ((const GAS v2u*)add_bf + lane)[64 * j]; v[j] += (f32x4){bflo(w2.x), bfhi(w2.x), bflo(w2.y), bfhi(w2.y)}; } s += (v[j].x + v[j].y) + (v[j].z + v[j].w); }
    const float mean = wave_sum(s) * (1.f / D); float s2 = 0.f;
#pragma unroll
    for (int j = 0; j < 4; ++j) { v[j] = v[j] - mean; s2 += (v[j].x * v[j].x + v[j].y * v[j].y) + (v[j].z * v[j].z + v[j].w * v[j].w); }
    const float rstd = 1.f / sqrtf(wave_sum(s2) * (1.f / D) + LN_EPS);
#pragma unroll
    for (int j = 0; j < 4; ++j) { const f32x4 gg = ((const GAS f32x4*)g + lane)[64 * j], bb = ((const GAS f32x4*)b + lane)[64 * j]; v[j] = v[j] * rstd * gg + bb;
        if (of32) ((GAS f32x4*)of32 + lane)[64 * j] = v[j];
        if (obf) ((GAS v2u*)obf + lane)[64 * j] = (v2u){pk2(v[j].x, v[j].y), pk2(v[j].z, v[j].w)}; }
}
__device__ __forceinline__ void ln0_rows4(int lane, const float* x, size_t m0, size_t mstride, const float* g, const float* b, bf16* XN) {
    f32x4 v[4][4];
#pragma unroll
    for (int r = 0; r < 4; ++r)
#pragma unroll
        for (int j = 0; j < 4; ++j) v[r][j] = __builtin_nontemporal_load((const f32x4*)(x + (m0 + r * mstride) * D) + lane + 64 * j);
    f32x4 gg[4], bb[4];
#pragma unroll
    for (int j = 0; j < 4; ++j) { gg[j] = ((const GAS f32x4*)g + lane)[64 * j]; bb[j] = ((const GAS f32x4*)b + lane)[64 * j]; }
    float s[4], q[4];
#pragma unroll
    for (int r = 0; r < 4; ++r) { s[r] = 0.f;
#pragma unroll
        for (int j = 0; j < 4; ++j) s[r] += (v[r][j].x + v[r][j].y) + (v[r][j].z + v[r][j].w); }
#pragma unroll
    for (int o = 1; o < 64; o <<= 1)
#pragma unroll
        for (int r = 0; r < 4; ++r) s[r] += __shfl_xor(s[r], o);
#pragma unroll
    for (int r = 0; r < 4; ++r) { const float mean = s[r] * (1.f / D); q[r] = 0.f;
#pragma unroll
        for (int j = 0; j < 4; ++j) { v[r][j] = v[r][j] - mean; q[r] += (v[r][j].x * v[r][j].x + v[r][j].y * v[r][j].y) + (v[r][j].z * v[r][j].z + v[r][j].w * v[r][j].w); } }
#pragma unroll
    for (int o = 1; o < 64; o <<= 1)
#pragma unroll
        for (int r = 0; r < 4; ++r) q[r] += __shfl_xor(q[r], o);
#pragma unroll
    for (int r = 0; r < 4; ++r) { const float rstd = 1.f / sqrtf(q[r] * (1.f / D) + LN_EPS);
#pragma unroll
        for (int j = 0; j < 4; ++j) { const f32x4 y = v[r][j] * rstd * gg[j] + bb[j];
            ((GAS v2u*)(XN + (m0 + r * mstride) * D) + lane)[64 * j] = (v2u){pk2(y.x, y.y), pk2(y.z, y.w)}; } }
}
__device__ __forceinline__ void s5_tables(Frame& F, const Args& a, int g, int part);
__device__ __forceinline__ void p0_prologue(Frame& F, const Args& a) {
    LAS float* scr = (LAS float*)(F.lds + F.wave * 16640);
    const int gw = F.vcu * NWAVES + F.wave, NGW = F.G * NWAVES;
    constexpr int I_IN = (D / 64) * (IN_WP / 64), I_GLU = (SSMW / 64) * (2048 / 64), I_AP = (AW / 64) * (D / 64), I_O = (D / 64) * (D / 64);
    constexpr int NITEMS = I_IN + I_GLU + I_AP + I_O;
    for (int u = F.vcu; u < NG * 8; u += F.G) s5_tables(F, a, u >> 3, u & 7);
    for (int it = gw; it < NITEMS; it += NGW) {
        int r = it;
        if (r < I_IN) { p0_transpose_item(a.in[3], D, IN_W, IN_WP, 1, (bf16*)(F.ws + WS_WIN), scr, r, F.lane); continue; } r -= I_IN;
        if (r < I_GLU) { p0_transpose_item(a.in[13], SSMW, 2048, 2048, 2, (bf16*)(F.ws + WS_WGLU), scr, r, F.lane); continue; } r -= I_GLU;
        if (r < I_AP) { p0_transpose_item(a.in[14], AW, D, D, 0, (bf16*)(F.ws + WS_WAP), scr, r, F.lane); continue; } r -= I_AP;
        p0_transpose_item(a.in[15], D, D, D, 0, (bf16*)(F.ws + WS_WO), scr, r, F.lane);
    }
    for (int i = gw * 64 + F.lane; i < 128 * 64; i += NGW * 64) { const int t = i >> 6, l = i & 63; const float* wr = a.in[18] + (size_t)(8 * t + 4 * (l >> 5)) * NE + (l & 31);
        ((f32x4*)(F.ws + WS_WRF))[i] = (f32x4){wr[0], wr[NE], wr[2 * NE], wr[3 * NE]}; }
    for (int m = gw; m + 3 * NGW < T; m += 4 * NGW) ln0_rows4(F.lane, a.in[0], (size_t)m, (size_t)NGW, a.in[1], a.in[2], (bf16*)(F.ws + WS_XN));
}

using pg8::Unit; using pg8::HALF; using pg8::BM;
__device__ __forceinline__ v4u pack8(const f32x4 a, const f32x4 b) { v4u w; w.x = pg8::cvt_pk_bf16(a[0], a[1]); w.y = pg8::cvt_pk_bf16(a[2], a[3]); w.z = pg8::cvt_pk_bf16(b[0], b[1]); w.w = pg8::cvt_pk_bf16(b[2], b[3]); return w; }
struct EpiIn {
    static constexpr bool PERM = true;
    unsigned char* ws; const float* b_gate;
    __device__ __forceinline__ void operator()(const f32x4 (&acc)[2][2][4][2], const Unit& u, int wr, int wc, int fr, int fq) const {
        const int row0 = u.pm * BM + wr * 64 + fr, pn = u.pn;
        if (pn < 10) {
            const int t = pn >> 1; bf16* base = (bf16*)(ws + WS_U + (size_t)t * 16 * MiB); const float sc = (t == 1) ? 0.125f * LOG2E : 1.f;
            const int col0 = (pn & 1) * 256 + wc * 32 + 8 * fq;
#pragma unroll
            for (int ai = 0; ai < 2; ++ai)
#pragma unroll
                for (int m = 0; m < 4; ++m) { bf16* rowp = base + (size_t)(row0 + ai * HALF + m * 16) * 512 + col0;
#pragma unroll
                    for (int bj = 0; bj < 2; ++bj) *(v4u*)(rowp + bj * HALF) = pack8(acc[ai][bj][m][0] * sc, acc[ai][bj][m][1] * sc); }
        } else if (pn < 18) {
            bf16* base = (bf16*)(ws + WS_G); const int col0 = (pn - 10) * 256 + wc * 32 + 8 * fq;
            f32x4 bv[2][2];
#pragma unroll
            for (int bj = 0; bj < 2; ++bj)
#pragma unroll
                for (int n = 0; n < 2; ++n) bv[bj][n] = *(const f32x4*)(b_gate + col0 + bj * HALF + 4 * n) * (-LOG2E);
#pragma unroll
            for (int ai = 0; ai < 2; ++ai)
#pragma unroll
                for (int m = 0; m < 4; ++m) { bf16* rowp = base + (size_t)(row0 + ai * HALF + m * 16) * 2048 + col0;
#pragma unroll
                    for (int bj = 0; bj < 2; ++bj) { f32x4 v0, v1;
#pragma unroll
                        for (int i = 0; i < 4; ++i) { v0[i] = __builtin_amdgcn_rcpf(1.0f + __builtin_amdgcn_exp2f(__builtin_fmaf(acc[ai][bj][m][0][i], -LOG2E, bv[bj][0][i])));
                                                      v1[i] = __builtin_amdgcn_rcpf(1.0f + __builtin_amdgcn_exp2f(__builtin_fmaf(acc[ai][bj][m][1][i], -LOG2E, bv[bj][1][i]))); }
                        *(v4u*)(rowp + bj * HALF) = pack8(v0, v1); } }
        } else {
            if (wc < 2) {
                bf16* base = (bf16*)(ws + WS_KI); const int col0 = wc * 32 + 8 * fq;
#pragma unroll
                for (int ai = 0; ai < 2; ++ai)
#pragma unroll
                    for (int m = 0; m < 4; ++m) *(v4u*)(base + (size_t)(row0 + ai * HALF + m * 16) * 64 + col0) = pack8(acc[ai][0][m][0], acc[ai][0][m][1]);
            } else if (wc == 2 && fq == 0) {
                float* base = (float*)(ws + WS_WI);
#pragma unroll
                for (int ai = 0; ai < 2; ++ai)
#pragma unroll
                    for (int m = 0; m < 4; ++m) { float* p = base + (size_t)(row0 + ai * HALF + m * 16) * 8; *(f32x4*)p = acc[ai][0][m][0]; *(f32x4*)(p + 4) = acc[ai][0][m][1]; }
            }
        }
    }
};
struct EpiGlu {
    static constexpr bool PERM = true;
    unsigned char* ws;
    __device__ __forceinline__ void operator()(const f32x4 (&acc)[2][2][4][2], const Unit& u, int wr, int wc, int fr, int fq) const {
        const int row0 = u.pm * BM + wr * 64 + fr, col0 = u.pn * 128 + wc * 32 + 8 * fq;
        const bf16* G = (const bf16*)(ws + WS_G); bf16* Z = (bf16*)(ws + WS_Z);
#pragma unroll
        for (int ai = 0; ai < 2; ++ai)
#pragma unroll
            for (int m = 0; m < 4; ++m) { const size_t r = (size_t)(row0 + ai * HALF + m * 16);
                const v4u gw = *(const v4u*)(G + r * 2048 + col0);
                const float gs[8] = {bflo(gw.x), bfhi(gw.x), bflo(gw.y), bfhi(gw.y), bflo(gw.z), bfhi(gw.z), bflo(gw.w), bfhi(gw.w)};
                f32x4 o0, o1;
#pragma unroll
                for (int i = 0; i < 4; ++i) { o0[i] = gs[i] * acc[ai][0][m][0][i] * sigmoidf_(acc[ai][1][m][0][i]); o1[i] = gs[4 + i] * acc[ai][0][m][1][i] * sigmoidf_(acc[ai][1][m][1][i]); }
                *(v4u*)(Z + r * 1024 + col0) = pack8(o0, o1); }
    }
};
struct EpiAtt {
    static constexpr bool PERM = true;
    unsigned char* ws;
    __device__ __forceinline__ void operator()(const f32x4 (&acc)[2][2][4][2], const Unit& u, int wr, int wc, int fr, int fq) const {
        const int row0 = u.pm * BM + wr * 64 + fr, col0 = u.pn * 256 + wc * 32 + 8 * fq;
        const bf16* G = (const bf16*)(ws + WS_G); bf16* Z = (bf16*)(ws + WS_Z);
#pragma unroll
        for (int ai = 0; ai < 2; ++ai)
#pragma unroll
            for (int m = 0; m < 4; ++m) { const size_t r = (size_t)(row0 + ai * HALF + m * 16);
#pragma unroll
                for (int bj = 0; bj < 2; ++bj) { const int c = col0 + bj * HALF;
                    const v4u gw = *(const v4u*)(G + r * 2048 + 1024 + c); const v4u zw = *(const v4u*)(Z + r * 1024 + c);
                    const float gs[8] = {bflo(gw.x), bfhi(gw.x), bflo(gw.y), bfhi(gw.y), bflo(gw.z), bfhi(gw.z), bflo(gw.w), bfhi(gw.w)};
                    const float zs[8] = {bflo(zw.x), bfhi(zw.x), bflo(zw.y), bfhi(zw.y), bflo(zw.z), bfhi(zw.z), bflo(zw.w), bfhi(zw.w)};
                    f32x4 o0, o1;
#pragma unroll
                    for (int i = 0; i < 4; ++i) { o0[i] = zs[i] + gs[i] * acc[ai][bj][m][0][i]; o1[i] = zs[4 + i] + gs[4 + i] * acc[ai][bj][m][1][i]; }
                    *(v4u*)(Z + r * 1024 + c) = pack8(o0, o1); } }
    }
};
struct EpiF32 {
    static constexpr bool PERM = false;
    float* C; int ldc;
    __device__ __forceinline__ void operator()(const f32x4 (&acc)[2][2][4][2], const Unit& u, int wr, int wc, int fr, int fq) const {
        const int row0 = u.pm * BM + wr * 64 + fr, col0 = u.pn * BM + wc * 32 + 4 * fq;
#pragma unroll
        for (int ai = 0; ai < 2; ++ai)
#pragma unroll
            for (int m = 0; m < 4; ++m) { float* rowp = C + (size_t)(row0 + ai * HALF + m * 16) * ldc + col0;
#pragma unroll
                for (int bj = 0; bj < 2; ++bj)
#pragma unroll
                    for (int n = 0; n < 2; ++n) *(f32x4*)(rowp + bj * HALF + n * 16) = acc[ai][bj][m][n]; }
    }
};
struct EpiMix {
    static constexpr bool PERM = true;
    bf16* C;
    __device__ __forceinline__ void operator()(const f32x4 (&acc)[2][2][4][2], const Unit& u, int wr, int wc, int fr, int fq) const {
        const int row0 = u.pm * BM + wr * 64 + fr, col0 = u.pn * BM + wc * 32 + 8 * fq;
#pragma unroll
        for (int ai = 0; ai < 2; ++ai)
#pragma unroll
            for (int m = 0; m < 4; ++m) { bf16* rowp = C + (size_t)(row0 + ai * HALF + m * 16) * D + col0;
#pragma unroll
                for (int bj = 0; bj < 2; ++bj) *(v4u*)(rowp + bj * HALF) = pack8(acc[ai][bj][m][0], acc[ai][bj][m][1]); }
    }
};
struct EpiSwiglu {
    static constexpr bool PERM = true;
    unsigned char* ws; const float* b_up;
    __device__ __forceinline__ void operator()(const f32x4 (&acc)[2][2][4][2], const Unit& u, int wr, int wc, int fr, int fq) const {
        const int row0 = u.pm * BM + wr * 64 + fr, cl = wc * 32 + 8 * fq, col0 = u.pn * 128 + cl;
        const float* bg = b_up + (size_t)u.e * 2048 + u.pn * 128 + cl; const float* bl = bg + 1024;
        bf16* HHp = (bf16*)(ws + WS_HH);
        f32x4 bgv[2], blv[2];
#pragma unroll
        for (int n = 0; n < 2; ++n) { bgv[n] = *(const f32x4*)(bg + 4 * n); blv[n] = *(const f32x4*)(bl + 4 * n) + 1.0f; }
#pragma unroll
        for (int ai = 0; ai < 2; ++ai)
#pragma unroll
            for (int m = 0; m < 4; ++m) { const size_t r = (size_t)(row0 + ai * HALF + m * 16);
                f32x4 o[2];
#pragma unroll
                for (int n = 0; n < 2; ++n)
#pragma unroll
                    for (int i = 0; i < 4; ++i) { float hg = acc[ai][0][m][n][i] + bgv[n][i], hl = acc[ai][1][m][n][i] + blv[n][i];
                        hg = fminf(hg, 7.0f); hl = __builtin_amdgcn_fmed3f(hl, -6.0f, 8.0f);
                        o[n][i] = hl * (hg * __builtin_amdgcn_rcpf(1.0f + __builtin_amdgcn_exp2f(hg * (-1.702f * 1.4426950408889634f)))); }
                *(v4u*)(HHp + r * 1024 + col0) = pack8(o[0], o[1]); }
    }
};
struct EpiDown {
    static constexpr bool PERM = true;
    unsigned char* ws; const float* b_down; const float* row_gate;
    __device__ __forceinline__ void operator()(const f32x4 (&acc)[2][2][4][2], const Unit& u, int wr, int wc, int fr, int fq) const {
        const int row0 = u.pm * BM + wr * 64 + fr, col0 = u.pn * 256 + wc * 32 + 8 * fq;
        const float* bd = b_down + (size_t)u.e * 1024 + col0; bf16* Y = (bf16*)(ws + WS_XG);
        f32x4 bv[2][2];
#pragma unroll
        for (int bj = 0; bj < 2; ++bj)
#pragma unroll
            for (int n = 0; n < 2; ++n) bv[bj][n] = *(const f32x4*)(bd + bj * HALF + 4 * n);
#pragma unroll
        for (int ai = 0; ai < 2; ++ai)
#pragma unroll
            for (int m = 0; m < 4; ++m) { const size_t r = (size_t)(row0 + ai * HALF + m * 16); const float gt = row_gate[r];
#pragma unroll
                for (int bj = 0; bj < 2; ++bj) *(v4u*)(Y + r * 1024 + col0 + bj * HALF) = pack8((acc[ai][bj][m][0] + bv[bj][0]) * gt, (acc[ai][bj][m][1] + bv[bj][1]) * gt); }
    }
};

struct S5Lane { float ar, ai; float br[GP], bi[GP]; };
__device__ __forceinline__ void s5_lane_setup(const Args& a, int g, int n, S5Lane& L) {
    const float lr = a.in[5][g * NS + n], li = a.in[6][g * NS + n], dt = expf(a.in[7][g]);
    const float er = expf(lr * dt); L.ar = er * cosf(li * dt); L.ai = er * sinf(li * dt);
    const float nr = L.ar - 1.f, ni = L.ai, den = lr * lr + li * li; const float fr_ = (nr * lr + ni * li) / den, fi_ = (ni * lr - nr * li) / den;
#pragma unroll
    for (int p = 0; p < GP; ++p) { const float b_r = a.in[8][(g * NS + n) * GP + p], b_i = a.in[9][(g * NS + n) * GP + p]; L.br[p] = fr_ * b_r - fi_ * b_i; L.bi[p] = fr_ * b_i + fi_ * b_r; }
}
__device__ __forceinline__ float gelu_tanh(float x) { const float t = 0.7978845608028654f * (x + 0.044715f * x * x * x); const float e = __builtin_amdgcn_exp2f(2.885390081777927f * t); return x * (1.f - __builtin_amdgcn_rcpf(e + 1.f)); }
__device__ __forceinline__ void s5_tables(Frame& F, const Args& a, int g, int part) {
    typedef float f32x2 __attribute__((ext_vector_type(2)));
    LAS f32x2* pwr = (LAS f32x2*)F.lds;
    LAS f32x2* bbl = (LAS f32x2*)(F.lds + 33280);
    LAS f32x2* ccl = (LAS f32x2*)(F.lds + 33280 + 8192);
    const int tid = F.tid;
    __syncthreads();
    if (tid < 64) { S5Lane L; s5_lane_setup(a, g, tid, L);
#pragma unroll
        for (int p = 0; p < GP; ++p) bbl[tid * GP + p] = (f32x2){L.br[p], L.bi[p]};
        float pr = 1.f, pi = 0.f;
        for (int m = 0; m <= 64; ++m) { pwr[m * 64 + tid] = (f32x2){pr, pi}; const float nr = pr * L.ar - pi * L.ai, ni = pr * L.ai + pi * L.ar; pr = nr; pi = ni; }
        if (part == 0) { const f32x2 a64 = pwr[64 * 64 + tid]; float qr = a64.x, qi = a64.y;
            ((f32x2*)(F.ws + WS_S5A))[g * 64 + tid] = a64;
#pragma unroll
            for (int k = 0; k < 5; ++k) { const float nr = qr * qr - qi * qi, ni = 2.f * qr * qi; qr = nr; qi = ni; }
            ((f32x2*)(F.ws + WS_S5A + 16384))[g * 64 + tid] = (f32x2){qr, qi}; } }
    for (int e = tid; e < GP * NS; e += NTHR) ccl[e] = (f32x2){a.in[10][(size_t)g * GP * NS + e], a.in[11][(size_t)g * GP * NS + e]};
    __syncthreads();
    unsigned char* base = F.ws + WS_S5T + (size_t)g * S5T_STRIDE;
    for (int e = part * 2048 + tid; e < (part + 1) * 2048; e += NTHR) {
        const int lane = e & 63, jp = (e >> 6) & 63, rt = e >> 12, r = lane & 31, h = lane >> 5, n = (32 * rt + r) & 63, ri = rt >> 1;
        const f32x2 pw = pwr[(63 - jp) * 64 + n]; float v[8];
#pragma unroll
        for (int jj = 0; jj < 8; ++jj) { const f32x2 b = bbl[n * GP + 8 * h + jj]; v[jj] = ri == 0 ? pw.x * b.x - pw.y * b.y : pw.x * b.y + pw.y * b.x; }
        ((v4u*)base)[e] = (v4u){pk2(v[0], v[1]), pk2(v[2], v[3]), pk2(v[4], v[5]), pk2(v[6], v[7])}; }
    for (int e = part * 2048 + tid; e < (part + 1) * 2048; e += NTHR) {
        const int lane = e & 63, ks = (e >> 6) & 7, i = e >> 9, r = lane & 31, h = lane >> 5, lp = 2 * i + (r >> 4), pp = r & 15; float v[8];
#pragma unroll
        for (int jj = 0; jj < 8; ++jj) { const int comp = 16 * ks + 8 * h + jj, ri = comp >> 6, n = comp & 63;
            const f32x2 c = ccl[pp * NS + n]; const f32x2 pw = pwr[(lp + 1) * 64 + n];
            v[jj] = ri == 0 ? c.x * pw.x - c.y * pw.y : -(c.x * pw.y + c.y * pw.x); }
        ((v4u*)(base + 262144))[e] = (v4u){pk2(v[0], v[1]), pk2(v[2], v[3]), pk2(v[4], v[5]), pk2(v[6], v[7])}; }
    for (int e = part * 2080 + tid; e < (part + 1) * 2080; e += NTHR) {
        const int blk = e >> 8, po = (e >> 4) & 15, pi = e & 15; float acc = 0.f;
        if (blk > 0) { const int m = blk - 1;
            for (int n = 0; n < NS; ++n) { const f32x2 c = ccl[po * NS + n], pw = pwr[m * 64 + n], b = bbl[n * GP + pi];
                const float tr = pw.x * b.x - pw.y * b.y, ti = pw.x * b.y + pw.y * b.x; acc += c.x * tr - c.y * ti; }
            if (m == 0 && po == pi) acc += a.in[12][g * GP + po]; }
        ((bf16*)(base + 524288))[e] = (bf16)f2bf(acc); }
    __syncthreads();
}
namespace s5 {
using bf16x8 = __attribute__((ext_vector_type(8))) short;
using f32x16 = __attribute__((ext_vector_type(16))) float;
typedef float f32x2 __attribute__((ext_vector_type(2)));
constexpr int CSTR = 2064;
constexpr int U_OFF = 0, KF_OFF = 32 * CSTR, SLOC_OFF = KF_OFF + 33280, TMP_OFF = SLOC_OFF + 128 * 33 * 4;
__device__ __forceinline__ int crow(int r, int hi) { return (r & 3) + 8 * (r >> 2) + 4 * hi; }
__device__ __forceinline__ void phase_a(Frame& F) {
    const int v = F.vcu, b = v >> 7, g = (v >> 2) & 31, seg = v & 3, tid = F.tid, lane = F.lane, wave = F.wave;
    LAS unsigned char* lds = F.lds; const unsigned char* tb = F.ws + WS_S5T + (size_t)g * S5T_STRIDE;
    const bf16* U = (const bf16*)(F.ws + WS_U) + ((size_t)b * SEQ + (size_t)seg * 2048) * SSMW + g * GP;
#pragma unroll
    for (int i = 0; i < 8; ++i) { const int pc = tid + NTHR * i, tk = pc >> 1, hf = pc & 1;
        *(LAS v4u*)(lds + U_OFF + (tk >> 6) * CSTR + (tk & 63) * 32 + hf * 16) = *(const v4u*)(U + (size_t)tk * SSMW + hf * 8); }
    for (int pc = tid; pc < 2080; pc += NTHR) *(LAS v4u*)(lds + KF_OFF + pc * 16) = ((const v4u*)(tb + 524288))[pc];
    bf16x8 wa[32];
    { const bf16x8* wsf = (const bf16x8*)tb + (size_t)((wave & 3) * 64 + (wave >> 2) * 32) * 64 + lane;
#pragma unroll
      for (int jj = 0; jj < 32; ++jj) wa[jj] = wsf[jj * 64]; }
    __syncthreads();
    { const int rt = wave & 3, kh = wave >> 2; f32x16 acc = {};
      const LAS unsigned char* ub = lds + U_OFF + (lane & 31) * CSTR + (lane >> 5) * 16 + kh * 32 * 32;
#pragma unroll
      for (int jj = 0; jj < 32; ++jj) acc = __builtin_amdgcn_mfma_f32_32x32x16_bf16(wa[jj], *(const LAS bf16x8*)(ub + jj * 32), acc, 0, 0, 0);
      LAS float* tmp = (LAS float*)(lds + TMP_OFF); LAS float* sloc = (LAS float*)(lds + SLOC_OFF);
      if (kh == 1) {
#pragma unroll
          for (int r = 0; r < 16; ++r) tmp[(rt * 16 + r) * 64 + lane] = acc[r]; }
      __syncthreads();
      if (kh == 0) {
#pragma unroll
          for (int r = 0; r < 16; ++r) sloc[(32 * rt + crow(r, lane >> 5)) * 33 + (lane & 31)] = acc[r] + tmp[(rt * 16 + r) * 64 + lane]; }
      __syncthreads(); }
    if (tid < 64) { const f32x2 a64 = ((const f32x2*)(F.ws + WS_S5A))[g * 64 + tid]; const LAS float* sloc = (const LAS float*)(lds + SLOC_OFF); float zr = 0.f, zi = 0.f;
        for (int c = 0; c < 32; ++c) { const float lr = sloc[tid * 33 + c], li = sloc[(64 + tid) * 33 + c]; const float nr = a64.x * zr - a64.y * zi + lr, ni = a64.x * zi + a64.y * zr + li; zr = nr; zi = ni; }
        ((f32x2*)(F.ws + WS_S5E))[(size_t)v * 64 + tid] = (f32x2){zr, zi}; }
}
__device__ __forceinline__ void phase_b(Frame& F) {
    const int v = F.vcu, b = v >> 7, g = (v >> 2) & 31, seg = v & 3, tid = F.tid, lane = F.lane, wave = F.wave;
    LAS unsigned char* lds = F.lds; const unsigned char* tb = F.ws + WS_S5T + (size_t)g * S5T_STRIDE;
    bf16x8 wy[4][8];
    { const bf16x8* wyf0 = (const bf16x8*)(tb + 262144) + lane;
#pragma unroll
      for (int q = 0; q < 4; ++q) { const int i = q == 0 ? wave : q == 1 ? 15 - wave : q == 2 ? 16 + wave : 31 - wave;
#pragma unroll
          for (int ks = 0; ks < 8; ++ks) wy[q][ks] = wyf0[(size_t)(i * 8 + ks) * 64]; } }
    if (tid < 64) { const f32x2 a64 = ((const f32x2*)(F.ws + WS_S5A))[g * 64 + tid], aS = ((const f32x2*)(F.ws + WS_S5A + 16384))[g * 64 + tid];
        const LAS float* sloc = (const LAS float*)(lds + SLOC_OFF); LAS bf16* sinb = (LAS bf16*)(lds + TMP_OFF);
        float sr = 0.f, si = 0.f;
        for (int j = 0; j < seg; ++j) { const f32x2 e = ((const f32x2*)(F.ws + WS_S5E))[(size_t)(v - seg + j) * 64 + tid]; const float nr = aS.x * sr - aS.y * si + e.x, ni = aS.x * si + aS.y * sr + e.y; sr = nr; si = ni; }
        const int n = tid, ore = (((n >> 4) * 64 + ((n >> 3) & 1) * 32) * 8) + (n & 7), oim = ore + 4 * 64 * 8;
        for (int c = 0; c < 32; ++c) { sinb[ore + c * 8] = (bf16)f2bf(sr); sinb[oim + c * 8] = (bf16)f2bf(si);
            const float lr = sloc[n * 33 + c], li = sloc[(64 + n) * 33 + c]; const float nr = a64.x * sr - a64.y * si + lr, ni = a64.x * si + a64.y * sr + li; sr = nr; si = ni; } }
    __syncthreads();
    const int r32 = lane & 31, h = lane >> 5;
    const LAS unsigned char* ub = lds + U_OFF + r32 * CSTR + h * 16; const LAS unsigned char* kfb = lds + KF_OFF + r32 * 32 + h * 16; const LAS bf16x8* sb = (const LAS bf16x8*)(lds + TMP_OFF) + lane;
    bf16* YG = (bf16*)(F.ws + WS_YG) + ((size_t)b * SEQ + (size_t)seg * 2048 + (size_t)r32 * 64) * SSMW + g * GP + 4 * h;
#pragma unroll
    for (int q = 0; q < 4; ++q) { const int i = q == 0 ? wave : q == 1 ? 15 - wave : q == 2 ? 16 + wave : 31 - wave;
        f32x16 acc = {};
#pragma unroll
        for (int ks = 0; ks < 8; ++ks) acc = __builtin_amdgcn_mfma_f32_32x32x16_bf16(wy[q][ks], sb[ks * 64], acc, 0, 0, 0);
        const int nj = 2 * i + 2;
#pragma unroll 2
        for (int j = 0; j < nj; ++j) acc = __builtin_amdgcn_mfma_f32_32x32x16_bf16(*(const LAS bf16x8*)(kfb + (2 * i - j + 1) * 512), *(const LAS bf16x8*)(ub + j * 32), acc, 0, 0, 0);
#pragma unroll
        for (int k = 0; k < 4; ++k) { const int tok = 2 * i + (k >> 1), pc = (k & 1) * 8;
            const float o0 = gelu_tanh(acc[4 * k]), o1 = gelu_tanh(acc[4 * k + 1]), o2 = gelu_tanh(acc[4 * k + 2]), o3 = gelu_tanh(acc[4 * k + 3]);
            *(v2u*)(YG + (size_t)tok * SSMW + pc) = (v2u){pk2(o0, o1), pk2(o2, o3)}; } }
    __syncthreads();
}
}

namespace idx {
using bf16x8 = __attribute__((ext_vector_type(8))) short;
using f32x16 = __attribute__((ext_vector_type(16))) float;
constexpr int CAPT = 16, CAPQ = 96, CREF = 64;
constexpr int QF_OFF = 65536, CTOT_OFF = 131072, PFX_OFF = CTOT_OFF + 2048, NEED_OFF = PFX_OFF + 128, OFLAG_OFF = NEED_OFF + 128, RFLAG_OFF = OFLAG_OFF + 4;
__device__ __forceinline__ unsigned key32(float x) { const unsigned u = __builtin_bit_cast(unsigned, x); return u ^ ((unsigned)((int)u >> 31) | 0x80000000u); }
__device__ __forceinline__ int crow(int r, int hi) { return (r & 3) + 8 * (r >> 2) + 4 * hi; }
__device__ __forceinline__ void load_k(bf16x8 (&kf)[4], const unsigned short* KI, size_t row, int hi) {
#pragma unroll
    for (int ks = 0; ks < 4; ++ks) kf[ks] = *(const bf16x8*)(KI + row * 64 + ks * 16 + hi * 8);
}
__device__ __forceinline__ void score_tile(float (&sc)[16], const bf16x8 (&kf)[4], const LAS unsigned char* qfl  , const float (&wh)[8]) {
    bf16x8 fq[3][4]; f32x16 aclin, ac[2];
#pragma unroll
    for (int st = 0; st <= 10; ++st) {
        if (st <= 8) { const int li = st == 0 ? 8 : st - 1;
#pragma unroll
            for (int ks = 0; ks < 4; ++ks) fq[st % 3][ks] = *(const LAS bf16x8*)(qfl + (li * 4 + ks) * 1024); }
        if (st >= 1 && st <= 9) { const int it = st - 1; f32x16 a = {};
#pragma unroll
            for (int ks = 0; ks < 4; ++ks) a = __builtin_amdgcn_mfma_f32_32x32x16_bf16(kf[ks], fq[it % 3][ks], a, 0, 0, 0);
            if (it == 0) aclin = a; else ac[it & 1] = a; }
        if (st >= 3) { const int it = st - 2;
#pragma unroll
            for (int r = 0; r < 16; ++r) { sc[r] = __builtin_fmaf(wh[it - 1], __builtin_fabsf(ac[it & 1][r]), it == 1 ? aclin[r] : sc[r]); asm volatile("" : "+v"(sc[r])); } }
        __builtin_amdgcn_sched_barrier(0);
    }
}
template <int PASS, bool DIAG> __device__ __forceinline__ void hist_tile(const float (&sc)[16], unsigned hbase  , unsigned pfx, int q, int hi) {
    constexpr int SH = PASS == 0 ? 22 : PASS == 1 ? 11 : 0, SHP = PASS == 1 ? 22 : 11;
#pragma unroll
    for (int r = 0; r < 16; ++r) { const unsigned u = key32(sc[r]);
        bool ok = !DIAG || crow(r, hi) <= q; if (PASS > 0) ok = ok && ((u >> SHP) == pfx);
        if (PASS == 0) { if (ok) { const unsigned ad = hbase + ((u >> 23) << 7); const unsigned val = ((u >> 22) & 1u) * 0xffffu + 1u;
                                   __hip_atomic_fetch_add((LAS unsigned*)(uintptr_t)ad, val, __ATOMIC_RELAXED, __HIP_MEMORY_SCOPE_WORKGROUP); } }
        else if (__any(ok)) { if (ok) { const unsigned bin = (u >> SH) & 2047u; const unsigned ad = hbase + ((bin >> 1) << 7); const unsigned val = (bin & 1u) * 0xffffu + 1u;
                                   __hip_atomic_fetch_add((LAS unsigned*)(uintptr_t)ad, val, __ATOMIC_RELAXED, __HIP_MEMORY_SCOPE_WORKGROUP); } } }
}
__device__ __forceinline__ float lin_x(float s, float aq) { return __builtin_fmaf(s, aq, __builtin_amdgcn_fmed3f(__builtin_fmaf(s, aq * 16.0f, 512.0f), 384.0f, 640.0f)); }
__device__ __forceinline__ unsigned lin_bin(float s, float aq) { return (unsigned)__builtin_amdgcn_fmed3f(lin_x(s, aq), 0.0f, 1023.0f); }
__device__ __forceinline__ unsigned sub_bin(float s, float aq, unsigned bn) { return (unsigned)__builtin_amdgcn_fmed3f((lin_x(s, aq) - (float)bn) * 2048.0f, 0.0f, 2047.0f); }
template <bool REF> __device__ __forceinline__ unsigned cls_id(float s, float aq) { const unsigned bn = lin_bin(s, aq); if constexpr (REF) return (bn << 11) | sub_bin(s, aq, bn); else return bn; }
template <bool DIAG> __device__ __forceinline__ void hist_tile_sub(const float (&sc)[16], unsigned hbase, unsigned pfx, float aq, int q, int hi) {
#pragma unroll
    for (int r = 0; r < 16; ++r) { const unsigned bn = lin_bin(sc[r], aq); const bool ok = (!DIAG || crow(r, hi) <= q) && bn == pfx;
        if (__any(ok)) { if (ok) { const unsigned sb = sub_bin(sc[r], aq, bn); const unsigned ad = hbase + ((sb >> 1) << 7); const unsigned val = (sb & 1u) * 0xffffu + 1u;
            __hip_atomic_fetch_add((LAS unsigned*)(uintptr_t)ad, val, __ATOMIC_RELAXED, __HIP_MEMORY_SCOPE_WORKGROUP); } } }
}
template <bool DIAG> __device__ __forceinline__ void hist_tile_lin(const float (&sc)[16], unsigned hbase, float aq, int q, int hi) {
#pragma unroll
    for (int r = 0; r < 16; ++r) { const unsigned bn = lin_bin(sc[r], aq);
        if (!DIAG || crow(r, hi) <= q) { const unsigned ad = hbase + ((bn >> 1) << 7); const unsigned val = (bn & 1u) * 0xffffu + 1u;
            __hip_atomic_fetch_add((LAS unsigned*)(uintptr_t)ad, val, __ATOMIC_RELAXED, __HIP_MEMORY_SCOPE_WORKGROUP); } }
}
template <int PASS> __device__ __forceinline__ void scan_hist(LAS unsigned char* lds, int tid, int lane, int wave) {
    constexpr int NB = PASS == 0 ? 1024 : 2048, NBITS = PASS == 0 ? 10 : 11, NCH = NB / 128;
    LAS unsigned* hist = (LAS unsigned*)lds; LAS unsigned* ctot = (LAS unsigned*)(lds + CTOT_OFF); LAS unsigned* PFX = (LAS unsigned*)(lds + PFX_OFF); LAS unsigned* NEED = (LAS unsigned*)(lds + NEED_OFF);
    { const int q = lane & 31, c = 2 * wave + (lane >> 5);
      if (c < NCH) { unsigned tot = 0u;
#pragma unroll 8
          for (int i = 0; i < 64; ++i) { const unsigned d = hist[(c * 64 + i) * 32 + q]; tot += (d & 0xffffu) + (d >> 16); }
          ctot[c * 32 + q] = tot; }
      __syncthreads(); }
    if (tid < 32) { const int q = tid; const unsigned need = PASS == 0 ? (unsigned)TOPK : NEED[q]; unsigned cum = 0u; int cs = 0; bool found = false;
#pragma unroll
        for (int c = NCH - 1; c >= 0; --c) { const unsigned t = ctot[c * 32 + q]; if (!found) { if (cum + t >= need) { found = true; cs = c; } else cum += t; } }
        int bin = 0; unsigned rem = 1u, pop = 0u; bool f2 = false;
        for (int i = 63; i >= 0; --i) { const unsigned d = hist[(cs * 64 + i) * 32 + q]; const unsigned hi16 = d >> 16, lo16 = d & 0xffffu;
            if (!f2) { if (cum + hi16 >= need) { f2 = true; bin = (cs * 64 + i) * 2 + 1; rem = need - cum; pop = hi16; } else cum += hi16; }
            if (!f2) { if (cum + lo16 >= need) { f2 = true; bin = (cs * 64 + i) * 2; rem = need - cum; pop = lo16; } else cum += lo16; } }
        const unsigned pf = PASS == 0 ? 0u : PFX[q];
        PFX[q] = (pf << NBITS) | (unsigned)bin; NEED[q] = rem;
        if (PASS == 0 && pop > (unsigned)CREF) *(LAS unsigned*)(lds + RFLAG_OFF) = 1u; }
    __syncthreads();
}
__device__ __forceinline__ void zero_hist(LAS unsigned char* lds, int tid, int n16  ) {
    const f32x4 z = {0.f, 0.f, 0.f, 0.f};
    for (int i = 0; i < n16; ++i) *(LAS f32x4*)(lds + (size_t)(i * NTHR + tid) * 16) = z;
    __syncthreads();
}
__device__ __forceinline__ void pass0(LAS unsigned char* lds, const unsigned short* KI, float* SC, size_t krow0, int qgb, const float (&wh)[8], float aq, int tid, int lane, int wave) {
    const int q = lane & 31, hi = lane >> 5;
    zero_hist(lds, tid, 8);
    const LAS unsigned char* qfl = lds + QF_OFF + lane * 16; const unsigned hbase = (unsigned)(uintptr_t)lds + 4u * (unsigned)q;
    bf16x8 kf[4], kn[4];
    if (wave <= qgb) load_k(kf, KI, krow0 + (size_t)wave * 32 + q, hi);
    for (int kt32 = wave; kt32 <= qgb; kt32 += 8) {
        const int ktn = kt32 + 8 <= qgb ? kt32 + 8 : kt32;
        load_k(kn, KI, krow0 + (size_t)ktn * 32 + q, hi);
        float sc[16]; score_tile(sc, kf, qfl, wh);
        float* st = SC + (size_t)kt32 * 1024 + lane;
#pragma unroll
        for (int r = 0; r < 16; ++r) __builtin_nontemporal_store(sc[r], st + r * 64);
        if (kt32 == qgb) hist_tile_lin<true>(sc, hbase, aq, q, hi); else hist_tile_lin<false>(sc, hbase, aq, q, hi);
#pragma unroll
        for (int ks = 0; ks < 4; ++ks) kf[ks] = kn[ks];
    }
    __syncthreads();
    scan_hist<0>(lds, tid, lane, wave);
}
__device__ __forceinline__ void load_sc(float (&sc)[16], const float* SC, int kt32, int lane) {
    const float* st = SC + (size_t)kt32 * 1024 + lane;
#pragma unroll
    for (int r = 0; r < 16; ++r) sc[r] = __builtin_nontemporal_load(st + r * 64);
}
template <int PASS> __device__ __forceinline__ void stream_pass(LAS unsigned char* lds, const float* SC, int qgb, int tid, int lane, int wave) {
    const int q = lane & 31, hi = lane >> 5;
    zero_hist(lds, tid, 16);
    const unsigned pfx = ((LAS unsigned*)(lds + PFX_OFF))[q]; const unsigned hbase = (unsigned)(uintptr_t)lds + 4u * (unsigned)q;
    float sc[16], sn[16];
    if (wave <= qgb) load_sc(sc, SC, wave, lane);
    for (int kt32 = wave; kt32 <= qgb; kt32 += 8) {
        const int ktn = kt32 + 8 <= qgb ? kt32 + 8 : kt32;
        load_sc(sn, SC, ktn, lane);
        if (kt32 == qgb) hist_tile<PASS, true>(sc, hbase, pfx, q, hi); else hist_tile<PASS, false>(sc, hbase, pfx, q, hi);
#pragma unroll
        for (int r = 0; r < 16; ++r) sc[r] = sn[r];
    }
    __syncthreads();
    scan_hist<PASS>(lds, tid, lane, wave);
}
__device__ __forceinline__ void refine_pass(LAS unsigned char* lds, const float* SC, int qgb, float aq, int tid, int lane, int wave) {
    const int q = lane & 31, hi = lane >> 5;
    zero_hist(lds, tid, 16);
    const unsigned pfx = ((LAS unsigned*)(lds + PFX_OFF))[q]; const unsigned hbase = (unsigned)(uintptr_t)lds + 4u * (unsigned)q;
    float sc[16], sn[16];
    if (wave <= qgb) load_sc(sc, SC, wave, lane);
    for (int kt32 = wave; kt32 <= qgb; kt32 += 8) {
        const int ktn = kt32 + 8 <= qgb ? kt32 + 8 : kt32;
        load_sc(sn, SC, ktn, lane);
        if (kt32 == qgb) hist_tile_sub<true>(sc, hbase, pfx, aq, q, hi); else hist_tile_sub<false>(sc, hbase, pfx, aq, q, hi);
#pragma unroll
        for (int r = 0; r < 16; ++r) sc[r] = sn[r];
    }
    __syncthreads();
    scan_hist<1>(lds, tid, lane, wave);
}
template <bool REF> __device__ __forceinline__ void fused_last(LAS unsigned char* lds, unsigned char* ws, const float* SC, unsigned* MK, int b, int qgb, int nout, float aq, int tid, int lane, int wave) {
    const int q = lane & 31, hi = lane >> 5;
    LAS unsigned* cu = (LAS unsigned*)lds; LAS unsigned* cp = cu + NTHR * CAPT; LAS unsigned* pcnt = cp + NTHR * CAPT; LAS unsigned* Lu = pcnt + NTHR; LAS unsigned* Lp = Lu + 32 * CAPQ;
    LAS unsigned* oflag = (LAS unsigned*)(lds + OFLAG_OFF);
    const unsigned pfx = ((LAS unsigned*)(lds + PFX_OFF))[q]; unsigned pc = 0u;
    float sa[16], sb[16], na[16], nb[16]; unsigned word = 0u;
    auto tile = [&](const float (&sc)[16], int kt64, int p) { const int kt32 = 2 * kt64 + p;
        if (kt32 <= qgb) {
#pragma unroll
            for (int r = 0; r < 16; ++r) { const bool causal = kt32 < qgb || crow(r, hi) <= q; const unsigned cls = cls_id<REF>(sc[r], aq);
                word |= ((causal && cls >= pfx) ? 1u : 0u) << (16 * p + r);
                if (causal && cls == pfx) { if (pc < (unsigned)CAPT) { cu[pc * NTHR + tid] = key32(sc[r]); cp[pc * NTHR + tid] = ((unsigned)kt64 << 6) | ((unsigned)hi << 5) | (unsigned)(16 * p + r); } ++pc; } } } };
    auto clampt = [&](int kt32) { return kt32 <= qgb ? kt32 : qgb; };
    if (wave < nout) { load_sc(sa, SC, clampt(2 * wave), lane); load_sc(sb, SC, clampt(2 * wave + 1), lane); }
    for (int kt64 = wave; kt64 < nout; kt64 += 8) { const int kn = kt64 + 8 < nout ? kt64 + 8 : kt64;
        load_sc(na, SC, clampt(2 * kn), lane); load_sc(nb, SC, clampt(2 * kn + 1), lane);
        word = 0u; tile(sa, kt64, 0); tile(sb, kt64, 1);
        MK[(size_t)kt64 * 64] = word;
#pragma unroll
        for (int r = 0; r < 16; ++r) { sa[r] = na[r]; sb[r] = nb[r]; } }
    pcnt[tid] = pc;
    asm volatile("s_waitcnt vmcnt(0)" ::: "memory");
    __syncthreads();
    const int sl = 2 * wave + hi; unsigned cq = 0u, off = 0u;
#pragma unroll
    for (int s2 = 0; s2 < 16; ++s2) { const unsigned cn = pcnt[(s2 >> 1) * 64 + (s2 & 1) * 32 + q]; cq += cn; off += s2 < sl ? cn : 0u; }
    if (pc > (unsigned)CAPT || cq > (unsigned)CAPQ) oflag[0] = 1u;
    else for (unsigned i = 0; i < pc; ++i) { Lu[q * CAPQ + off + i] = cu[i * NTHR + tid]; Lp[q * CAPQ + off + i] = cp[i * NTHR + tid]; }
    __syncthreads();
    const unsigned need = ((LAS unsigned*)(lds + NEED_OFF))[q];
    if (oflag[0] == 0u && cq > need && (unsigned)sl < cq) { unsigned um[CAPQ / 16], rk[CAPQ / 16];
#pragma unroll
        for (int k = 0; k < CAPQ / 16; ++k) { const unsigned i = (unsigned)(sl + 16 * k); um[k] = i < cq ? Lu[q * CAPQ + i] : 0xffffffffu; rk[k] = 0u; }
#pragma unroll 4
        for (unsigned j = 0; j < cq; ++j) { const unsigned v = Lu[q * CAPQ + j];
#pragma unroll
            for (int k = 0; k < CAPQ / 16; ++k) rk[k] += v > um[k] ? 1u : 0u; }
        unsigned* mkq = (unsigned*)(ws + WS_MASK) + (((size_t)b * 256 + (size_t)qgb) * 128) * 64 + q;
#pragma unroll
        for (int k = 0; k < CAPQ / 16; ++k) { const unsigned i = (unsigned)(sl + 16 * k);
            if (i < cq && rk[k] >= need) { const unsigned ps = Lp[q * CAPQ + i]; atomicAnd(mkq + (size_t)(ps >> 6) * 64 + ((ps >> 5) & 1u) * 32, ~(1u << (ps & 31u))); } } }
    asm volatile("s_waitcnt vmcnt(0)" ::: "memory");
    __syncthreads();
}
__device__ __forceinline__ void unit(LAS unsigned char* lds, unsigned char* ws, int b, int qgb, int tid, int lane, int wave) {
    const unsigned short* QI = (const unsigned short*)(ws + WS_QI); const unsigned short* KI = (const unsigned short*)(ws + WS_KI); const float* WI = (const float*)(ws + WS_WI);
    unsigned* MK = (unsigned*)(ws + WS_MASK) + (((size_t)b * 256 + (size_t)qgb) * 128) * 64 + lane;
    float* SC = (float*)(ws + WS_XG) + ((size_t)b * 32896 + (size_t)(qgb * (qgb + 1) / 2)) * 1024;
    const int q = lane & 31, hi = lane >> 5; const size_t qrow = (size_t)b * SEQ + (size_t)qgb * 32 + q, krow0 = (size_t)b * SEQ;
    const int nout = 4 * (qgb >> 3) + 4;
    if (qgb < 8) {
        for (int kt64 = wave; kt64 < nout; kt64 += 8) { unsigned word = 0u;
#pragma unroll
            for (int p = 0; p < 2; ++p) { const int kt32 = 2 * kt64 + p;
#pragma unroll
                for (int r = 0; r < 16; ++r) { const bool s = kt32 < qgb || (kt32 == qgb && crow(r, hi) <= q); word |= (s ? 1u : 0u) << (16 * p + r); } }
            MK[(size_t)kt64 * 64] = word; }
        return;
    }
    float wh[8];
#pragma unroll
    for (int h = 0; h < 8; ++h) wh[h] = WI[qrow * 8 + h] * (0.5f * 0.04419417382415922f);
#pragma unroll
    for (int ks = 0; ks < 4; ++ks) *(LAS bf16x8*)(lds + QF_OFF + (wave * 4 + ks) * 1024 + lane * 16) = *(const bf16x8*)(QI + qrow * 512 + wave * 64 + ks * 16 + hi * 8);
    __syncthreads();
    if (tid < 256) { const int ks = tid >> 6; float lin[8] = {0.f, 0.f, 0.f, 0.f, 0.f, 0.f, 0.f, 0.f};
#pragma unroll
        for (int h = 0; h < 8; ++h) { const bf16x8 f = *(const LAS bf16x8*)(lds + QF_OFF + (h * 4 + ks) * 1024 + lane * 16);
#pragma unroll
            for (int j = 0; j < 8; ++j) lin[j] = __builtin_fmaf(wh[h], bf2f((unsigned short)f[j]), lin[j]); }
        *(LAS v4u*)(lds + QF_OFF + (32 + ks) * 1024 + lane * 16) = (v4u){pk2(lin[0], lin[1]), pk2(lin[2], lin[3]), pk2(lin[4], lin[5]), pk2(lin[6], lin[7])}; }
    if (tid == 0) { *(LAS unsigned*)(lds + OFLAG_OFF) = 0u; *(LAS unsigned*)(lds + RFLAG_OFF) = 0u; }
    float aq; { float wn = 0.f;
#pragma unroll
        for (int h = 0; h < 8; ++h) wn = __builtin_fmaf(wh[h], wh[h], wn);
        aq = wn > 1e-30f ? 8.0f * __builtin_amdgcn_rsqf(wn) : 0.0f; }
    pass0(lds, KI, SC, krow0, qgb, wh, aq, tid, lane, wave);
    if (*(LAS unsigned*)(lds + RFLAG_OFF) != 0u) { refine_pass(lds, SC, qgb, aq, tid, lane, wave); fused_last<true>(lds, ws, SC, MK, b, qgb, nout, aq, tid, lane, wave); }
    else fused_last<false>(lds, ws, SC, MK, b, qgb, nout, aq, tid, lane, wave);
    { LAS unsigned* oflag = (LAS unsigned*)(lds + OFLAG_OFF);
      if (oflag[0] != 0u) {
          stream_pass<0>(lds, SC, qgb, tid, lane, wave);
          stream_pass<1>(lds, SC, qgb, tid, lane, wave);
          stream_pass<2>(lds, SC, qgb, tid, lane, wave);
          const unsigned thr = ((LAS unsigned*)(lds + PFX_OFF))[q];
          for (int kt64 = wave; kt64 < nout; kt64 += 8) { unsigned word = 0u;
#pragma unroll
              for (int p = 0; p < 2; ++p) { const int kt32 = 2 * kt64 + p;
                  if (kt32 <= qgb) { float sc[16]; load_sc(sc, SC, kt32, lane);
#pragma unroll
                      for (int r = 0; r < 16; ++r) { const bool sel = (kt32 < qgb || crow(r, hi) <= q) && key32(sc[r]) >= thr; word |= (sel ? 1u : 0u) << (16 * p + r); } } }
              MK[(size_t)kt64 * 64] = word; } } }
    __syncthreads();
}
}
__device__ __forceinline__ void indexer_phase(Frame& F) {
    for (int v = F.vcu; v < 256; v += F.G) {
        idx::unit(F.lds, F.ws, 0, v, F.tid, F.lane, F.wave);
        idx::unit(F.lds, F.ws, 1, 255 - v, F.tid, F.lane, F.wave);
    }
}
__device__ __forceinline__ void kmax_phase(Frame& F) {
    LAS float* red = (LAS float*)(F.lds + MISC_OFF + 3072);
    for (int v = F.vcu; v < 256; v += F.G) { const int bh = v >> 4, part = v & 15;
        const bf16* kr = (const bf16*)(F.ws + WS_K) + ((size_t)(bh >> 3) * SEQ + (size_t)part * 512 + F.tid) * 512 + (bh & 7) * 64; float ss = 0.f;
#pragma unroll
        for (int c = 0; c < 8; ++c) { const v4u w = *(const v4u*)(kr + 8 * c); const float x[8] = {bflo(w.x), bfhi(w.x), bflo(w.y), bfhi(w.y), bflo(w.z), bfhi(w.z), bflo(w.w), bfhi(w.w)};
#pragma unroll
            for (int i = 0; i < 8; ++i) ss = __builtin_fmaf(x[i], x[i], ss); }
        ss = wave_max(ss);
        __syncthreads();
        if (F.lane == 0) red[F.wave] = ss;
        __syncthreads();
        if (F.tid == 0) { float m = red[0];
#pragma unroll
            for (int w = 1; w < 8; ++w) m = fmaxf(m, red[w]);
            atomicMax((unsigned*)(F.ws + WS_CTL) + CW_KMAX + bh, __builtin_bit_cast(unsigned, m)); } }
}
constexpr size_t WS_OPART = WS_XG;
constexpr size_t WS_LSE = WS_XG + 64 * MiB;
__device__ __forceinline__ void attn_item(int i, int pr, int& h, int& qb, int& toff, int& ntp, bool& part) {
    const int hs = i / 48, r = i % 48; h = pr == 0 ? 7 : pr == 1 ? 6 : pr == 2 ? (hs == 0 ? 5 : 3) : (hs == 0 ? 4 : 3 - hs);
    if (r < 32) { qb = 31 - (r >> 1); part = true; if ((r & 1) == 0) { toff = 0; ntp = 64; } else { toff = 64; ntp = 4 * (qb + 1) - 64; } }
    else { qb = 47 - r; part = false; toff = 0; ntp = 4 * (qb + 1); }
}
__device__ __forceinline__ int attn_cost(int i, int pr) {
    int h, qb, toff, ntp; bool part; attn_item(i, pr, h, qb, toff, ntp, part);
    const int cap = h == 7 ? 128 : h == 6 ? 116 : h == 5 ? 62 : h == 4 ? 36 : h == 3 ? 22 : h == 2 ? 16 : h == 1 ? 12 : 10;
    const int lim = 4 * (qb + 1) < cap ? 4 * (qb + 1) : cap, c = lim - toff;
    return c <= 0 ? 0 : (c > ntp ? ntp : c);
}
__device__ __forceinline__ bool conv_up_tickets(Frame& F, const float* wup, int n) {
    volatile LAS int* qs = (volatile LAS int*)(F.lds + MISC_OFF + 3072); LAS float* scr = (LAS float*)(F.lds + F.wave * 16640);
    for (int k = 0; k < n; ++k) {
        __syncthreads();
        if (F.tid == 0) qs[2] = (int)atomicAdd((unsigned*)(F.ws + WS_CTL) + CW_CVU, 1u);
        __syncthreads();
        const int u = qs[2];
        if (u >= NE * 512 / NWAVES) return false;
        const int item = u * NWAVES + F.wave, e = item >> 9;
        p0_transpose_item(wup + (size_t)e * D * 2048, D, 2048, 2048, 2, (bf16*)(F.ws + WS_WUP) + (size_t)e * 2048 * D, scr, item & 511, F.lane);
    }
    return true;
}
__device__ __forceinline__ void attn_phase(Frame& F, unsigned char* lds_generic, const float* wup) {
    volatile LAS int* qs = (volatile LAS int*)(F.lds + MISC_OFF + 3072); volatile LAS int* ord = qs + 16;
    const float* kmx = (const float*)((unsigned*)(F.ws + WS_CTL) + CW_KMAX);
    __syncthreads();
    const int NI = ((F.vcu >> 5) & 3) < 2 ? 48 : ((F.vcu >> 5) & 3) == 2 ? 96 : 192;
    if (F.tid == 0) { qs[0] = NI; qs[1] = -1; }
    __syncthreads();
    for (;;) {
        const int u = qs[0]; int st = qs[1];
        __syncthreads();
        if (u >= NI) {
            ++st; if (st >= 1) break;
            const int y = (((F.vcu >> 5) & 7) + st) & 7, pr = y & 3;
            { volatile LAS int* cst = ord + 192;
              if (F.tid < NI) cst[F.tid] = attn_cost(F.tid, pr);
              __syncthreads();
              if (F.tid < NI) { const int c = cst[F.tid]; int rank = 0;
                  for (int j = 0; j < NI; ++j) { const int cj = cst[j]; rank += (cj > c || (cj == c && j < F.tid)) ? 1 : 0; }
                  ord[rank] = F.tid; } }
            if (F.tid == 0) { qs[0] = (int)atomicAdd((unsigned*)(F.ws + WS_CTL) + CW_ATTQ + 64 * y, 1u); qs[1] = st; }
            __syncthreads();
            continue; }
        const int y = (((F.vcu >> 5) & 7) + st) & 7, b = y >> 2;
        int nxt = 0; if (F.tid == 0) nxt = (int)atomicAdd((unsigned*)(F.ws + WS_CTL) + CW_ATTQ + 64 * y, 1u);
        int h, qb, toff, ntp; bool part; attn_item(ord[u], y & 3, h, qb, toff, ntp, part);
        const size_t piece = ((size_t)((b * 8 + h) * 32 + qb)) * 2 + (toff ? 1 : 0);
        attn_body::attn_unit<8>(b, h, qb, toff, ntp, part, (const attn_body::bf16*)(F.ws + WS_Q), (const attn_body::bf16*)(F.ws + WS_K), (const attn_body::bf16*)(F.ws + WS_V),
                                (attn_body::bf16*)(F.ws + WS_O), (attn_body::bf16*)(F.ws + WS_OPART) + piece * 256 * 64, (float*)(F.ws + WS_LSE) + piece * 256,
                                (const unsigned*)(F.ws + WS_MASK), kmx[b * 8 + h], (char*)lds_generic);
        if (F.tid == 0) qs[0] = nxt;
        __syncthreads();
    }
    for (;;) {
        if (F.tid == 0) qs[0] = (int)atomicAdd((unsigned*)(F.ws + WS_CTL) + CW_GLUQ, 1u);
        __syncthreads();
        const int u = qs[0];
        __syncthreads();
        if (u >= 512) break;
        pg8::Gemm g{(const bf16*)(F.ws + WS_YG), (const bf16*)(F.ws + WS_WGLU), T, 2048, SSMW}; pg8::OneUnit S{{u >> 3, u & 7, u & 7, 0}, true};
        EpiGlu E{F.ws}; pg8::gemm_phase<EpiGlu, pg8::OneUnit, false, true>(F.lds, g, S, E);
        (void)conv_up_tickets(F, wup, 4);
    }
    while (conv_up_tickets(F, wup, 4)) {}
}
__device__ __forceinline__ void attn_merge(Frame& F) {
    const int gt = F.vcu * NTHR + F.tid, NGT = F.G * NTHR;
    const bf16* OPp = (const bf16*)(F.ws + WS_OPART); const float* LS = (const float*)(F.ws + WS_LSE); bf16* O = (bf16*)(F.ws + WS_O);
    constexpr int NIT = 16 * 16 * 256 * 8;
    for (int i0 = gt; i0 < NIT; i0 += 4 * NGT) {
        float l0[4], l1[4]; size_t p0[4]; int row[4], ch[4], qb[4], bh[4];
#pragma unroll
        for (int k = 0; k < 4; ++k) { const int i = i0 + k * NGT < NIT ? i0 + k * NGT : i0;
            ch[k] = i & 7; row[k] = (i >> 3) & 255; qb[k] = 16 + ((i >> 11) & 15); bh[k] = i >> 15; p0[k] = ((size_t)(bh[k] * 32 + qb[k])) * 2;
            l0[k] = LS[p0[k] * 256 + row[k]]; l1[k] = LS[(p0[k] + 1) * 256 + row[k]]; }
        v4u a[4], c[4]; float f0[4], f1[4];
#pragma unroll
        for (int k = 0; k < 4; ++k) { const float mx = fmaxf(l0[k], l1[k]), w0 = exp2f(l0[k] - mx), w1 = exp2f(l1[k] - mx), inv = 1.f / (w0 + w1); f0[k] = w0 * inv; f1[k] = w1 * inv;
            a[k] = (v4u){0u, 0u, 0u, 0u}; c[k] = (v4u){0u, 0u, 0u, 0u};
            if (w0 > 0.f) a[k] = *(const v4u*)(OPp + (p0[k] * 256 + row[k]) * 64 + ch[k] * 8);
            if (w1 > 0.f) c[k] = *(const v4u*)(OPp + ((p0[k] + 1) * 256 + row[k]) * 64 + ch[k] * 8); }
#pragma unroll
        for (int k = 0; k < 4; ++k) if (i0 + k * NGT < NIT) { v4u o;
            o.x = pk2(f0[k] * bflo(a[k].x) + f1[k] * bflo(c[k].x), f0[k] * bfhi(a[k].x) + f1[k] * bfhi(c[k].x)); o.y = pk2(f0[k] * bflo(a[k].y) + f1[k] * bflo(c[k].y), f0[k] * bfhi(a[k].y) + f1[k] * bfhi(c[k].y));
            o.z = pk2(f0[k] * bflo(a[k].z) + f1[k] * bflo(c[k].z), f0[k] * bfhi(a[k].z) + f1[k] * bfhi(c[k].z)); o.w = pk2(f0[k] * bflo(a[k].w) + f1[k] * bflo(c[k].w), f0[k] * bfhi(a[k].w) + f1[k] * bfhi(c[k].w));
            *(v4u*)(O + ((size_t)(bh[k] >> 3) * SEQ + (size_t)qb[k] * 256 + row[k]) * 512 + (bh[k] & 7) * 64 + ch[k] * 8) = o; }
    }
}

__device__ __forceinline__ void ln1_router(Frame& F, const Args& a) {
    typedef float f32x16 __attribute__((ext_vector_type(16)));
    constexpr int RS = 1028;
    LAS float* tile = (LAS float*)F.lds; LAS float* part = (LAS float*)F.lds; LAS float* lg = (LAS float*)(F.lds + 32768);
    const int lane = F.lane, wave = F.wave, tid = F.tid;
    float* H = (float*)(F.ws + WS_H); const float* MIX = (const float*)(F.ws + WS_MIX); bf16* XN = (bf16*)(F.ws + WS_XN);
    int* top_e = (int*)(F.ws + WS_RT); float* top_g = (float*)(F.ws + WS_RT + 256 * 1024);
    unsigned* cnt = (unsigned*)(F.ws + WS_CTL) + CW_CNT;
    const f32x4* WRF = (const f32x4*)(F.ws + WS_WRF); const float* br = a.in[19];
    LAS unsigned* lcnt = (LAS unsigned*)(F.lds + 132096);
    int* lrank = (int*)(F.ws + WS_RT + 512 * 1024);
    if (tid < NE) lcnt[tid] = 0u;
    __syncthreads();
    f32x4 wrf[16];
#pragma unroll
    for (int tt = 0; tt < 16; ++tt) wrf[tt] = WRF[(16 * wave + tt) * 64 + lane];
    for (int grp = F.vcu; grp < T / 32; grp += F.G) {
        {
          f32x4 v[4][4]; const size_t m0 = (size_t)grp * 32 + 4 * wave;
#pragma unroll
          for (int i = 0; i < 4; ++i)
#pragma unroll
              for (int j = 0; j < 4; ++j) { const v2u hw = ((const GAS v2u*)(XN + (m0 + i) * D) + lane)[64 * j], mw = ((const GAS v2u*)((const bf16*)MIX + (m0 + i) * D) + lane)[64 * j];
                  v[i][j] = (f32x4){bflo(hw.x), bfhi(hw.x), bflo(hw.y), bfhi(hw.y)} * ALPHA + (f32x4){bflo(mw.x), bfhi(mw.x), bflo(mw.y), bfhi(mw.y)}; }
          f32x4 gg[4], bb[4];
#pragma unroll
          for (int j = 0; j < 4; ++j) { gg[j] = ((const GAS f32x4*)a.in[16] + lane)[64 * j]; bb[j] = ((const GAS f32x4*)a.in[17] + lane)[64 * j]; }
          float sm[4], sq[4];
#pragma unroll
          for (int i = 0; i < 4; ++i) { sm[i] = 0.f;
#pragma unroll
              for (int j = 0; j < 4; ++j) sm[i] += (v[i][j].x + v[i][j].y) + (v[i][j].z + v[i][j].w); }
#pragma unroll
          for (int o = 1; o < 64; o <<= 1)
#pragma unroll
              for (int i = 0; i < 4; ++i) sm[i] += __shfl_xor(sm[i], o);
#pragma unroll
          for (int i = 0; i < 4; ++i) { const float mean = sm[i] * (1.f / D); sq[i] = 0.f;
#pragma unroll
              for (int j = 0; j < 4; ++j) { v[i][j] = v[i][j] - mean; sq[i] += (v[i][j].x * v[i][j].x + v[i][j].y * v[i][j].y) + (v[i][j].z * v[i][j].z + v[i][j].w * v[i][j].w); } }
#pragma unroll
          for (int o = 1; o < 64; o <<= 1)
#pragma unroll
              for (int i = 0; i < 4; ++i) sq[i] += __shfl_xor(sq[i], o);
#pragma unroll
          for (int i = 0; i < 4; ++i) { const float rstd = 1.f / sqrtf(sq[i] * (1.f / D) + LN_EPS); const int r = 4 * wave + i;
#pragma unroll
              for (int j = 0; j < 4; ++j) { const f32x4 y = v[i][j] * rstd * gg[j] + bb[j];
                  ((GAS v2u*)(XN + (m0 + i) * D) + lane)[64 * j] = (v2u){pk2(y.x, y.y), pk2(y.z, y.w)};
                  *(LAS f32x4*)(tile + r * RS + 256 * j + 4 * lane) = y; } } }
        __syncthreads();
        f32x16 acc = {};
#pragma unroll
        for (int tt = 0; tt < 16; ++tt) { const int t = 16 * wave + tt;
            const f32x4 bv = *(const LAS f32x4*)(tile + (lane & 31) * RS + 8 * t + 4 * (lane >> 5)); const f32x4 av = wrf[tt];
#pragma unroll
            for (int j = 0; j < 4; ++j) acc = __builtin_amdgcn_mfma_f32_32x32x2f32(av[j], bv[j], acc, 0, 0, 0); }
        __syncthreads();
#pragma unroll
        for (int r = 0; r < 16; ++r) part[wave * 1024 + r * 64 + lane] = acc[r];
        __syncthreads();
#pragma unroll
        for (int k = 0; k < 2; ++k) { const int idx = tid + 512 * k; float sum = 0.f;
#pragma unroll
            for (int w = 0; w < 8; ++w) sum += part[w * 1024 + idx];
            const int r = idx >> 6, l = idx & 63, e = (r & 3) + 8 * (r >> 2) + 4 * (l >> 5), row = l & 31;
            lg[row * 33 + e] = sum + br[e]; }
        __syncthreads();
        if (tid < 32) { const size_t m = (size_t)grp * 32 + tid; float tv[4] = {-INFINITY, -INFINITY, -INFINITY, -INFINITY}; int te[4] = {0, 0, 0, 0};
            for (int e = 0; e < NE; ++e) { const float x = lg[tid * 33 + e];
                if (x > tv[3]) { tv[3] = x; te[3] = e;
#pragma unroll
                    for (int k = 3; k > 0; --k) if (tv[k] > tv[k - 1]) { const float tf = tv[k]; tv[k] = tv[k - 1]; tv[k - 1] = tf; const int ti = te[k]; te[k] = te[k - 1]; te[k - 1] = ti; } } }
            const float e1 = __expf(tv[1] - tv[0]), e2 = __expf(tv[2] - tv[0]), e3 = __expf(tv[3] - tv[0]); const float inv = 1.f / (1.f + e1 + e2 + e3);
            *(int4*)(top_e + m * 4) = make_int4(te[0], te[1], te[2], te[3]); *(f32x4*)(top_g + m * 4) = (f32x4){inv, e1 * inv, e2 * inv, e3 * inv};
            int4 rk;
            rk.x = (int)atomicAdd((unsigned*)&lcnt[te[0]], 1u); rk.y = (int)atomicAdd((unsigned*)&lcnt[te[1]], 1u); rk.z = (int)atomicAdd((unsigned*)&lcnt[te[2]], 1u); rk.w = (int)atomicAdd((unsigned*)&lcnt[te[3]], 1u);
            *(int4*)(lrank + m * 4) = rk; }
        __syncthreads();
    }
    if (tid < NE) ((unsigned*)(F.ws + WS_BASE))[F.vcu * NE + tid] = atomicAdd(cnt + tid, lcnt[tid]);
}
__device__ __forceinline__ void moe_offsets(const unsigned* cnt, LAS int* pstart  , LAS int* tile_e  , int tid) {
    LAS int* cl = (LAS int*)((LAS unsigned char*)pstart + 12288);
    if (tid < NE) cl[tid] = (int)__hip_atomic_load(cnt + tid, __ATOMIC_RELAXED, __HIP_MEMORY_SCOPE_AGENT);
    __syncthreads();
    if (tid == 0) { int s = 0; for (int e = 0; e < NE; ++e) { pstart[e] = s; const int nt = (cl[e] + 255) >> 8; for (int t = 0; t < nt; ++t) tile_e[(s >> 8) + t] = e; s += nt << 8; } pstart[NE] = s; }
    __syncthreads();
}
__device__ __forceinline__ void moe_scatter(Frame& F) {
    LAS int* pstart = (LAS int*)(F.lds + MISC_OFF); LAS int* tile_e = pstart + 64;
    unsigned* ctl = (unsigned*)(F.ws + WS_CTL);
    moe_offsets(ctl + CW_CNT, pstart, tile_e, F.tid);
    const int gt = F.vcu * NTHR + F.tid, NGT = F.G * NTHR;
    const int* top_e = (const int*)(F.ws + WS_RT); const float* top_g = (const float*)(F.ws + WS_RT + 256 * 1024);
    int* slot_of = (int*)(F.ws + WS_RT + 512 * 1024); float* row_gate = (float*)(F.ws + WS_RT + 768 * 1024); int* row_tok = (int*)(F.ws + WS_RT + 1280 * 1024);
    for (int idx = gt; idx < T * 4; idx += NGT) { const int m = idx >> 2, e = top_e[idx], blk = (m >> 5) % F.G;
        const int slot = pstart[e] + (int)((const unsigned*)(F.ws + WS_BASE))[blk * NE + e] + slot_of[idx];
        slot_of[idx] = slot; row_gate[slot] = top_g[idx]; row_tok[slot] = m; }
    for (int idx = gt; idx < NE * 256; idx += NGT) { const int e = idx >> 8, sl = pstart[e] + (int)ctl[CW_CNT + e] + (idx & 255);
        if (sl < pstart[e + 1]) { row_tok[sl] = 0; row_gate[sl] = 0.f; } }
}
__device__ __forceinline__ void moe_combine(Frame& F, const Args& a) {
    const int gw = F.vcu * NWAVES + F.wave, NGW = F.G * NWAVES, lane = F.lane;
    const bf16* XNb = (const bf16*)(F.ws + WS_XN); const bf16* Y = (const bf16*)(F.ws + WS_XG); const int* slot_of = (const int*)(F.ws + WS_RT + 512 * 1024);
    f32x4 gg[4], bb[4];
#pragma unroll
    for (int j = 0; j < 4; ++j) { gg[j] = ((const GAS f32x4*)a.in[24] + lane)[64 * j]; bb[j] = ((const GAS f32x4*)a.in[25] + lane)[64 * j]; }
    for (int m = gw; m + NGW < T; m += 2 * NGW) {
        const int4 sa = *(const int4*)(slot_of + (size_t)m * 4), sb = *(const int4*)(slot_of + (size_t)(m + NGW) * 4);
        const int ss[2][4] = {{sa.x, sa.y, sa.z, sa.w}, {sb.x, sb.y, sb.z, sb.w}};
        v2u hw[2][4], yw[2][4][4];
#pragma unroll
        for (int t = 0; t < 2; ++t)
#pragma unroll
            for (int j = 0; j < 4; ++j) { hw[t][j] = ((const GAS v2u*)(XNb + (size_t)(m + t * NGW) * D) + lane)[64 * j];
#pragma unroll
                for (int k = 0; k < 4; ++k) yw[t][k][j] = ((const GAS v2u*)(Y + (size_t)ss[t][k] * D) + lane)[64 * j]; }
        f32x4 v[2][4]; float s[2], q[2];
#pragma unroll
        for (int t = 0; t < 2; ++t) { s[t] = 0.f;
#pragma unroll
            for (int j = 0; j < 4; ++j) { v[t][j] = (f32x4){bflo(hw[t][j].x), bfhi(hw[t][j].x), bflo(hw[t][j].y), bfhi(hw[t][j].y)} * ALPHA;
#pragma unroll
                for (int k = 0; k < 4; ++k) { const v2u w = yw[t][k][j]; v[t][j] += (f32x4){bflo(w.x), bfhi(w.x), bflo(w.y), bfhi(w.y)}; }
                s[t] += (v[t][j].x + v[t][j].y) + (v[t][j].z + v[t][j].w); } }
#pragma unroll
        for (int o = 1; o < 64; o <<= 1) { s[0] += __shfl_xor(s[0], o); s[1] += __shfl_xor(s[1], o); }
#pragma unroll
        for (int t = 0; t < 2; ++t) { const float mean = s[t] * (1.f / D); q[t] = 0.f;
#pragma unroll
            for (int j = 0; j < 4; ++j) { v[t][j] = v[t][j] - mean; q[t] += (v[t][j].x * v[t][j].x + v[t][j].y * v[t][j].y) + (v[t][j].z * v[t][j].z + v[t][j].w * v[t][j].w); } }
#pragma unroll
        for (int o = 1; o < 64; o <<= 1) { q[0] += __shfl_xor(q[0], o); q[1] += __shfl_xor(q[1], o); }
#pragma unroll
        for (int t = 0; t < 2; ++t) { const float rstd = 1.f / sqrtf(q[t] * (1.f / D) + LN_EPS);
#pragma unroll
            for (int j = 0; j < 4; ++j) ((GAS f32x4*)(a.out + (size_t)(m + t * NGW) * D) + lane)[64 * j] = v[t][j] * rstd * gg[j] + bb[j]; }
    }
}

constexpr int N_PHASES = 13;
__global__ void __launch_bounds__(NTHR, 2) fwd(Args args) {
    extern __shared__ __attribute__((aligned(16))) unsigned char lds[];
    Frame F; F.lds = (LAS unsigned char*)lds; F.tid = threadIdx.x; F.lane = F.tid & 63; F.wave = __builtin_amdgcn_readfirstlane(F.tid >> 6);
    F.G = gridDim.x; { const int bx = blockIdx.x; F.vcu = (F.G % 8 == 0) ? (bx % 8) * (F.G / 8) + bx / 8 : bx; }
    F.ws = args.ws;
    const int lo = args.ph_lo, hi = args.ph_hi;
    { volatile LAS unsigned* st0 = (volatile LAS unsigned*)(F.lds + LDS_BYTES - 16); if (F.tid < 2) st0[F.tid] = 0u; }
    __syncthreads();
    const XcdBarrier gbar = xcd_barrier_post((unsigned*)(F.ws + WS_CTL) + CW_BAR, (volatile LAS unsigned*)(F.lds + LDS_BYTES - 16));
#define GSYNC() xcd_barrier(gbar)
#define IN(k) (lo <= (k) && (k) < hi)
#define SEAM(k) do { if (IN(k) && IN((k) + 1)) GSYNC(); } while (0)
    if (IN(0)) p0_prologue(F, args);
    SEAM(0);
    if (IN(1)) { pg8::Gemm g{(const bf16*)(F.ws + WS_XN), (const bf16*)(F.ws + WS_WIN), T, IN_WP, D}; pg8::StaticOrder S; S.init(T, IN_WP, F.G, (int)blockIdx.x);
        EpiIn E{F.ws, args.in[4]}; pg8::gemm_phase<EpiIn, pg8::StaticOrder, true, true>(F.lds, g, S, E);
        if (F.G == 256 && blockIdx.x >= 192) (void)conv_up_tickets(F, args.in[20], 3); }
    SEAM(1);
    if (IN(2)) s5::phase_a(F);
    SEAM(2);
    if (IN(3)) s5::phase_b(F);
    if (IN(5)) { kmax_phase(F); indexer_phase(F); GSYNC(); attn_phase(F, lds, args.in[20]); GSYNC(); attn_merge(F); }
    SEAM(5);
    if (IN(6)) {
      for (int c = blockIdx.x; c < 256; c += F.G) {
        const bool have = true; const int pm = c >> 2, s = c & 3;
        { pg8::Gemm g{(const bf16*)(F.ws + WS_O), (const bf16*)(F.ws + WS_WAP), T, D, AW}; pg8::OneUnit S{{pm, s, s, 0}, have};
            EpiAtt E{F.ws}; pg8::gemm_phase<EpiAtt, pg8::OneUnit, false, true>(F.lds, g, S, E); }
      }
    }
    SEAM(6);
    if (IN(7)) { pg8::Gemm g{(const bf16*)(F.ws + WS_Z), (const bf16*)(F.ws + WS_WO), T, D, D}; pg8::StaticOrder S; S.init(T, D, F.G, (int)blockIdx.x);
        EpiMix E{(bf16*)(F.ws + WS_MIX)}; pg8::gemm_phase<EpiMix, pg8::StaticOrder, false, true>(F.lds, g, S, E); }
    SEAM(7);
    if (IN(8)) ln1_router(F, args);
    SEAM(8);
    if (IN(9)) moe_scatter(F);
    SEAM(9);
    if (IN(10) || IN(11)) {
        LAS int* pstart = (LAS int*)(F.lds + MISC_OFF); LAS int* tile_e = pstart + 64;
        __syncthreads();
        moe_offsets((unsigned*)(F.ws + WS_CTL) + CW_CNT, pstart, tile_e, F.tid);
        const int ntiles = pstart[NE] >> 8;
        if (IN(10)) { LAS int* tokl = (LAS int*)(F.lds + MISC_OFF + 1536); const int* row_tok = (const int*)(F.ws + WS_RT + 1280 * 1024);
            pg8::MoeOrder S{ntiles * 8, 8, F.G, (int)blockIdx.x, tile_e};
            for (int i = 0; i < 9; ++i) { pg8::Unit uu; if (S.next(i, uu) && F.tid < 256) tokl[i * 256 + F.tid] = row_tok[uu.pm * 256 + F.tid]; }
            __syncthreads();
            pg8::Gemm g{(const bf16*)(F.ws + WS_XN), (const bf16*)(F.ws + WS_WUP), MOE_ROWS, 2048, D, tokl};
            EpiSwiglu E{F.ws, args.in[21]}; pg8::gemm_phase<EpiSwiglu, pg8::MoeOrder, true, true, true>(F.lds, g, S, E);
            { volatile LAS int* qs = (volatile LAS int*)(F.lds + MISC_OFF + 3072); LAS float* scr = (LAS float*)(F.lds + F.wave * 16640);
              for (;;) {
                  if (F.tid == 0) qs[0] = (int)atomicAdd((unsigned*)(F.ws + WS_CTL) + CW_CVQ, 1u);
                  __syncthreads();
                  const int u = qs[0];
                  __syncthreads();
                  if (u >= NE * 256 / NWAVES) break;
                  const int item = u * NWAVES + F.wave, e = item >> 8;
                  p0_transpose_item(args.in[22] + (size_t)e * FF * D, FF, D, D, 0, (bf16*)(F.ws + WS_WDN) + (size_t)e * D * FF, scr, item & 255, F.lane); }
              __syncthreads();
              moe_offsets((unsigned*)(F.ws + WS_CTL) + CW_CNT, pstart, tile_e, F.tid); } }
        SEAM(10);
        if (IN(11)) { pg8::Gemm g{(const bf16*)(F.ws + WS_HH), (const bf16*)(F.ws + WS_WDN), MOE_ROWS, D, FF}; pg8::MoeOrder S{ntiles * 4, 4, F.G, (int)blockIdx.x, tile_e};
            EpiDown E{F.ws, args.in[23], (const float*)(F.ws + WS_RT + 768 * 1024)}; pg8::gemm_phase<EpiDown, pg8::MoeOrder, true, true>(F.lds, g, S, E); }
    }
    SEAM(11);
    if (IN(12)) moe_combine(F, args);
#undef IN
#undef SEAM
}

extern "C" void kernel_launch(void* const* d_in, const int* in_sizes, int n_in, void* d_out, int out_size, void* d_ws, size_t ws_size, hipStream_t stream) {
    static int grid = 0;
    if (grid == 0) {
        if (n_in != 26 || ws_size < WS_END) { fprintf(stderr, "kernel_launch: unexpected n_in %d / ws %zu\n", n_in, ws_size); grid = -1; return; }
        if (hipFuncSetAttribute((const void*)fwd, hipFuncAttributeMaxDynamicSharedMemorySize, LDS_BYTES) != hipSuccess) { fprintf(stderr, "hipFuncSetAttribute failed\n"); grid = -1; return; }
        int dev = 0, cus = 0, per_cu = 0;
        hipGetDevice(&dev); hipDeviceGetAttribute(&cus, hipDeviceAttributeMultiprocessorCount, dev);
        if (hipOccupancyMaxActiveBlocksPerMultiprocessor(&per_cu, (const void*)fwd, NTHR, LDS_BYTES) != hipSuccess || per_cu < 1) { fprintf(stderr, "occupancy query failed (%d)\n", per_cu); grid = -1; return; }
        grid = cus * per_cu; if (grid < 256) { fprintf(stderr, "needs 256 resident workgroups (have %d)\n", grid); grid = -1; return; } grid = 256;
        grid &= ~7; if (grid < 8) { grid = -1; return; }
    }
    if (grid < 0) return;
    (void)hipMemsetAsync((char*)d_ws + WS_CTL, 0, CTL_ZERO_BYTES, stream);
    Args a{};
    for (int i = 0; i < 26; ++i) a.in[i] = (const float*)d_in[i];
    a.out = (float*)d_out; a.ws = (unsigned char*)d_ws;
    a.ph_lo = 0; a.ph_hi = N_PHASES;
    void* kargs[] = {&a};
    hipError_t e = hipLaunchCooperativeKernel((const void*)fwd, dim3(grid), dim3(NTHR), kargs, LDS_BYTES, stream);
    if (e != hipSuccess) fprintf(stderr, "cooperative launch failed: %s (grid %d)\n", hipGetErrorString(e), grid);
}
```

```cpp
#include <hip/hip_runtime.h>
#include <hip/hip_cooperative_groups.h>
#include <cstdio>
#include <cstdint>

namespace pg8 {
#define PG8_LAS __attribute__((address_space(3)))
typedef unsigned short bf16_t;
typedef short bf16x8 __attribute__((ext_vector_type(8)));
typedef float f32x4 __attribute__((ext_vector_type(4)));
typedef unsigned u32x4 __attribute__((ext_vector_type(4)));
constexpr int BM = 256, BK = 64, HALF = 128, HTB = HALF * BK * 2, STAGE_BYTES = 8 * HTB, NXCD = 8, WGM = 8;

__host__ __device__ __forceinline__ int lds_byte(int r, int c) { const int st = (r >> 4) * 2 + (c >> 5), rr = r & 15, cc = c & 31, ob = rr * 64 + cc * 2; return st * 1024 + (ob ^ (((ob >> 9) & 1) << 5)); }
__host__ __device__ __forceinline__ void stage_rc(int b, int& R, int& C) { const int st = b / 1024, sb = b % 1024, swz = sb ^ (((sb >> 9) & 1) << 5); R = (st >> 1) * 16 + swz / 64; C = (st & 1) * 32 + (swz % 64) / 2; }
__host__ __device__ __forceinline__ int perm32(int rho) { const int n = rho >> 4, i = rho & 15; return 8 * (i >> 2) + 4 * n + (i & 3); }

struct Unit { int pm, pn, pb, e; };
struct Gemm { const bf16_t* A; const bf16_t* Bt; int M, N, K; const PG8_LAS int* tokl; };

struct StaticOrder {
    int nM, nN, nwg, G, c;
    __host__ __device__ void init(int M, int N, int G_, int c_) { nM = M / BM; nN = N / BM; nwg = nM * nN; G = G_; c = c_; }
    __host__ __device__ bool next(int i, Unit& u) const {
        const long L = (long)i * G + c; if (L >= nwg) return false;
        int wgid = (int)L; { const int q = nwg / NXCD, r = nwg % NXCD, xcd = wgid % NXCD, off = wgid / NXCD; wgid = (xcd < r ? xcd * (q + 1) : r * (q + 1) + (xcd - r) * q) + off; }
        const int nig = WGM * nN, gid = wgid / nig, fm = gid * WGM, gsz = (nM - fm) < WGM ? (nM - fm) : WGM;
        u.pm = fm + ((wgid % nig) % gsz); u.pn = (wgid % nig) / gsz; u.pb = u.pn; u.e = 0; return true;
    }
    __device__ __forceinline__ void a_ready(const Unit&) const {}
    __device__ __forceinline__ void done(const Unit&) const {}
};
struct OneUnit {
    Unit u; bool have;
    __device__ __forceinline__ bool next(int i, Unit& o) const { if (i != 0 || !have) return false; o = u; return true; }
    __device__ __forceinline__ void a_ready(const Unit&) const {}
    __device__ __forceinline__ void done(const Unit&) const {}
};
struct MoeOrder {
    int nunits, nN, G, c; const PG8_LAS int* tile_e;
    __device__ __forceinline__ bool next(int i, Unit& u) const {
        const long L = (long)i * G + c; if (L >= nunits) return false;
        int wgid = (int)L; { const int q = nunits / NXCD, r = nunits % NXCD, xcd = wgid % NXCD, off = wgid / NXCD; wgid = (xcd < r ? xcd * (q + 1) : r * (q + 1) + (xcd - r) * q) + off; }
        const int tile = wgid / nN, pn = wgid % nN; u.pm = tile; u.pn = pn; u.e = tile_e[tile]; u.pb = u.e * nN + pn; return true;
    }
    __device__ __forceinline__ void a_ready(const Unit&) const {}
    __device__ __forceinline__ void done(const Unit&) const {}
};

typedef float f32x2_cv __attribute__((ext_vector_type(2))); typedef __bf16 bf16x2_cv __attribute__((ext_vector_type(2)));
__device__ __forceinline__ unsigned cvt_pk_bf16(float lo, float hi) { const f32x2_cv v = {lo, hi}; const bf16x2_cv b = __builtin_convertvector(v, bf16x2_cv); return __builtin_bit_cast(unsigned, b); }

template <class Epi, class Sched, bool ALIGN_EPI = false, bool SP2 = false, bool GATHER = false>
__device__ __forceinline__ void gemm_phase(PG8_LAS unsigned char* lds, const Gemm g, const Sched& S, const Epi& E) {
    const int tid = threadIdx.x, wid = __builtin_amdgcn_readfirstlane(tid >> 6), lane = tid & 63, wr = wid >> 2, wc = wid & 3, fr = lane & 15, fq = lane >> 4;
    const int K = g.K, nt = K / BK;
    unsigned voffA[2], voffB[2];
#pragma unroll
    for (int i = 0; i < 2; ++i) { int R, C; stage_rc(tid * 16 + i * 8192, R, C); const int Rb = Epi::PERM ? ((R & ~31) + perm32(R & 31)) : R;
        voffA[i] = (unsigned)(R * K + C) * 2u; voffB[i] = (unsigned)(Rb * K + C) * 2u; }
    unsigned vg[2][2] = {{0u, 0u}, {0u, 0u}}, vn[2][2] = {{0u, 0u}, {0u, 0u}}, v2[2][2] = {{0u, 0u}, {0u, 0u}};
    auto tok_offs = [&](int slot, unsigned (&vo)[2][2]) {
#pragma unroll
        for (int h = 0; h < 2; ++h)
#pragma unroll
            for (int i = 0; i < 2; ++i) { int R, C; stage_rc(tid * 16 + i * 8192, R, C); vo[h][i] = (unsigned)(g.tokl[slot * 256 + h * HALF + R] * K + C) * 2u; } };
    const size_t kstep = (size_t)(BK * 2);
    const size_t hstep = (size_t)HALF * K * 2;
    const size_t tstep = 2 * hstep;
    const unsigned ldsw = (unsigned)wid * 1024u;
    const int aoff = lds_byte(wr * 64 + fr, fq * 8), boff = lds_byte(wc * 32 + fr, fq * 8);
#define PG8_SA(b, h) (((b) * 2 + (h)) * HTB)
#define PG8_SB(b, h) ((4 + (b) * 2 + (h)) * HTB)
#define PG8_STAGE(bufoff, gbase, voff) do { _Pragma("unroll") for (int _i = 0; _i < 2; ++_i) \
        __builtin_amdgcn_global_load_lds((const unsigned*)((const char*)(gbase) + (voff)[_i]), (PG8_LAS unsigned*)(lds + (bufoff) + ldsw + _i * 8192), 16, 0, 0); } while (0)
#define PG8_STAGEA(bufoff, gbase, h, vo) do { if constexpr (GATHER) { _Pragma("unroll") for (int _i = 0; _i < 2; ++_i) \
        __builtin_amdgcn_global_load_lds((const unsigned*)((const char*)(gbase) + (vo)[h][_i]), (PG8_LAS unsigned*)(lds + (bufoff) + ldsw + _i * 8192), 16, 0, 0); } \
        else { PG8_STAGE(bufoff, (const char*)(gbase) + (h) * hstep, voffA); } } while (0)
#define PG8_LDA(dst, b, h) do { _Pragma("unroll") for (int m = 0; m < 4; ++m) _Pragma("unroll") for (int k = 0; k < 2; ++k) dst[m][k] = *(const PG8_LAS bf16x8*)(lds + PG8_SA(b, h) + aoff + m * 2048 + k * 1024); } while (0)
#define PG8_LDB(dst, b, h) do { _Pragma("unroll") for (int n = 0; n < 2; ++n) _Pragma("unroll") for (int k = 0; k < 2; ++k) dst[n][k] = *(const PG8_LAS bf16x8*)(lds + PG8_SB(b, h) + boff + n * 2048 + k * 1024); } while (0)
#define PG8_MMA(ai, bj, At, Bt) do { __builtin_amdgcn_s_setprio(1); _Pragma("unroll") for (int m = 0; m < 4; ++m) _Pragma("unroll") for (int n = 0; n < 2; ++n) _Pragma("unroll") for (int k = 0; k < 2; ++k) \
        acc[ai][bj][m][n] = __builtin_amdgcn_mfma_f32_16x16x32_bf16(Bt[n][k], At[m][k], acc[ai][bj][m][n], 0, 0, 0); __builtin_amdgcn_s_setprio(0); } while (0)
#define PG8_WAIT_V(n) asm volatile("s_waitcnt vmcnt(" #n ")" ::: "memory")
#define PG8_WAIT_L(n) asm volatile("s_waitcnt lgkmcnt(" #n ")" ::: "memory")
#define PG8_BAR __builtin_amdgcn_s_barrier()
#define PG8_SCHED __builtin_amdgcn_sched_barrier(0)
    Unit cur, nxt; int ui = 0;
    if (!S.next(0, cur)) return;
    f32x4 acc[2][2][4][2];
#pragma unroll
    for (int a = 0; a < 2; ++a)
#pragma unroll
        for (int b = 0; b < 2; ++b)
#pragma unroll
            for (int m = 0; m < 4; ++m)
#pragma unroll
                for (int n = 0; n < 2; ++n) acc[a][b][m][n] = (f32x4){0.f, 0.f, 0.f, 0.f};
    bf16x8 At[4][2], B0[2][2], B1[2][2];
    const char* cA = (const char*)g.A + (GATHER ? (size_t)0 : (size_t)cur.pm * tstep); const char* cB = (const char*)g.Bt + (size_t)cur.pb * tstep;
    if constexpr (GATHER) tok_offs(0, vg);
    S.a_ready(cur);
    if constexpr (SP2) {
        PG8_STAGE(PG8_SB(0, 0), cB, voffB); PG8_STAGE(PG8_SB(0, 1), cB + hstep, voffB); PG8_STAGEA(PG8_SA(0, 0), cA, 0, vg); PG8_STAGEA(PG8_SA(0, 1), cA, 1, vg);
        if (wr == 1) PG8_BAR;
        PG8_WAIT_V(2); PG8_BAR;
        PG8_STAGE(PG8_SB(1, 0), cB + kstep, voffB); PG8_STAGEA(PG8_SA(1, 0), cA + kstep, 0, vg); PG8_STAGE(PG8_SB(1, 1), cB + hstep + kstep, voffB);
        PG8_WAIT_V(6); PG8_BAR;
    } else {
        PG8_STAGE(PG8_SB(0, 0), cB, voffB); PG8_STAGEA(PG8_SA(0, 0), cA, 0, vg); PG8_STAGE(PG8_SB(0, 1), cB + hstep, voffB); PG8_STAGEA(PG8_SA(0, 1), cA, 1, vg);
        if (wr == 1) PG8_BAR;
        PG8_WAIT_V(4); PG8_BAR;
        PG8_STAGE(PG8_SB(1, 0), cB + kstep, voffB); PG8_STAGEA(PG8_SA(1, 0), cA + kstep, 0, vg); PG8_STAGE(PG8_SB(1, 1), cB + hstep + kstep, voffB);
        PG8_WAIT_V(6); PG8_BAR;
    }
    for (;;) {
        const bool has_next = S.next(ui + 1, nxt);
        const char* nA = (has_next && !GATHER) ? (const char*)g.A + (size_t)nxt.pm * tstep : cA; const char* nB = has_next ? (const char*)g.Bt + (size_t)nxt.pb * tstep : cB;
        if constexpr (GATHER) { if (has_next) tok_offs(ui + 1, vn); }
        for (int t = 0; t < nt; t += 2) {
            const bool last = (t == nt - 2);
            const char* a1 = cA + (size_t)(t + 1) * kstep;
            const char* a2 = last ? nA : cA + (size_t)(t + 2) * kstep; const char* b2 = last ? nB : cB + (size_t)(t + 2) * kstep;
            const char* a3 = a2 + kstep; const char* b3 = b2 + kstep;
            if (last && has_next) S.a_ready(nxt);
            if constexpr (GATHER) { const bool un = last && has_next;
#pragma unroll
                for (int h = 0; h < 2; ++h)
#pragma unroll
                    for (int i = 0; i < 2; ++i) v2[h][i] = un ? vn[h][i] : vg[h][i]; }
            if constexpr (SP2) {
            PG8_LDB(B0, 0, 0); PG8_LDB(B1, 0, 1); PG8_SCHED; PG8_LDA(At, 0, 0); PG8_STAGEA(PG8_SA(1, 1), a1, 1, vg);
            PG8_WAIT_V(8); PG8_WAIT_L(0); PG8_BAR; PG8_MMA(0, 0, At, B0); PG8_MMA(0, 1, At, B1); PG8_BAR; PG8_SCHED;
            PG8_LDA(At, 0, 1); PG8_STAGE(PG8_SB(0, 0), b2, voffB); PG8_STAGE(PG8_SB(0, 1), b2 + hstep, voffB); PG8_STAGEA(PG8_SA(0, 0), a2, 0, v2);
            PG8_WAIT_V(8); PG8_WAIT_L(0); PG8_BAR; PG8_MMA(1, 0, At, B0); PG8_MMA(1, 1, At, B1); PG8_BAR; PG8_SCHED;
            PG8_LDB(B0, 1, 0); PG8_LDB(B1, 1, 1); PG8_SCHED; PG8_LDA(At, 1, 0); PG8_STAGEA(PG8_SA(0, 1), a2, 1, v2);
            PG8_WAIT_V(8); PG8_WAIT_L(0); PG8_BAR; PG8_MMA(0, 0, At, B0); PG8_MMA(0, 1, At, B1); PG8_BAR; PG8_SCHED;
            PG8_LDA(At, 1, 1); PG8_STAGE(PG8_SB(1, 0), b3, voffB); PG8_STAGE(PG8_SB(1, 1), b3 + hstep, voffB); PG8_STAGEA(PG8_SA(1, 0), a3, 0, v2);
            PG8_WAIT_V(8); PG8_WAIT_L(0); PG8_BAR; PG8_MMA(1, 0, At, B0); PG8_MMA(1, 1, At, B1); PG8_BAR; PG8_SCHED;
            } else {
            PG8_LDB(B0, 0, 0); PG8_SCHED; PG8_LDA(At, 0, 0); PG8_STAGEA(PG8_SA(1, 1), a1, 1, vg);
            PG8_WAIT_L(8); PG8_BAR; PG8_WAIT_L(0); PG8_MMA(0, 0, At, B0); PG8_BAR; PG8_SCHED;
            PG8_LDB(B1, 0, 1); PG8_STAGE(PG8_SB(0, 0), b2, voffB);
            PG8_BAR; PG8_WAIT_L(0); PG8_MMA(0, 1, At, B1); PG8_BAR;
            PG8_LDA(At, 0, 1); PG8_STAGEA(PG8_SA(0, 0), a2, 0, v2);
            PG8_BAR; PG8_WAIT_L(0); PG8_MMA(1, 0, At, B0); PG8_BAR; PG8_SCHED;
            PG8_STAGE(PG8_SB(0, 1), b2 + hstep, voffB);
            PG8_WAIT_V(6); PG8_BAR; PG8_MMA(1, 1, At, B1); PG8_BAR;
            PG8_LDB(B0, 1, 0); PG8_SCHED; PG8_LDA(At, 1, 0); PG8_STAGEA(PG8_SA(0, 1), a2, 1, v2);
            PG8_WAIT_L(8); PG8_BAR; PG8_WAIT_L(0); PG8_MMA(0, 0, At, B0); PG8_BAR; PG8_SCHED;
            PG8_LDB(B1, 1, 1); PG8_STAGE(PG8_SB(1, 0), b3, voffB);
            PG8_BAR; PG8_WAIT_L(0); PG8_MMA(0, 1, At, B1); PG8_BAR;
            PG8_LDA(At, 1, 1); PG8_STAGEA(PG8_SA(1, 0), a3, 0, v2);
            PG8_BAR; PG8_WAIT_L(0); PG8_MMA(1, 0, At, B0); PG8_BAR; PG8_SCHED;
            PG8_STAGE(PG8_SB(1, 1), b3 + hstep, voffB);
            PG8_WAIT_V(6); PG8_BAR; PG8_MMA(1, 1, At, B1); PG8_BAR;
            }
        }
        if constexpr (ALIGN_EPI) { if (wr == 0) PG8_BAR; }
        E(acc, cur, wr, wc, fr, fq); S.done(cur);
        if (!has_next) break;
#pragma unroll
        for (int a = 0; a < 2; ++a)
#pragma unroll
            for (int b = 0; b < 2; ++b)
#pragma unroll
                for (int m = 0; m < 4; ++m)
#pragma unroll
                    for (int n = 0; n < 2; ++n) acc[a][b][m][n] = (f32x4){0.f, 0.f, 0.f, 0.f};
        cur = nxt; cA = nA; cB = nB; ++ui;
        if constexpr (GATHER) {
#pragma unroll
            for (int h = 0; h < 2; ++h)
#pragma unroll
                for (int i = 0; i < 2; ++i) vg[h][i] = vn[h][i]; }
        if constexpr (ALIGN_EPI) { if (wr == 1) PG8_BAR; }
    }
    PG8_WAIT_V(0);
    if constexpr (!ALIGN_EPI) { if (wr == 0) PG8_BAR; }
    PG8_BAR;
#undef PG8_SA
#undef PG8_SB
#undef PG8_STAGE
#undef PG8_STAGEA
#undef PG8_LDA
#undef PG8_LDB
#undef PG8_MMA
#undef PG8_WAIT_V
#undef PG8_WAIT_L
#undef PG8_BAR
#undef PG8_SCHED
}
}


#include <hip/hip_bf16.h>
namespace attn_body {
using bf16=__hip_bfloat16;
using bf16x8=__attribute__((ext_vector_type(8)))short;
using s16x4=__attribute__((ext_vector_type(4)))short;
using f32x16=__attribute__((ext_vector_type(16)))float;
using u32x4=__attribute__((ext_vector_type(4)))unsigned;
constexpr int BATCH=2,NHEAD=8,SEQ=8192,D=64,DM=NHEAD*D;
constexpr int NW=8,QBLK=32,QB=QBLK*NW,KVBLK=64,NQB=SEQ/QB;
__device__ __forceinline__ int crow(int r,int hi){return (r&3)+8*(r>>2)+4*hi;}
#define SBAR() __builtin_amdgcn_sched_barrier(0)
constexpr int NSLOT=3, SLOTB=8192;
constexpr int LDS_K=0, LDS_V=NSLOT*SLOTB, LDS_WS=2*NSLOT*SLOTB, LDS_OST=LDS_WS+NW*64*4, LDS_BYTES=LDS_OST+NW*4096;
__device__ __forceinline__ void glds16(const void*gsrc,unsigned lds_dst){unsigned keep;
  asm volatile("s_mov_b32 %0, m0\n\ts_mov_b32 m0, %2\n\ts_nop 0\n\tglobal_load_lds_dwordx4 %1, off\n\ts_mov_b32 m0, %0":"=&s"(keep):"v"(gsrc),"s"(lds_dst):"memory");}
__device__ __forceinline__ float max3f(float a,float b,float c){float r;asm("v_max3_f32 %0, %1, %2, %3":"=v"(r):"v"(a),"v"(b),"v"(c));return r;}
__device__ __forceinline__ float max2f(float a,float b){float r;asm("v_max_f32_e32 %0, %1, %2":"=v"(r):"v"(a),"v"(b));return r;}
__device__ __forceinline__ float fadd_s(float a,float b){float r;asm("v_add_f32_e32 %0, %1, %2":"=v"(r):"v"(a),"v"(b));return r;}
__device__ __forceinline__ float fsub_s(float a,float b){float r;asm("v_sub_f32_e32 %0, %1, %2":"=v"(r):"v"(a),"v"(b));return r;}
typedef float f32x2_t __attribute__((ext_vector_type(2))); typedef __bf16 bf16x2_t __attribute__((ext_vector_type(2)));
__device__ __forceinline__ unsigned cvtpk_s(float lo,float hi){f32x2_t v={lo,hi};bf16x2_t b=__builtin_convertvector(v,bf16x2_t);return __builtin_bit_cast(unsigned,b);}
#define WAIT_BAR(N) asm volatile("s_waitcnt vmcnt(" #N ") lgkmcnt(0)\n\ts_barrier":::"memory")
__device__ __forceinline__ void qkt(f32x16&p0,f32x16&p1,const char*Kslot,const bf16x8*qr,const f32x16&negm,int r32,int hi){
  const char*kb=Kslot+hi*1024+r32*16;
  #pragma unroll
  for(int d0=0;d0<4;++d0){
    const bf16x8 b0=*reinterpret_cast<const bf16x8*>(kb+d0*2048);
    const bf16x8 b1=*reinterpret_cast<const bf16x8*>(kb+d0*2048+512);
    if(d0==0){p0=__builtin_amdgcn_mfma_f32_32x32x16_bf16(b0,qr[0],negm,0,0,0);p1=__builtin_amdgcn_mfma_f32_32x32x16_bf16(b1,qr[0],negm,0,0,0);}
    else{p0=__builtin_amdgcn_mfma_f32_32x32x16_bf16(b0,qr[d0],p0,0,0,0);p1=__builtin_amdgcn_mfma_f32_32x32x16_bf16(b1,qr[d0],p1,0,0,0);}}
}
typedef __attribute__((address_space(3))) const char* lds_cptr;
typedef short v4i16_t __attribute__((ext_vector_type(4)));
__device__ __forceinline__ void kload8(bf16x8*kf,lds_cptr kp){
  kf[0]=*(const __attribute__((address_space(3))) bf16x8*)(kp);      kf[1]=*(const __attribute__((address_space(3))) bf16x8*)(kp+512);
  kf[2]=*(const __attribute__((address_space(3))) bf16x8*)(kp+2048); kf[3]=*(const __attribute__((address_space(3))) bf16x8*)(kp+2560);
  kf[4]=*(const __attribute__((address_space(3))) bf16x8*)(kp+4096); kf[5]=*(const __attribute__((address_space(3))) bf16x8*)(kp+4608);
  kf[6]=*(const __attribute__((address_space(3))) bf16x8*)(kp+6144); kf[7]=*(const __attribute__((address_space(3))) bf16x8*)(kp+6656);
}
__device__ __forceinline__ void kload2(bf16x8*kf,lds_cptr kp,int j){ kf[2*j]=*(const __attribute__((address_space(3))) bf16x8*)(kp+j*2048); kf[2*j+1]=*(const __attribute__((address_space(3))) bf16x8*)(kp+j*2048+512); }
__device__ __forceinline__ s16x4 vtr(lds_cptr p){ return __builtin_bit_cast(s16x4,__builtin_amdgcn_ds_read_tr16_b64_v4i16((__attribute__((address_space(3))) v4i16_t*)p)); }
__device__ __forceinline__ float rowmax(const f32x16&p0,const f32x16&p1){
  float a=max3f(p0[0],p0[1],p1[0]),b=max3f(p0[2],p0[3],p1[1]);a=max3f(a,p1[2],p1[3]);
  #pragma unroll
  for(int r=4;r<16;r+=4){a=max3f(a,p0[r],p0[r+1]);b=max3f(b,p0[r+2],p0[r+3]);a=max3f(a,p1[r],p1[r+1]);b=max3f(b,p1[r+2],p1[r+3]);}
  const float m=max2f(a,b);
  auto rr=__builtin_amdgcn_permlane32_swap(__float_as_uint(m),__float_as_uint(m),false,false);
  return max2f(__uint_as_float(rr[0]),__uint_as_float(rr[1]));
}
__device__ __forceinline__ void pv(f32x16*o,int vb,bf16x8 pa0,bf16x8 pa1,bf16x8 pa2,bf16x8 pa3){
  #pragma unroll
  for(int d0=0;d0<2;++d0){s16x4 lo[4],hi[4];
    #pragma unroll
    for(int ks=0;ks<4;++ks){
      asm volatile("ds_read_b64_tr_b16 %0,%1 offset:%c2":"=&v"(lo[ks]):"v"(vb),"i"(d0*4096+ks*1024):"memory");
      asm volatile("ds_read_b64_tr_b16 %0,%1 offset:%c2":"=&v"(hi[ks]):"v"(vb),"i"(d0*4096+ks*1024+512):"memory");}
    asm volatile("s_waitcnt lgkmcnt(0)":::"memory");SBAR();
    #define PK(k) (bf16x8){lo[k][0],lo[k][1],lo[k][2],lo[k][3],hi[k][0],hi[k][1],hi[k][2],hi[k][3]}
    o[d0]=__builtin_amdgcn_mfma_f32_32x32x16_bf16(pa0,PK(0),o[d0],0,0,0);
    o[d0]=__builtin_amdgcn_mfma_f32_32x32x16_bf16(pa1,PK(1),o[d0],0,0,0);
    o[d0]=__builtin_amdgcn_mfma_f32_32x32x16_bf16(pa2,PK(2),o[d0],0,0,0);
    o[d0]=__builtin_amdgcn_mfma_f32_32x32x16_bf16(pa3,PK(3),o[d0],0,0,0);
    #undef PK
  }
}
__device__ __forceinline__ float bfi_f(unsigned m,float x,float y){float r;asm("v_bfi_b32 %0, %1, %2, %3":"=v"(r):"v"(m),"v"(x),"v"(y));return r;}
__device__ __forceinline__ void maskalibi(f32x16&c0,f32x16&c1,unsigned mk,float s2){
  float ninf=-INFINITY; asm volatile("":"+v"(ninf));
  #pragma unroll
  for(int r=0;r<16;++r){ const float kr=(float)((r&3)+8*(r>>2));
    const float a=__builtin_fmaf(s2,kr,c0[r]), b=__builtin_fmaf(s2,kr+32.f,c1[r]);
    const unsigned m0=(unsigned)__builtin_amdgcn_sbfe((int)mk,r,1), m1=(unsigned)__builtin_amdgcn_sbfe((int)mk,16+r,1);
    c0[r]=bfi_f(m0,a,ninf); c1[r]=bfi_f(m1,b,ninf); }
}
#ifndef ATTN_STORE16
#define ATTN_STORE16(p,v) (*(u32x4*)(p)=(v))
#endif
template<int THRL> __device__ __forceinline__ void attn_unit(int b,int h,int qb,int TOFF,int NTP,bool PART,const bf16*Q,const bf16*__restrict__ K,const bf16*__restrict__ V,bf16*O,bf16*OP,float*LSE,const unsigned*MK,float kmax2,char*shm){
  const int tid=threadIdx.x,lane=tid&63,r32=lane&31,hi=lane>>5; const int wid=__builtin_amdgcn_readfirstlane(tid>>6);
  const long rowbase=(long)b*SEQ; const int q0=qb*QB;
  const bf16*Qw=Q+(rowbase+q0+wid*QBLK)*DM+h*D;
  const bf16*Kh=K+rowbase*DM+h*D,*Vh=V+rowbase*DM+h*D;
  const unsigned lds0=(unsigned)(uintptr_t)shm;
  float*wsf=(float*)(shm+LDS_WS)+wid*64;
  const bf16*ksrc=Kh+(long)lane*DM+wid*8;
  const bf16*vsrc=Vh+(long)(16*(wid&3)+(lane>>2))*DM+(wid>>2)*32+(lane&3)*8;
  const unsigned kdst=lds0+LDS_K+wid*1024, vdst=lds0+LDS_V+wid*1024;
  const int NT=(q0+QB)/KVBLK;
  #define PT(t) (NT-1-TOFF-(t))
  #define DMA_K(t,slot) glds16(ksrc+(long)PT(t)*KVBLK*DM,(unsigned)__builtin_amdgcn_readfirstlane(kdst+(slot)))
  #define DMA_V(t,slot) glds16(vsrc+(long)PT(t)*KVBLK*DM,(unsigned)__builtin_amdgcn_readfirstlane(vdst+(slot)))
  const int vb0=(int)(lds0+LDS_V)+((lane>>4)&1)*32+(lane&3)*8+(4*hi+((lane&15)>>2))*64;
  const char*Kbase=shm+LDS_K; bf16x8 kf[8];
  const lds_cptr shm3=(lds_cptr)shm; const lds_cptr kp0=shm3+LDS_K+hi*1024+r32*16; const lds_cptr vp0=shm3+LDS_V+((lane>>4)&1)*32+(lane&3)*8+(4*hi+((lane&15)>>2))*64;
  const float slope2=__builtin_amdgcn_exp2f(-(float)(h+1))*1.4426950408889634f;
  const float hib=slope2*4.f*(float)hi;
  const unsigned*mkp=MK+(((size_t)b*256+(size_t)(qb*8+wid))*128)*64+lane;
  #define MKLD(dst,t) asm volatile("global_load_dword %0, %1, off":"=v"(dst):"v"(mkp+(size_t)PT(t)*64):"memory")
  bf16x8 qr[4];
  #pragma unroll
  for(int d0=0;d0<4;++d0)qr[d0]=*reinterpret_cast<const bf16x8*>(&Qw[(long)r32*DM+d0*16+hi*8]);
  int NP;
  if(h==7){ NP=NT-TOFF; NP=NP>NTP?NTP:NP; }
  else { unsigned mw[8];
    #pragma unroll
    for(int j=0;j<8;++j)mw[j]=(j<NT)?mkp[(size_t)(NT-1-j)*64]:0u;
    float q2=0.f;
    #pragma unroll
    for(int d0=0;d0<4;++d0)
      #pragma unroll
      for(int i=0;i<8;++i){const float x=__builtin_bit_cast(float,(unsigned)(unsigned short)qr[d0][i]<<16);q2=__builtin_fmaf(x,x,q2);}
    q2+=__shfl_xor(q2,32);
    int best=-1;
    #pragma unroll
    for(int j=0;j<8;++j){ const unsigned w=mw[j]; if(w){ const int hb=31-__builtin_clz(w); const int pos=64*(NT-1-j)+32*(hb>>4)+crow(hb&15,hi); best=best>pos?best:pos; } }
    { const int ob=__shfl_xor(best,32); best=best>ob?best:ob; }
    const float need=(40.f+2.f*__builtin_sqrtf(q2*kmax2))/slope2;
    float kminf=best>=0?(float)best-need:-1.0e9f;
    #pragma unroll
    for(int o=1;o<32;o<<=1)kminf=__builtin_fminf(kminf,__shfl_xor(kminf,o));
    if(lane==0)wsf[0]=kminf;
    asm volatile("s_waitcnt lgkmcnt(0)\n\ts_barrier":::"memory");
    float km=((float*)(shm+LDS_WS))[0];
    #pragma unroll
    for(int w=1;w<8;++w)km=__builtin_fminf(km,((float*)(shm+LDS_WS))[w*64]);
    const int ptmin=km<=0.f?0:((int)km>>6);
    int NTE=NT-ptmin; NTE=(NTE+1)&~1; NTE=NTE<4?4:NTE; NTE=NTE>NT?NT:NTE;
    NP=NTE-TOFF; NP=NP>NTP?NTP:NP; if(NP>0&&NP<4)NP=4;
    NP=__builtin_amdgcn_readfirstlane(NP);
    asm volatile("s_waitcnt lgkmcnt(0)\n\ts_barrier":::"memory"); }
  if(NP<=0){ if(PART&&hi==0)LSE[wid*QBLK+r32]=-INFINITY; return; }
  unsigned mkA,mkB;
  MKLD(mkA,0); MKLD(mkB,1);
  DMA_K(0,0);DMA_V(0,0);DMA_K(1,SLOTB);
  float mhat=0.f,l_reg=0.f;f32x16 o[2];o[0]=f32x16{};o[1]=f32x16{};f32x16 negm=f32x16{};
  #define SETNEG(t) do{ const float lb_=slope2*(float)(64*PT(t)-q0)+hib-mhat; _Pragma("unroll") for(int r=0;r<16;++r)negm[r]=lb_; asm volatile("":"+v"(negm)); }while(0)
  SETNEG(0);
  bool resc=false;
  #define START(P0,P1) do{ const float rm=rowmax(P0,P1); resc=false; \
    { const float dl=max2f(rm,-16384.f); mhat=fadd_s(mhat,dl); \
      _Pragma("unroll") for(int r=0;r<16;++r){P0[r]=fsub_s(P0[r],dl);P1[r]=fsub_s(P1[r],dl);} } \
    _Pragma("unroll") for(int r=0;r<16;++r)P0[r]=__builtin_amdgcn_exp2f(P0[r]); }while(0)
  #define RESC() do{ if(resc){ asm volatile("s_waitcnt lgkmcnt(0)":::"memory"); \
      _Pragma("unroll") for(int d_=0;d_<2;++d_) _Pragma("unroll") for(int r=0;r<16;++r)o[d_][r]*=wsf[crow(r,hi)]; } }while(0)
  f32x16 pA0,pA1,pB0,pB1;
  int sl_prev=0,sl_cur=0,sl_next=SLOTB;
  #define ROT() do{sl_prev=sl_cur;sl_cur=sl_next;sl_next=(sl_next==(NSLOT-1)*SLOTB)?0:sl_next+SLOTB;}while(0)
  DMA_K(2,2*SLOTB);
  WAIT_BAR(3);
  asm volatile("":"+v"(mkA),"+v"(mkB));
  qkt(pA0,pA1,Kbase,qr,negm,r32,hi); maskalibi(pA0,pA1,mkA,slope2); asm volatile("s_nop 15\n\ts_nop 7":"+v"(pA0),"+v"(pA1));
  START(pA0,pA1);
  _Pragma("unroll") for(int r=0;r<16;++r)pA1[r]=__builtin_amdgcn_exp2f(pA1[r]);
  WAIT_BAR(0);
  DMA_K(3,0);DMA_V(1,SLOTB);
  ROT();
  kload8(kf,kp0+sl_cur);
  WAIT_BAR(2);
  s16x4 vlo[8],vhi[8]; u32x4 pw0,pw1,pw2,pw3;
  #define PKW(P,B) cvtpk_s(P[B],P[B+1])
  #define PAF(k) __builtin_bit_cast(bf16x8,pw##k)
  #define VFR(i) (bf16x8){vlo[i][0],vlo[i][1],vlo[i][2],vlo[i][3],vhi[i][0],vhi[i][1],vhi[i][2],vhi[i][3]}
  #define PIN(x) asm volatile("":"+v"(x))
  #define MX3(a,b,c) __builtin_fmaxf(__builtin_fmaxf((a),(b)),(c))
  #define GAPA(MF,A0,A1,A2,A3,W0,W1,PW) do{ MF; sacc+=A0; sacc+=A1; sacc+=A2; sacc+=A3; PIN(sacc); W0; W1; PIN(PW); SBAR(); }while(0)
  #define EX(v) __builtin_amdgcn_exp2f(v)
  #define GAPB(MF,X,B) do{ MF; X[B]=EX(X[B]); X[B+1]=EX(X[B+1]); X[B+2]=EX(X[B+2]); X[B+3]=EX(X[B+3]); PIN(X); SBAR(); }while(0)
  #define VRD(i) do{ vlo[i]=vtr(vp_+(((i)>>2)*4096+((i)&3)*1024)); vhi[i]=vtr(vp_+(((i)>>2)*4096+((i)&3)*1024+512)); }while(0)
  #define KRD(G,j) do{ if(G){ kload2(kf,kp0+sl_next,j); SBAR(); } }while(0)
  #define STEP(C0,C1,P0,P1,t,GK,GV,GL,MCUR,MNXT) do{ SBAR(); \
    SETNEG(t); \
    const lds_cptr vp_=vp0+sl_prev; \
    VRD(0); SBAR(); float sacc=(P0[0]+P0[1]); \
    GAPA(C0=__builtin_amdgcn_mfma_f32_32x32x16_bf16(kf[0],qr[0],negm,0,0,0), P0[2],P0[3],P0[4],P0[5],     pw0[0]=PKW(P0,0), pw0[1]=PKW(P0,2), pw0); \
    VRD(4); SBAR(); GAPA(C1=__builtin_amdgcn_mfma_f32_32x32x16_bf16(kf[1],qr[0],negm,0,0,0), P0[6],P0[7],P0[8],P0[9],     pw0[2]=PKW(P0,4), pw0[3]=PKW(P0,6), pw0); \
    VRD(1); SBAR(); GAPA(C0=__builtin_amdgcn_mfma_f32_32x32x16_bf16(kf[2],qr[1],C0,0,0,0),   P0[10],P0[11],P0[12],P0[13], pw1[0]=PKW(P0,8), pw1[1]=PKW(P0,10), pw1); \
    VRD(5); SBAR(); GAPA(C1=__builtin_amdgcn_mfma_f32_32x32x16_bf16(kf[3],qr[1],C1,0,0,0),   P0[14],P0[15],P1[0],P1[1],   pw1[2]=PKW(P0,12),pw1[3]=PKW(P0,14), pw1); \
    VRD(2); SBAR(); GAPA(C0=__builtin_amdgcn_mfma_f32_32x32x16_bf16(kf[4],qr[2],C0,0,0,0),   P1[2],P1[3],P1[4],P1[5],     pw2[0]=PKW(P1,0), pw2[1]=PKW(P1,2), pw2); \
    VRD(6); SBAR(); GAPA(C1=__builtin_amdgcn_mfma_f32_32x32x16_bf16(kf[5],qr[2],C1,0,0,0),   P1[6],P1[7],P1[8],P1[9],     pw2[2]=PKW(P1,4), pw2[3]=PKW(P1,6), pw2); \
    VRD(3); SBAR(); GAPA(C0=__builtin_amdgcn_mfma_f32_32x32x16_bf16(kf[6],qr[3],C0,0,0,0),   P1[10],P1[11],P1[12],P1[13], pw3[0]=PKW(P1,8), pw3[1]=PKW(P1,10), pw3); \
    VRD(7); SBAR(); GAPA(C1=__builtin_amdgcn_mfma_f32_32x32x16_bf16(kf[7],qr[3],C1,0,0,0),   P1[14],P1[15],0.f,0.f,       pw3[2]=PKW(P1,12),pw3[3]=PKW(P1,14), pw3); \
    l_reg+=sacc; \
    if(GV){MKLD(MNXT,(t)+1);} if(GK){DMA_K((t)+3,sl_cur);} if(GV){DMA_V((t)+1,sl_next);} \
    maskalibi(C0,C1,MCUR,slope2); \
    { float a=MX3(C0[0],C0[1],C1[0]),b=MX3(C0[2],C0[3],C1[1]); a=MX3(a,C1[2],C1[3]); \
      _Pragma("unroll") for(int r=4;r<16;r+=4){a=MX3(a,C0[r],C0[r+1]);b=MX3(b,C0[r+2],C0[r+3]);a=MX3(a,C1[r],C1[r+1]);b=MX3(b,C1[r+2],C1[r+3]);} \
      float rm=__builtin_fmaxf(a,b); { auto rr=__builtin_amdgcn_permlane32_swap(__float_as_uint(rm),__float_as_uint(rm),false,false); rm=__builtin_fmaxf(__uint_as_float(rr[0]),__uint_as_float(rr[1])); } \
      resc=false; \
      if(__builtin_expect(__any(rm>(float)THRL),0)){ const float dl=__builtin_fmaxf(rm,0.f); mhat+=dl; \
        _Pragma("unroll") for(int r=0;r<16;++r){C0[r]-=dl;C1[r]-=dl;} \
        const float f=__builtin_amdgcn_exp2f(-dl); l_reg*=f; if(hi==0)wsf[r32]=f; resc=true; } } \
    SBAR(); \
    GAPB(o[0]=__builtin_amdgcn_mfma_f32_32x32x16_bf16(PAF(0),VFR(0),o[0],0,0,0), C0,0); \
    GAPB(o[1]=__builtin_amdgcn_mfma_f32_32x32x16_bf16(PAF(0),VFR(4),o[1],0,0,0), C0,4); \
    KRD(GL,0); GAPB(o[0]=__builtin_amdgcn_mfma_f32_32x32x16_bf16(PAF(1),VFR(1),o[0],0,0,0), C0,8); \
    KRD(GL,1); GAPB(o[1]=__builtin_amdgcn_mfma_f32_32x32x16_bf16(PAF(1),VFR(5),o[1],0,0,0), C0,12); \
    KRD(GL,2); GAPB(o[0]=__builtin_amdgcn_mfma_f32_32x32x16_bf16(PAF(2),VFR(2),o[0],0,0,0), C1,0); \
    KRD(GL,3); GAPB(o[1]=__builtin_amdgcn_mfma_f32_32x32x16_bf16(PAF(2),VFR(6),o[1],0,0,0), C1,4); \
    GAPB(o[0]=__builtin_amdgcn_mfma_f32_32x32x16_bf16(PAF(3),VFR(3),o[0],0,0,0), C1,8); \
    GAPB(o[1]=__builtin_amdgcn_mfma_f32_32x32x16_bf16(PAF(3),VFR(7),o[1],0,0,0), C1,12); \
    }while(0)
  int t=1;
  for(;t+5<NP;t+=2){
    STEP(pB0,pB1,pA0,pA1,t,true,true,true,mkB,mkA);     WAIT_BAR(2); PIN(mkA); RESC(); ROT();
    STEP(pA0,pA1,pB0,pB1,t+1,true,true,true,mkA,mkB);   WAIT_BAR(2); PIN(mkB); RESC(); ROT();
  }
  #define ENDW(tt) do{ if((tt)+3<NP){WAIT_BAR(2);} else if((tt)+2<NP){WAIT_BAR(1);} else {WAIT_BAR(0);} }while(0)
  for(;t+1<NP;t+=2){
    STEP(pB0,pB1,pA0,pA1,t,(t+3<NP),(t+1<NP),(t+1<NP),mkB,mkA);       ENDW(t);   PIN(mkA); RESC(); ROT();
    STEP(pA0,pA1,pB0,pB1,t+1,(t+4<NP),(t+2<NP),(t+2<NP),mkA,mkB);     ENDW(t+1); PIN(mkB); RESC(); ROT();
  }
  STEP(pB0,pB1,pA0,pA1,NP-1,false,false,false,mkB,mkA); RESC();
  { float sacc=pB0[0]+pB0[1]; _Pragma("unroll") for(int r=2;r<16;++r)sacc+=pB0[r]; _Pragma("unroll") for(int r=0;r<16;++r)sacc+=pB1[r]; l_reg+=sacc;
    pw0=(u32x4){PKW(pB0,0),PKW(pB0,2),PKW(pB0,4),PKW(pB0,6)};pw1=(u32x4){PKW(pB0,8),PKW(pB0,10),PKW(pB0,12),PKW(pB0,14)};pw2=(u32x4){PKW(pB1,0),PKW(pB1,2),PKW(pB1,4),PKW(pB1,6)};pw3=(u32x4){PKW(pB1,8),PKW(pB1,10),PKW(pB1,12),PKW(pB1,14)};
    SBAR(); pv(o,vb0+sl_cur,PAF(0),PAF(1),PAF(2),PAF(3)); }
  #undef PKW
  #undef PAF
  #undef VFR
  #undef PIN
  #undef MX3
  #undef GAPA
  #undef GAPB
  #undef EX
  #undef VRD
  #undef KRD
  #undef STEP
  #undef ENDW
  {auto rr=__builtin_amdgcn_permlane32_swap(__float_as_uint(l_reg),__float_as_uint(l_reg),false,false);l_reg=__uint_as_float(rr[0])+__uint_as_float(rr[1]);}
  if(hi==0)wsf[32+r32]=l_reg;asm volatile("s_waitcnt lgkmcnt(0)":::"memory");
  if(PART&&hi==0)LSE[wid*QBLK+r32]=l_reg>0.f?mhat+__builtin_amdgcn_logf(l_reg):-INFINITY;
  float rli[16];
  #pragma unroll
  for(int r=0;r<16;++r){const float lv=wsf[32+crow(r,hi)];rli[r]=lv>0.f?__builtin_amdgcn_rcpf(lv):0.f;}
  bf16*Ow=PART?OP+(long)(wid*QBLK)*D:O+(rowbase+q0+wid*QBLK)*DM+h*D; const long opitch=PART?D:DM;
  { bf16*stg=(bf16*)(shm+LDS_OST)+wid*2048;
    #pragma unroll
    for(int r=0;r<16;++r){const int orow=crow(r,hi);
      #pragma unroll
      for(int d0=0;d0<2;++d0)stg[orow*64+d0*32+r32]=__float2bfloat16(o[d0][r]*rli[r]);}
    asm volatile("s_waitcnt lgkmcnt(0)":::"memory");
    #pragma unroll
    for(int i=0;i<4;++i){const int row=i*8+(lane>>3),ch=lane&7; const u32x4 v=*(const u32x4*)(stg+row*64+ch*8); ATTN_STORE16(Ow+(long)row*opitch+ch*8,v);} }
  asm volatile("s_waitcnt lgkmcnt(0)\n\ts_barrier":::"memory");
  #undef DMA_K
  #undef DMA_V
  #undef START
  #undef RESC
  #undef ROT
  #undef PT
  #undef MKLD
  #undef SETNEG
}
constexpr int ATTN_LDS_BYTES=LDS_BYTES;
#undef SBAR
#undef WAIT_BAR
}

constexpr int NWAVES = 8, NTHR = 512;
constexpr int BATCH = 2, SEQ = 8192, D = 1024, T = BATCH * SEQ;
constexpr int SSMW = 512, NG = 32, GP = 16, NS = 64;
constexpr int NH = 8, HD = 64, AW = 512, TOPK = 256;
constexpr int NE = 32, FF = 1024;
constexpr int IN_W = 4680, IN_WP = 4864;
constexpr int CH = 64, NCH = SEQ / CH;
constexpr float LN_EPS = 1e-5f;
constexpr float ALPHA = 1.189207115002721f;
constexpr float LOG2E = 1.4426950408889634f;
constexpr int MOE_ROWS = T * 4 + NE * 256;
constexpr int MOE_TILES = MOE_ROWS / 256;

constexpr size_t MiB = 1u << 20;
constexpr size_t WS_CTL = 0, CTL_ZERO_BYTES = 1 * MiB;
constexpr size_t WS_WIN = 2 * MiB;
constexpr size_t WS_WGLU = 12 * MiB;
constexpr size_t WS_WAP = 14 * MiB;
constexpr size_t WS_WO = 15 * MiB;
constexpr size_t WS_WUP = 18 * MiB;
constexpr size_t WS_WDN = 146 * MiB;
constexpr size_t WS_XN = 210 * MiB;
constexpr size_t WS_H = 242 * MiB;
constexpr size_t WS_U = 306 * MiB;
constexpr size_t WS_Q = 322 * MiB, WS_K = 338 * MiB, WS_V = 354 * MiB, WS_QI = 370 * MiB;
constexpr size_t WS_KI = 386 * MiB;
constexpr size_t WS_WI = 388 * MiB;
constexpr size_t WS_G = 390 * MiB;
constexpr size_t WS_YG = 454 * MiB;
constexpr size_t WS_O = 470 * MiB;
constexpr size_t WS_Z = 486 * MiB;
constexpr size_t WS_MIX = 518 * MiB;
constexpr size_t WS_S5 = 582 * MiB;
constexpr size_t WS_RT = 592 * MiB;
constexpr size_t WS_XG = 596 * MiB;
constexpr size_t WS_HH = 740 * MiB;
constexpr size_t WS_MASK = 884 * MiB;
constexpr size_t WS_WRF = 900 * MiB;
constexpr size_t WS_S5T = 902 * MiB, S5T_STRIDE = 589824;
constexpr size_t WS_S5A = 920 * MiB;
constexpr size_t WS_S5E = 921 * MiB;
constexpr size_t WS_BASE = 922 * MiB;
constexpr size_t WS_END = 923 * MiB;
constexpr int CW_CNT = 64;
constexpr int CW_CUR = 128;
constexpr int CW_KMAX = 256;
constexpr int CW_ATTQ = 512;
constexpr int CW_GLUQ = 1280;
constexpr int CW_CVQ = 1344;
constexpr int CW_CVU = 1408;
constexpr int CW_BAR = 4096;

constexpr int RING_BYTES = 131072;
constexpr int MISC_OFF = RING_BYTES;
constexpr int LDS_BYTES = 147456;

#define GAS __attribute__((address_space(1)))
#define LAS __attribute__((address_space(3)))
typedef unsigned short bf16;
typedef unsigned v4u __attribute__((ext_vector_type(4)));
typedef unsigned v2u __attribute__((ext_vector_type(2)));
typedef float f32x4 __attribute__((ext_vector_type(4)));
typedef short bf16x8 __attribute__((ext_vector_type(8)));
#define LDS_WAIT() asm volatile("s_waitcnt lgkmcnt(0)" ::: "memory")
#define VM_WAIT() asm volatile("s_waitcnt vmcnt(0)" ::: "memory")
__device__ __forceinline__ unsigned pk2(float lo, float hi) { return pg8::cvt_pk_bf16(lo, hi); }
__device__ __forceinline__ unsigned f2bf(float f) { return pg8::cvt_pk_bf16(f, 0.f) & 0xffffu; }
__device__ __forceinline__ float bf2f(unsigned short h) { return __builtin_bit_cast(float, (unsigned)h << 16); }
__device__ __forceinline__ float bflo(unsigned w) { return __builtin_bit_cast(float, w << 16); }
__device__ __forceinline__ float bfhi(unsigned w) { return __builtin_bit_cast(float, w & 0xffff0000u); }
__device__ __forceinline__ float sigmoidf_(float x) { return __builtin_amdgcn_rcpf(1.0f + __builtin_amdgcn_exp2f(-1.4426950408889634f * x)); }
__device__ __forceinline__ float wave_sum(float v) {
#pragma unroll
    for (int o = 1; o < 64; o <<= 1) v += __shfl_xor(v, o);
    return v;
}
__device__ __forceinline__ float wave_max(float v) {
#pragma unroll
    for (int o = 1; o < 64; o <<= 1) v = fmaxf(v, __shfl_xor(v, o));
    return v;
}


typedef GAS unsigned gu32;
#define XB_TMO      128
#define XB_XCNT(j)  (256  + 64 * (j))
#define XB_XSUB(j)  (1280 + 64 * (j))
#define XB_XGEN(j)  (2304 + 64 * (j))
#define XB_TOP      3328
#define XB_TOPGEN   3392
#define XCD_BAR_WORDS 3456
#define XB_SPIN_CAP (1u << 22)
__device__ __forceinline__ unsigned xb_ld(unsigned* p)              { return __hip_atomic_load(p, __ATOMIC_RELAXED, __HIP_MEMORY_SCOPE_AGENT); }
__device__ __forceinline__ unsigned xb_add(unsigned* p, unsigned v) { return __hip_atomic_fetch_add(p, v, __ATOMIC_RELAXED, __HIP_MEMORY_SCOPE_AGENT); }
__device__ __forceinline__ unsigned xb_xcc_id() { return (unsigned)__builtin_amdgcn_s_getreg((3 << 11) | 20) & 0xFu; }
#define XB_SPIN(cond, bar) do { unsigned _sp = 0; while (cond) { __builtin_amdgcn_s_sleep(1); \
    if ((++_sp & 255u) == 0u) { if (xb_ld(&(bar)[XB_TMO])) break; if (_sp > XB_SPIN_CAP) { atomicAdd(&(bar)[XB_TMO], 1u); break; } } } } while (0)
struct XcdBarrier { unsigned* bar; unsigned x; volatile LAS unsigned* st; };
__device__ __forceinline__ XcdBarrier xcd_barrier_post(unsigned* bar, volatile LAS unsigned* st) {
    XcdBarrier b; b.bar = bar; b.x = xb_xcc_id(); b.st = st;
    if (threadIdx.x == 0) (void)xb_add(&bar[XB_XCNT(b.x)], 1u);
    return b;
}
__device__ __forceinline__ void xcd_barrier_complete(unsigned* bar, unsigned x, unsigned& nloc, unsigned& nx) {
    const unsigned G = gridDim.x * gridDim.y * gridDim.z;
    unsigned sum, cnt, mine, sp = 0u;
    for (;;) {
        sum = 0u; cnt = 0u; mine = 0u;
#pragma unroll
        for (unsigned j = 0; j < 16; ++j) { const unsigned c = xb_ld(&bar[XB_XCNT(j)]); sum += c; cnt += (c > 0u) ? 1u : 0u; mine = (j == x) ? c : mine; }
        if (sum == G) break;
        __builtin_amdgcn_s_sleep(1);
        if ((++sp & 255u) == 0u) { if (xb_ld(&bar[XB_TMO])) break; if (sp > XB_SPIN_CAP) { atomicAdd(&bar[XB_TMO], 1u); break; } }
    }
    nloc = mine > 0u ? mine : 1u; nx = cnt > 0u ? cnt : 1u;
}
__device__ __forceinline__ void xcd_barrier(const XcdBarrier& b) {
    asm volatile("s_waitcnt vmcnt(0)" ::: "memory");
    __syncthreads();
    if (threadIdx.x == 0) {
        unsigned* bar = b.bar;
        __builtin_amdgcn_s_waitcnt(0);
        unsigned nloc = b.st[0], nx = b.st[1];
        if (nloc == 0u) { xcd_barrier_complete(bar, b.x, nloc, nx); b.st[0] = nloc; b.st[1] = nx; }
        const unsigned old = xb_add(&bar[XB_XSUB(b.x)], 1u);
        const unsigned gen = old / nloc;
        if (old + 1u == (gen + 1u) * nloc) {
            __builtin_amdgcn_fence(__ATOMIC_RELEASE, "agent");
            asm volatile("s_waitcnt vmcnt(0)" ::: "memory");
            const unsigned og = xb_add(&bar[XB_TOP], 1u);
            const unsigned tg = og / nx;
            if (og + 1u == (tg + 1u) * nx) xb_add(&bar[XB_TOPGEN], 1u);
            else XB_SPIN(xb_ld(&bar[XB_TOPGEN]) == tg, bar);
            __builtin_amdgcn_fence(__ATOMIC_ACQUIRE, "agent");
            xb_add(&bar[XB_XGEN(b.x)], 1u);
            asm volatile("s_waitcnt vmcnt(0)" ::: "memory");
        } else {
            XB_SPIN(xb_ld(&bar[XB_XGEN(b.x)]) == gen, bar);
            __builtin_amdgcn_fence(__ATOMIC_ACQUIRE, "agent");
            asm volatile("s_waitcnt vmcnt(0)" ::: "memory");
        }
    }
    __syncthreads();
}

struct Args { const float* in[26]; float* out; unsigned char* ws; int ph_lo, ph_hi; };
struct Frame {
    LAS unsigned char* lds;
    int tid, lane, wave, vcu, G;
    unsigned char* ws;
};

__device__ __forceinline__ int colmap(int kind, int np, int halfn) {
    if (kind == 0) return np;
    if (kind == 1) { if (np < 2560) return np; if (np < 4608) return np + 72; if (np < 4680) return np - 2048; return -1; }
    const int j = np >> 8, c = np & 255; return c < 128 ? 128 * j + c : halfn + 128 * j + (c - 128);
}
__device__ __forceinline__ void p0_transpose_item(const float* W, int K, int Nsrc, int Ndst, int kind, bf16* WT, LAS float* scr, int item, int lane) {
    const int nblk = Ndst / 64, kb = item / nblk, nb = item % nblk, k0 = 64 * kb, n0 = 64 * nb;
    const int n4 = (lane & 15) * 4, col = colmap(kind, n0 + n4, Nsrc / 2);
    f32x4 vv[16];
#pragma unroll
    for (int i = 0; i < 16; ++i) { const int kk = 4 * i + (lane >> 4);
        vv[i] = col >= 0 ? __builtin_nontemporal_load((const f32x4*)(W + (size_t)(k0 + kk) * Nsrc + col)) : (f32x4){0.f, 0.f, 0.f, 0.f}; }
#pragma unroll
    for (int i = 0; i < 16; ++i) { const int kk = 4 * i + (lane >> 4); const f32x4 v = vv[i];
        LAS float* d = scr + kk * 65 + n4; d[0] = v[0]; d[1] = v[1]; d[2] = v[2]; d[3] = v[3]; }
    LDS_WAIT(); asm volatile("" ::: "memory");
    const int c = lane & 7;
#pragma unroll
    for (int j = 0; j < 8; ++j) { const int n = (lane >> 3) + 8 * j; const LAS float* sp = scr + (8 * c) * 65 + n;
        v4u o; o.x = pk2(sp[0 * 65], sp[1 * 65]); o.y = pk2(sp[2 * 65], sp[3 * 65]); o.z = pk2(sp[4 * 65], sp[5 * 65]); o.w = pk2(sp[6 * 65], sp[7 * 65]);
        *(GAS v4u*)(WT + (size_t)(n0 + n) * K + k0 + 8 * c) = o; }
    LDS_WAIT(); asm volatile("" ::: "memory");
}
__device__ __forceinline__ void ln_row(int lane, const float* arow, float ascale, const float* addrow, const float* g, const float* b, float* of32, bf16* obf, f32x4 (&v)[4], const bf16* arow_bf = nullptr, const bf16* add_bf = nullptr) {
    const GAS f32x4* xr = (const GAS f32x4*)arow + lane; float s = 0.f;
#pragma unroll
    for (int j = 0; j < 4; ++j) { if (arow_bf) { const v2u w = ((const GAS v2u*)arow_bf + lane)[64 * j]; v[j] = (f32x4){bflo(w.x), bfhi(w.x), bflo(w.y), bfhi(w.y)} * ascale; } else v[j] = xr[64 * j] * ascale; if (addrow) v[j] += ((const GAS f32x4*)addrow + lane)[64 * j];
        if (add_bf) { const v2u w2 = ((const GAS v2u*)add_bf + lane)[64 * j]; v[j] += (f32x4){bflo(w2.x), bfhi(w2.x), bflo(w2.y), bfhi(w2.y)}; } s += (v[j].x + v[j].y) + (v[j].z + v[j].w); }
    const float mean = wave_sum(s) * (1.f / D); float s2 = 0.f;
#pragma unroll
    for (int j = 0; j < 4; ++j) { v[j] = v[j] - mean; s2 += (v[j].x * v[j].x + v[j].y * v[j].y) + (v[j].z * v[j].z + v[j].w * v[j].w); }
    const float rstd = 1.f / sqrtf(wave_sum(s2) * (1.f / D) + LN_EPS);
#pragma unroll
    for (int j = 0; j < 4; ++j) { const f32x4 gg = ((const GAS f32x4*)g + lane)[64 * j], bb = ((const GAS f32x4*)b + lane)[64 * j]; v[j] = v[j] * rstd * gg + bb;
        if (of32) ((GAS f32x4*)of32 + lane)[64 * j] = v[j];
        if (obf) ((GAS v2u*)obf + lane)[64 * j] = (v2u){pk2(v[j].x, v[j].y), pk2(v[j].z, v[j].w)}; }
}
__device__ __forceinline__ void ln0_rows4(int lane, const float* x, size_t m0, size_t mstride, const float* g, const float* b, bf16* XN) {
    f32x4 v[4][4];
#pragma unroll
    for (int r = 0; r < 4; ++r)
#pragma unroll
        for (int j = 0; j < 4; ++j) v[r][j] = __builtin_nontemporal_load((const f32x4*)(x + (m0 + r * mstride) * D) + lane + 64 * j);
    f32x4 gg[4], bb[4];
#pragma unroll
    for (int j = 0; j < 4; ++j) { gg[j] = ((const GAS f32x4*)g + lane)[64 * j]; bb[j] = ((const GAS f32x4*)b + lane)[64 * j]; }
    float s[4], q[4];
#pragma unroll
    for (int r = 0; r < 4; ++r) { s[r] = 0.f;
#pragma unroll
        for (int j = 0; j < 4; ++j) s[r] += (v[r][j].x + v[r][j].y) + (v[r][j].z + v[r][j].w); }
#pragma unroll
    for (int o = 1; o < 64; o <<= 1)
#pragma unroll
        for (int r = 0; r < 4; ++r) s[r] += __shfl_xor(s[r], o);
#pragma unroll
    for (int r = 0; r < 4; ++r) { const float mean = s[r] * (1.f / D); q[r] = 0.f;
#pragma unroll
        for (int j = 0; j < 4; ++j) { v[r][j] = v[r][j] - mean; q[r] += (v[r][j].x * v[r][j].x + v[r][j].y * v[r][j].y) + (v[r][j].z * v[r][j].z + v[r][j].w * v[r][j].w); } }
#pragma unroll
    for (int o = 1; o < 64; o <<= 1)
#pragma unroll
        for (int r = 0; r < 4; ++r) q[r] += __shfl_xor(q[r], o);
#pragma unroll
    for (int r = 0; r < 4; ++r) { const float rstd = 1.f / sqrtf(q[r] * (1.f / D) + LN_EPS);
#pragma unroll
        for (int j = 0; j < 4; ++j) { const f32x4 y = v[r][j] * rstd * gg[j] + bb[j];
            ((GAS v2u*)(XN + (m0 + r * mstride) * D) + lane)[64 * j] = (v2u){pk2(y.x, y.y), pk2(y.z, y.w)}; } }
}
__device__ __forceinline__ void s5_tables(Frame& F, const Args& a, int g, int part);
__device__ __forceinline__ void p0_prologue(Frame& F, const Args& a) {
    LAS float* scr = (LAS float*)(F.lds + F.wave * 16640);
    const int gw = F.vcu * NWAVES + F.wave, NGW = F.G * NWAVES;
    constexpr int I_IN = (D / 64) * (IN_WP / 64), I_GLU = (SSMW / 64) * (2048 / 64), I_AP = (AW / 64) * (D / 64), I_O = (D / 64) * (D / 64);
    constexpr int NITEMS = I_IN + I_GLU + I_AP + I_O;
    for (int u = F.vcu; u < NG * 8; u += F.G) s5_tables(F, a, u >> 3, u & 7);
    for (int it = gw; it < NITEMS; it += NGW) {
        int r = it;
        if (r < I_IN) { p0_transpose_item(a.in[3], D, IN_W, IN_WP, 1, (bf16*)(F.ws + WS_WIN), scr, r, F.lane); continue; } r -= I_IN;
        if (r < I_GLU) { p0_transpose_item(a.in[13], SSMW, 2048, 2048, 2, (bf16*)(F.ws + WS_WGLU), scr, r, F.lane); continue; } r -= I_GLU;
        if (r < I_AP) { p0_transpose_item(a.in[14], AW, D, D, 0, (bf16*)(F.ws + WS_WAP), scr, r, F.lane); continue; } r -= I_AP;
        p0_transpose_item(a.in[15], D, D, D, 0, (bf16*)(F.ws + WS_WO), scr, r, F.lane);
    }
    for (int i = gw * 64 + F.lane; i < 128 * 64; i += NGW * 64) { const int t = i >> 6, l = i & 63; const float* wr = a.in[18] + (size_t)(8 * t + 4 * (l >> 5)) * NE + (l & 31);
        ((f32x4*)(F.ws + WS_WRF))[i] = (f32x4){wr[0], wr[NE], wr[2 * NE], wr[3 * NE]}; }
    for (int m = gw; m + 3 * NGW < T; m += 4 * NGW) ln0_rows4(F.lane, a.in[0], (size_t)m, (size_t)NGW, a.in[1], a.in[2], (bf16*)(F.ws + WS_XN));
}

using pg8::Unit; using pg8::HALF; using pg8::BM;
__device__ __forceinline__ v4u pack8(const f32x4 a, const f32x4 b) { v4u w; w.x = pg8::cvt_pk_bf16(a[0], a[1]); w.y = pg8::cvt_pk_bf16(a[2], a[3]); w.z = pg8::cvt_pk_bf16(b[0], b[1]); w.w = pg8::cvt_pk_bf16(b[2], b[3]); return w; }
struct EpiIn {
    static constexpr bool PERM = true;
    unsigned char* ws; const float* b_gate;
    __device__ __forceinline__ void operator()(const f32x4 (&acc)[2][2][4][2], const Unit& u, int wr, int wc, int fr, int fq) const {
        const int row0 = u.pm * BM + wr * 64 + fr, pn = u.pn;
        if (pn < 10) {
            const int t = pn >> 1; bf16* base = (bf16*)(ws + WS_U + (size_t)t * 16 * MiB); const float sc = (t == 1) ? 0.125f * LOG2E : 1.f;
            const int col0 = (pn & 1) * 256 + wc * 32 + 8 * fq;
#pragma unroll
            for (int ai = 0; ai < 2; ++ai)
#pragma unroll
                for (int m = 0; m < 4; ++m) { bf16* rowp = base + (size_t)(row0 + ai * HALF + m * 16) * 512 + col0;
#pragma unroll
                    for (int bj = 0; bj < 2; ++bj) *(v4u*)(rowp + bj * HALF) = pack8(acc[ai][bj][m][0] * sc, acc[ai][bj][m][1] * sc); }
        } else if (pn < 18) {
            bf16* base = (bf16*)(ws + WS_G); const int col0 = (pn - 10) * 256 + wc * 32 + 8 * fq;
            f32x4 bv[2][2];
#pragma unroll
            for (int bj = 0; bj < 2; ++bj)
#pragma unroll
                for (int n = 0; n < 2; ++n) bv[bj][n] = *(const f32x4*)(b_gate + col0 + bj * HALF + 4 * n) * (-LOG2E);
#pragma unroll
            for (int ai = 0; ai < 2; ++ai)
#pragma unroll
                for (int m = 0; m < 4; ++m) { bf16* rowp = base + (size_t)(row0 + ai * HALF + m * 16) * 2048 + col0;
#pragma unroll
                    for (int bj = 0; bj < 2; ++bj) { f32x4 v0, v1;
#pragma unroll
                        for (int i = 0; i < 4; ++i) { v0[i] = __builtin_amdgcn_rcpf(1.0f + __builtin_amdgcn_exp2f(__builtin_fmaf(acc[ai][bj][m][0][i], -LOG2E, bv[bj][0][i])));
                                                      v1[i] = __builtin_amdgcn_rcpf(1.0f + __builtin_amdgcn_exp2f(__builtin_fmaf(acc[ai][bj][m][1][i], -LOG2E, bv[bj][1][i]))); }
                        *(v4u*)(rowp + bj * HALF) = pack8(v0, v1); } }
        } else {
            if (wc < 2) {
                bf16* base = (bf16*)(ws + WS_KI); const int col0 = wc * 32 + 8 * fq;
#pragma unroll
                for (int ai = 0; ai < 2; ++ai)
#pragma unroll
                    for (int m = 0; m < 4; ++m) *(v4u*)(base + (size_t)(row0 + ai * HALF + m * 16) * 64 + col0) = pack8(acc[ai][0][m][0], acc[ai][0][m][1]);
            } else if (wc == 2 && fq == 0) {
                float* base = (float*)(ws + WS_WI);
#pragma unroll
                for (int ai = 0; ai < 2; ++ai)
#pragma unroll
                    for (int m = 0; m < 4; ++m) { float* p = base + (size_t)(row0 + ai * HALF + m * 16) * 8; *(f32x4*)p = acc[ai][0][m][0]; *(f32x4*)(p + 4) = acc[ai][0][m][1]; }
            }
        }
    }
};
struct EpiGlu {
    static constexpr bool PERM = true;
    unsigned char* ws;
    __device__ __forceinline__ void operator()(const f32x4 (&acc)[2][2][4][2], const Unit& u, int wr, int wc, int fr, int fq) const {
        const int row0 = u.pm * BM + wr * 64 + fr, col0 = u.pn * 128 + wc * 32 + 8 * fq;
        const bf16* G = (const bf16*)(ws + WS_G); bf16* Z = (bf16*)(ws + WS_Z);
#pragma unroll
        for (int ai = 0; ai < 2; ++ai)
#pragma unroll
            for (int m = 0; m < 4; ++m) { const size_t r = (size_t)(row0 + ai * HALF + m * 16);
                const v4u gw = *(const v4u*)(G + r * 2048 + col0);
                const float gs[8] = {bflo(gw.x), bfhi(gw.x), bflo(gw.y), bfhi(gw.y), bflo(gw.z), bfhi(gw.z), bflo(gw.w), bfhi(gw.w)};
                f32x4 o0, o1;
#pragma unroll
                for (int i = 0; i < 4; ++i) { o0[i] = gs[i] * acc[ai][0][m][0][i] * sigmoidf_(acc[ai][1][m][0][i]); o1[i] = gs[4 + i] * acc[ai][0][m][1][i] * sigmoidf_(acc[ai][1][m][1][i]); }
                *(v4u*)(Z + r * 1024 + col0) = pack8(o0, o1); }
    }
};
struct EpiAtt {
    static constexpr bool PERM = true;
    unsigned char* ws;
    __device__ __forceinline__ void operator()(const f32x4 (&acc)[2][2][4][2], const Unit& u, int wr, int wc, int fr, int fq) const {
        const int row0 = u.pm * BM + wr * 64 + fr, col0 = u.pn * 256 + wc * 32 + 8 * fq;
        const bf16* G = (const bf16*)(ws + WS_G); bf16* Z = (bf16*)(ws + WS_Z);
#pragma unroll
        for (int ai = 0; ai < 2; ++ai)
#pragma unroll
            for (int m = 0; m < 4; ++m) { const size_t r = (size_t)(row0 + ai * HALF + m * 16);
#pragma unroll
                for (int bj = 0; bj < 2; ++bj) { const int c = col0 + bj * HALF;
                    const v4u gw = *(const v4u*)(G + r * 2048 + 1024 + c); const v4u zw = *(const v4u*)(Z + r * 1024 + c);
                    const float gs[8] = {bflo(gw.x), bfhi(gw.x), bflo(gw.y), bfhi(gw.y), bflo(gw.z), bfhi(gw.z), bflo(gw.w), bfhi(gw.w)};
                    const float zs[8] = {bflo(zw.x), bfhi(zw.x), bflo(zw.y), bfhi(zw.y), bflo(zw.z), bfhi(zw.z), bflo(zw.w), bfhi(zw.w)};
                    f32x4 o0, o1;
#pragma unroll
                    for (int i = 0; i < 4; ++i) { o0[i] = zs[i] + gs[i] * acc[ai][bj][m][0][i]; o1[i] = zs[4 + i] + gs[4 + i] * acc[ai][bj][m][1][i]; }
                    *(v4u*)(Z + r * 1024 + c) = pack8(o0, o1); } }
    }
};
struct EpiF32 {
    static constexpr bool PERM = false;
    float* C; int ldc;
    __device__ __forceinline__ void operator()(const f32x4 (&acc)[2][2][4][2], const Unit& u, int wr, int wc, int fr, int fq) const {
        const int row0 = u.pm * BM + wr * 64 + fr, col0 = u.pn * BM + wc * 32 + 4 * fq;
#pragma unroll
        for (int ai = 0; ai < 2; ++ai)
#pragma unroll
            for (int m = 0; m < 4; ++m) { float* rowp = C + (size_t)(row0 + ai * HALF + m * 16) * ldc + col0;
#pragma unroll
                for (int bj = 0; bj < 2; ++bj)
#pragma unroll
                    for (int n = 0; n < 2; ++n) *(f32x4*)(rowp + bj * HALF + n * 16) = acc[ai][bj][m][n]; }
    }
};
struct EpiMix {
    static constexpr bool PERM = true;
    bf16* C;
    __device__ __forceinline__ void operator()(const f32x4 (&acc)[2][2][4][2], const Unit& u, int wr, int wc, int fr, int fq) const {
        const int row0 = u.pm * BM + wr * 64 + fr, col0 = u.pn * BM + wc * 32 + 8 * fq;
#pragma unroll
        for (int ai = 0; ai < 2; ++ai)
#pragma unroll
            for (int m = 0; m < 4; ++m) { bf16* rowp = C + (size_t)(row0 + ai * HALF + m * 16) * D + col0;
#pragma unroll
                for (int bj = 0; bj < 2; ++bj) *(v4u*)(rowp + bj * HALF) = pack8(acc[ai][bj][m][0], acc[ai][bj][m][1]); }
    }
};
struct EpiSwiglu {
    static constexpr bool PERM = true;
    unsigned char* ws; const float* b_up;
    __device__ __forceinline__ void operator()(const f32x4 (&acc)[2][2][4][2], const Unit& u, int wr, int wc, int fr, int fq) const {
        const int row0 = u.pm * BM + wr * 64 + fr, cl = wc * 32 + 8 * fq, col0 = u.pn * 128 + cl;
        const float* bg = b_up + (size_t)u.e * 2048 + u.pn * 128 + cl; const float* bl = bg + 1024;
        bf16* HHp = (bf16*)(ws + WS_HH);
        f32x4 bgv[2], blv[2];
#pragma unroll
        for (int n = 0; n < 2; ++n) { bgv[n] = *(const f32x4*)(bg + 4 * n); blv[n] = *(const f32x4*)(bl + 4 * n) + 1.0f; }
#pragma unroll
        for (int ai = 0; ai < 2; ++ai)
#pragma unroll
            for (int m = 0; m < 4; ++m) { const size_t r = (size_t)(row0 + ai * HALF + m * 16);
                f32x4 o[2];
#pragma unroll
                for (int n = 0; n < 2; ++n)
#pragma unroll
                    for (int i = 0; i < 4; ++i) { float hg = acc[ai][0][m][n][i] + bgv[n][i], hl = acc[ai][1][m][n][i] + blv[n][i];
                        hg = fminf(hg, 7.0f); hl = __builtin_amdgcn_fmed3f(hl, -6.0f, 8.0f);
                        o[n][i] = hl * (hg * __builtin_amdgcn_rcpf(1.0f + __builtin_amdgcn_exp2f(hg * (-1.702f * 1.4426950408889634f)))); }
                *(v4u*)(HHp + r * 1024 + col0) = pack8(o[0], o[1]); }
    }
};
struct EpiDown {
    static constexpr bool PERM = true;
    unsigned char* ws; const float* b_down; const float* row_gate;
    __device__ __forceinline__ void operator()(const f32x4 (&acc)[2][2][4][2], const Unit& u, int wr, int wc, int fr, int fq) const {
        const int row0 = u.pm * BM + wr * 64 + fr, col0 = u.pn * 256 + wc * 32 + 8 * fq;
        const float* bd = b_down + (size_t)u.e * 1024 + col0; bf16* Y = (bf16*)(ws + WS_XG);
        f32x4 bv[2][2];
#pragma unroll
        for (int bj = 0; bj < 2; ++bj)
#pragma unroll
            for (int n = 0; n < 2; ++n) bv[bj][n] = *(const f32x4*)(bd + bj * HALF + 4 * n);
#pragma unroll
        for (int ai = 0; ai < 2; ++ai)
#pragma unroll
            for (int m = 0; m < 4; ++m) { const size_t r = (size_t)(row0 + ai * HALF + m * 16); const float gt = row_gate[r];
#pragma unroll
                for (int bj = 0; bj < 2; ++bj) *(v4u*)(Y + r * 1024 + col0 + bj * HALF) = pack8((acc[ai][bj][m][0] + bv[bj][0]) * gt, (acc[ai][bj][m][1] + bv[bj][1]) * gt); }
    }
};

struct S5Lane { float ar, ai; float br[GP], bi[GP]; };
__device__ __forceinline__ void s5_lane_setup(const Args& a, int g, int n, S5Lane& L) {
    const float lr = a.in[5][g * NS + n], li = a.in[6][g * NS + n], dt = expf(a.in[7][g]);
    const float er = expf(lr * dt); L.ar = er * cosf(li * dt); L.ai = er * sinf(li * dt);
    const float nr = L.ar - 1.f, ni = L.ai, den = lr * lr + li * li; const float fr_ = (nr * lr + ni * li) / den, fi_ = (ni * lr - nr * li) / den;
#pragma unroll
    for (int p = 0; p < GP; ++p) { const float b_r = a.in[8][(g * NS + n) * GP + p], b_i = a.in[9][(g * NS + n) * GP + p]; L.br[p] = fr_ * b_r - fi_ * b_i; L.bi[p] = fr_ * b_i + fi_ * b_r; }
}
__device__ __forceinline__ float gelu_tanh(float x) { const float t = 0.7978845608028654f * (x + 0.044715f * x * x * x); const float e = __builtin_amdgcn_exp2f(2.885390081777927f * t); return x * (1.f - __builtin_amdgcn_rcpf(e + 1.f)); }
__device__ __forceinline__ void s5_tables(Frame& F, const Args& a, int g, int part) {
    typedef float f32x2 __attribute__((ext_vector_type(2)));
    LAS f32x2* pwr = (LAS f32x2*)F.lds;
    LAS f32x2* bbl = (LAS f32x2*)(F.lds + 33280);
    LAS f32x2* ccl = (LAS f32x2*)(F.lds + 33280 + 8192);
    const int tid = F.tid;
    __syncthreads();
    if (tid < 64) { S5Lane L; s5_lane_setup(a, g, tid, L);
#pragma unroll
        for (int p = 0; p < GP; ++p) bbl[tid * GP + p] = (f32x2){L.br[p], L.bi[p]};
        float pr = 1.f, pi = 0.f;
        for (int m = 0; m <= 64; ++m) { pwr[m * 64 + tid] = (f32x2){pr, pi}; const float nr = pr * L.ar - pi * L.ai, ni = pr * L.ai + pi * L.ar; pr = nr; pi = ni; }
        if (part == 0) { const f32x2 a64 = pwr[64 * 64 + tid]; float qr = a64.x, qi = a64.y;
            ((f32x2*)(F.ws + WS_S5A))[g * 64 + tid] = a64;
#pragma unroll
            for (int k = 0; k < 5; ++k) { const float nr = qr * qr - qi * qi, ni = 2.f * qr * qi; qr = nr; qi = ni; }
            ((f32x2*)(F.ws + WS_S5A + 16384))[g * 64 + tid] = (f32x2){qr, qi}; } }
    for (int e = tid; e < GP * NS; e += NTHR) ccl[e] = (f32x2){a.in[10][(size_t)g * GP * NS + e], a.in[11][(size_t)g * GP * NS + e]};
    __syncthreads();
    unsigned char* base = F.ws + WS_S5T + (size_t)g * S5T_STRIDE;
    for (int e = part * 2048 + tid; e < (part + 1) * 2048; e += NTHR) {
        const int lane = e & 63, jp = (e >> 6) & 63, rt = e >> 12, r = lane & 31, h = lane >> 5, n = (32 * rt + r) & 63, ri = rt >> 1;
        const f32x2 pw = pwr[(63 - jp) * 64 + n]; float v[8];
#pragma unroll
        for (int jj = 0; jj < 8; ++jj) { const f32x2 b = bbl[n * GP + 8 * h + jj]; v[jj] = ri == 0 ? pw.x * b.x - pw.y * b.y : pw.x * b.y + pw.y * b.x; }
        ((v4u*)base)[e] = (v4u){pk2(v[0], v[1]), pk2(v[2], v[3]), pk2(v[4], v[5]), pk2(v[6], v[7])}; }
    for (int e = part * 2048 + tid; e < (part + 1) * 2048; e += NTHR) {
        const int lane = e & 63, ks = (e >> 6) & 7, i = e >> 9, r = lane & 31, h = lane >> 5, lp = 2 * i + (r >> 4), pp = r & 15; float v[8];
#pragma unroll
        for (int jj = 0; jj < 8; ++jj) { const int comp = 16 * ks + 8 * h + jj, ri = comp >> 6, n = comp & 63;
            const f32x2 c = ccl[pp * NS + n]; const f32x2 pw = pwr[(lp + 1) * 64 + n];
            v[jj] = ri == 0 ? c.x * pw.x - c.y * pw.y : -(c.x * pw.y + c.y * pw.x); }
        ((v4u*)(base + 262144))[e] = (v4u){pk2(v[0], v[1]), pk2(v[2], v[3]), pk2(v[4], v[5]), pk2(v[6], v[7])}; }
    for (int e = part * 2080 + tid; e < (part + 1) * 2080; e += NTHR) {
        const int blk = e >> 8, po = (e >> 4) & 15, pi = e & 15; float acc = 0.f;
        if (blk > 0) { const int m = blk - 1;
            for (int n = 0; n < NS; ++n) { const f32x2 c = ccl[po * NS + n], pw = pwr[m * 64 + n], b = bbl[n * GP + pi];
                const float tr = pw.x * b.x - pw.y * b.y, ti = pw.x * b.y + pw.y * b.x; acc += c.x * tr - c.y * ti; }
            if (m == 0 && po == pi) acc += a.in[12][g * GP + po]; }
        ((bf16*)(base + 524288))[e] = (bf16)f2bf(acc); }
    __syncthreads();
}
namespace s5 {
using bf16x8 = __attribute__((ext_vector_type(8))) short;
using f32x16 = __attribute__((ext_vector_type(16))) float;
typedef float f32x2 __attribute__((ext_vector_type(2)));
constexpr int CSTR = 2064;
constexpr int U_OFF = 0, KF_OFF = 32 * CSTR, SLOC_OFF = KF_OFF + 33280, TMP_OFF = SLOC_OFF + 128 * 33 * 4;
__device__ __forceinline__ int crow(int r, int hi) { return (r & 3) + 8 * (r >> 2) + 4 * hi; }
__device__ __forceinline__ void phase_a(Frame& F) {
    const int v = F.vcu, b = v >> 7, g = (v >> 2) & 31, seg = v & 3, tid = F.tid, lane = F.lane, wave = F.wave;
    LAS unsigned char* lds = F.lds; const unsigned char* tb = F.ws + WS_S5T + (size_t)g * S5T_STRIDE;
    const bf16* U = (const bf16*)(F.ws + WS_U) + ((size_t)b * SEQ + (size_t)seg * 2048) * SSMW + g * GP;
#pragma unroll
    for (int i = 0; i < 8; ++i) { const int pc = tid + NTHR * i, tk = pc >> 1, hf = pc & 1;
        *(LAS v4u*)(lds + U_OFF + (tk >> 6) * CSTR + (tk & 63) * 32 + hf * 16) = *(const v4u*)(U + (size_t)tk * SSMW + hf * 8); }
    for (int pc = tid; pc < 2080; pc += NTHR) *(LAS v4u*)(lds + KF_OFF + pc * 16) = ((const v4u*)(tb + 524288))[pc];
    bf16x8 wa[32];
    { const bf16x8* wsf = (const bf16x8*)tb + (size_t)((wave & 3) * 64 + (wave >> 2) * 32) * 64 + lane;
#pragma unroll
      for (int jj = 0; jj < 32; ++jj) wa[jj] = wsf[jj * 64]; }
    __syncthreads();
    { const int rt = wave & 3, kh = wave >> 2; f32x16 acc = {};
      const LAS unsigned char* ub = lds + U_OFF + (lane & 31) * CSTR + (lane >> 5) * 16 + kh * 32 * 32;
#pragma unroll
      for (int jj = 0; jj < 32; ++jj) acc = __builtin_amdgcn_mfma_f32_32x32x16_bf16(wa[jj], *(const LAS bf16x8*)(ub + jj * 32), acc, 0, 0, 0);
      LAS float* tmp = (LAS float*)(lds + TMP_OFF); LAS float* sloc = (LAS float*)(lds + SLOC_OFF);
      if (kh == 1) {
#pragma unroll
          for (int r = 0; r < 16; ++r) tmp[(rt * 16 + r) * 64 + lane] = acc[r]; }
      __syncthreads();
      if (kh == 0) {
#pragma unroll
          for (int r = 0; r < 16; ++r) sloc[(32 * rt + crow(r, lane >> 5)) * 33 + (lane & 31)] = acc[r] + tmp[(rt * 16 + r) * 64 + lane]; }
      __syncthreads(); }
    if (tid < 64) { const f32x2 a64 = ((const f32x2*)(F.ws + WS_S5A))[g * 64 + tid]; const LAS float* sloc = (const LAS float*)(lds + SLOC_OFF); float zr = 0.f, zi = 0.f;
        for (int c = 0; c < 32; ++c) { const float lr = sloc[tid * 33 + c], li = sloc[(64 + tid) * 33 + c]; const float nr = a64.x * zr - a64.y * zi + lr, ni = a64.x * zi + a64.y * zr + li; zr = nr; zi = ni; }
        ((f32x2*)(F.ws + WS_S5E))[(size_t)v * 64 + tid] = (f32x2){zr, zi}; }
}
__device__ __forceinline__ void phase_b(Frame& F) {
    const int v = F.vcu, b = v >> 7, g = (v >> 2) & 31, seg = v & 3, tid = F.tid, lane = F.lane, wave = F.wave;
    LAS unsigned char* lds = F.lds; const unsigned char* tb = F.ws + WS_S5T + (size_t)g * S5T_STRIDE;
    bf16x8 wy[4][8];
    { const bf16x8* wyf0 = (const bf16x8*)(tb + 262144) + lane;
#pragma unroll
      for (int q = 0; q < 4; ++q) { const int i = q == 0 ? wave : q == 1 ? 15 - wave : q == 2 ? 16 + wave : 31 - wave;
#pragma unroll
          for (int ks = 0; ks < 8; ++ks) wy[q][ks] = wyf0[(size_t)(i * 8 + ks) * 64]; } }
    if (tid < 64) { const f32x2 a64 = ((const f32x2*)(F.ws + WS_S5A))[g * 64 + tid], aS = ((const f32x2*)(F.ws + WS_S5A + 16384))[g * 64 + tid];
        const LAS float* sloc = (const LAS float*)(lds + SLOC_OFF); LAS bf16* sinb = (LAS bf16*)(lds + TMP_OFF);
        float sr = 0.f, si = 0.f;
        for (int j = 0; j < seg; ++j) { const f32x2 e = ((const f32x2*)(F.ws + WS_S5E))[(size_t)(v - seg + j) * 64 + tid]; const float nr = aS.x * sr - aS.y * si + e.x, ni = aS.x * si + aS.y * sr + e.y; sr = nr; si = ni; }
        const int n = tid, ore = (((n >> 4) * 64 + ((n >> 3) & 1) * 32) * 8) + (n & 7), oim = ore + 4 * 64 * 8;
        for (int c = 0; c < 32; ++c) { sinb[ore + c * 8] = (bf16)f2bf(sr); sinb[oim + c * 8] = (bf16)f2bf(si);
            const float lr = sloc[n * 33 + c], li = sloc[(64 + n) * 33 + c]; const float nr = a64.x * sr - a64.y * si + lr, ni = a64.x * si + a64.y * sr + li; sr = nr; si = ni; } }
    __syncthreads();
    const int r32 = lane & 31, h = lane >> 5;
    const LAS unsigned char* ub = lds + U_OFF + r32 * CSTR + h * 16; const LAS unsigned char* kfb = lds + KF_OFF + r32 * 32 + h * 16; const LAS bf16x8* sb = (const LAS bf16x8*)(lds + TMP_OFF) + lane;
    bf16* YG = (bf16*)(F.ws + WS_YG) + ((size_t)b * SEQ + (size_t)seg * 2048 + (size_t)r32 * 64) * SSMW + g * GP + 4 * h;
#pragma unroll
    for (int q = 0; q < 4; ++q) { const int i = q == 0 ? wave : q == 1 ? 15 - wave : q == 2 ? 16 + wave : 31 - wave;
        f32x16 acc = {};
#pragma unroll
        for (int ks = 0; ks < 8; ++ks) acc = __builtin_amdgcn_mfma_f32_32x32x16_bf16(wy[q][ks], sb[ks * 64], acc, 0, 0, 0);
        const int nj = 2 * i + 2;
#pragma unroll 2
        for (int j = 0; j < nj; ++j) acc = __builtin_amdgcn_mfma_f32_32x32x16_bf16(*(const LAS bf16x8*)(kfb + (2 * i - j + 1) * 512), *(const LAS bf16x8*)(ub + j * 32), acc, 0, 0, 0);
#pragma unroll
        for (int k = 0; k < 4; ++k) { const int tok = 2 * i + (k >> 1), pc = (k & 1) * 8;
            const float o0 = gelu_tanh(acc[4 * k]), o1 = gelu_tanh(acc[4 * k + 1]), o2 = gelu_tanh(acc[4 * k + 2]), o3 = gelu_tanh(acc[4 * k + 3]);
            *(v2u*)(YG + (size_t)tok * SSMW + pc) = (v2u){pk2(o0, o1), pk2(o2, o3)}; } }
    __syncthreads();
}
}

namespace idx {
using bf16x8 = __attribute__((ext_vector_type(8))) short;
using f32x16 = __attribute__((ext_vector_type(16))) float;
constexpr int CAPT = 16, CAPQ = 96, CREF = 64;
constexpr int QF_OFF = 65536, CTOT_OFF = 131072, PFX_OFF = CTOT_OFF + 2048, NEED_OFF = PFX_OFF + 128, OFLAG_OFF = NEED_OFF + 128, RFLAG_OFF = OFLAG_OFF + 4;
__device__ __forceinline__ unsigned key32(float x) { const unsigned u = __builtin_bit_cast(unsigned, x); return u ^ ((unsigned)((int)u >> 31) | 0x80000000u); }
__device__ __forceinline__ int crow(int r, int hi) { return (r & 3) + 8 * (r >> 2) + 4 * hi; }
__device__ __forceinline__ void load_k(bf16x8 (&kf)[4], const unsigned short* KI, size_t row, int hi) {
#pragma unroll
    for (int ks = 0; ks < 4; ++ks) kf[ks] = *(const bf16x8*)(KI + row * 64 + ks * 16 + hi * 8);
}
struct NoHook { __device__ __forceinline__ void operator()(int) const {} };
template <class Hook = NoHook> __device__ __forceinline__ void score_tile(float (&sc)[16], const bf16x8 (&kf)[4], const LAS unsigned char* qfl  , const float (&wh)[8], const Hook& hook = Hook()) {
    bf16x8 fq[2][4]; f32x16 aclin, ac[2];
#pragma unroll
    for (int st = 0; st <= 10; ++st) {
        if (st <= 8) { const int li = st == 0 ? 8 : st - 1;
#pragma unroll
            for (int ks = 0; ks < 4; ++ks) fq[st % 2][ks] = *(const LAS bf16x8*)(qfl + (li * 4 + ks) * 1024); }
        if (st >= 1 && st <= 9) { const int it = st - 1; f32x16 a = {};
#pragma unroll
            for (int ks = 0; ks < 4; ++ks) a = __builtin_amdgcn_mfma_f32_32x32x16_bf16(kf[ks], fq[it % 2][ks], a, 0, 0, 0);
            if (it == 0) aclin = a; else ac[it & 1] = a; }
        if (st >= 3) { const int it = st - 2;
#pragma unroll
            for (int r = 0; r < 16; ++r) { sc[r] = __builtin_fmaf(wh[it - 1], __builtin_fabsf(ac[it & 1][r]), it == 1 ? aclin[r] : sc[r]); asm volatile("" : "+v"(sc[r])); } }
        hook(st);
        __builtin_amdgcn_sched_barrier(0);
    }
}
__device__ __forceinline__ void score_tile2(float (&sa)[16], float (&sb)[16], const bf16x8 (&ka)[4], const bf16x8 (&kb)[4], const LAS unsigned char* qfl  , const float (&wh)[8]) {
    bf16x8 fq[2][4]; f32x16 aa[2], ab[2];
#pragma unroll
    for (int st = 0; st <= 10; ++st) {
        if (st <= 8) { const int li = st == 0 ? 8 : st - 1;
#pragma unroll
            for (int ks = 0; ks < 4; ++ks) fq[st % 2][ks] = *(const LAS bf16x8*)(qfl + (li * 4 + ks) * 1024); }
        if (st >= 1 && st <= 9) { const int it = st - 1; f32x16 a = {}, b = {};
#pragma unroll
            for (int ks = 0; ks < 4; ++ks) { a = __builtin_amdgcn_mfma_f32_32x32x16_bf16(ka[ks], fq[it % 2][ks], a, 0, 0, 0); b = __builtin_amdgcn_mfma_f32_32x32x16_bf16(kb[ks], fq[it % 2][ks], b, 0, 0, 0); }
            aa[it & 1] = a; ab[it & 1] = b; }
        if (st == 2) {
#pragma unroll
            for (int r = 0; r < 16; ++r) { sa[r] = aa[0][r]; sb[r] = ab[0][r]; } }
        if (st >= 3) { const int it = st - 2;
#pragma unroll
            for (int r = 0; r < 16; ++r) { sa[r] = __builtin_fmaf(wh[it - 1], __builtin_fabsf(aa[it & 1][r]), sa[r]); asm volatile("" : "+v"(sa[r]));
                                           sb[r] = __builtin_fmaf(wh[it - 1], __builtin_fabsf(ab[it & 1][r]), sb[r]); asm volatile("" : "+v"(sb[r])); } }
        __builtin_amdgcn_sched_barrier(0);
    }
}
template <int PASS, bool DIAG> __device__ __forceinline__ void hist_tile(const float (&sc)[16], unsigned hbase  , unsigned pfx, int q, int hi) {
    constexpr int SH = PASS == 0 ? 22 : PASS == 1 ? 11 : 0, SHP = PASS == 1 ? 22 : 11;
#pragma unroll
    for (int r = 0; r < 16; ++r) { const unsigned u = key32(sc[r]);
        bool ok = !DIAG || crow(r, hi) <= q; if (PASS > 0) ok = ok && ((u >> SHP) == pfx);
        if (PASS == 0) { if (ok) { const unsigned ad = hbase + ((u >> 23) << 7); const unsigned val = ((u >> 22) & 1u) * 0xffffu + 1u;
                                   __hip_atomic_fetch_add((LAS unsigned*)(uintptr_t)ad, val, __ATOMIC_RELAXED, __HIP_MEMORY_SCOPE_WORKGROUP); } }
        else if (__any(ok)) { if (ok) { const unsigned bin = (u >> SH) & 2047u; const unsigned ad = hbase + ((bin >> 1) << 7); const unsigned val = (bin & 1u) * 0xffffu + 1u;
                                   __hip_atomic_fetch_add((LAS unsigned*)(uintptr_t)ad, val, __ATOMIC_RELAXED, __HIP_MEMORY_SCOPE_WORKGROUP); } } }
}
__device__ __forceinline__ float lin_x(float s, float aq) { return __builtin_fmaf(s, aq, __builtin_amdgcn_fmed3f(__builtin_fmaf(s, aq * 16.0f, 512.0f), 384.0f, 640.0f)); }
__device__ __forceinline__ unsigned lin_bin(float s, float aq) { return (unsigned)__builtin_amdgcn_fmed3f(lin_x(s, aq), 0.0f, 1023.0f); }
__device__ __forceinline__ unsigned sub_bin(float s, float aq, unsigned bn) { return (unsigned)__builtin_amdgcn_fmed3f((lin_x(s, aq) - (float)bn) * 2048.0f, 0.0f, 2047.0f); }
template <bool REF> __device__ __forceinline__ unsigned cls_id(float s, float aq) { const unsigned bn = lin_bin(s, aq); if constexpr (REF) return (bn << 11) | sub_bin(s, aq, bn); else return bn; }
template <bool DIAG> __device__ __forceinline__ void hist_tile_sub(const float (&sc)[16], unsigned hbase, unsigned pfx, float aq, int q, int hi) {
#pragma unroll
    for (int r = 0; r < 16; ++r) { const unsigned bn = lin_bin(sc[r], aq); const bool ok = (!DIAG || crow(r, hi) <= q) && bn == pfx;
        if (__any(ok)) { if (ok) { const unsigned sb = sub_bin(sc[r], aq, bn); const unsigned ad = hbase + ((sb >> 1) << 7); const unsigned val = (sb & 1u) * 0xffffu + 1u;
            __hip_atomic_fetch_add((LAS unsigned*)(uintptr_t)ad, val, __ATOMIC_RELAXED, __HIP_MEMORY_SCOPE_WORKGROUP); } } }
}
template <bool DIAG, int R0 = 0, int R1 = 16> __device__ __forceinline__ void hist_tile_lin(const float (&sc)[16], unsigned hbase, float aq, int q, int hi) {
#pragma unroll
    for (int r = R0; r < R1; ++r) { const unsigned bn = lin_bin(sc[r], aq);
        if (!DIAG || crow(r, hi) <= q) { const unsigned ad = hbase + ((bn >> 1) << 7); const unsigned val = (bn & 1u) * 0xffffu + 1u;
            __hip_atomic_fetch_add((LAS unsigned*)(uintptr_t)ad, val, __ATOMIC_RELAXED, __HIP_MEMORY_SCOPE_WORKGROUP); } }
}
template <int PASS> __device__ __forceinline__ void scan_hist(LAS unsigned char* lds, int tid, int lane, int wave) {
    constexpr int NB = PASS == 0 ? 1024 : 2048, NBITS = PASS == 0 ? 10 : 11, NCH = NB / 128;
    LAS unsigned* hist = (LAS unsigned*)lds; LAS unsigned* ctot = (LAS unsigned*)(lds + CTOT_OFF); LAS unsigned* PFX = (LAS unsigned*)(lds + PFX_OFF); LAS unsigned* NEED = (LAS unsigned*)(lds + NEED_OFF);
    { const int q = lane & 31, c = 2 * wave + (lane >> 5);
      if (c < NCH) { unsigned tot = 0u;
#pragma unroll 8
          for (int i = 0; i < 64; ++i) { const unsigned d = hist[(c * 64 + i) * 32 + q]; tot += (d & 0xffffu) + (d >> 16); }
          ctot[c * 32 + q] = tot; }
      __syncthreads(); }
    if (tid < 32) { const int q = tid; const unsigned need = PASS == 0 ? (unsigned)TOPK : NEED[q]; unsigned cum = 0u; int cs = 0; bool found = false;
#pragma unroll
        for (int c = NCH - 1; c >= 0; --c) { const unsigned t = ctot[c * 32 + q]; if (!found) { if (cum + t >= need) { found = true; cs = c; } else cum += t; } }
        int bin = 0; unsigned rem = 1u, pop = 0u; bool f2 = false;
        for (int i = 63; i >= 0; --i) { const unsigned d = hist[(cs * 64 + i) * 32 + q]; const unsigned hi16 = d >> 16, lo16 = d & 0xffffu;
            if (!f2) { if (cum + hi16 >= need) { f2 = true; bin = (cs * 64 + i) * 2 + 1; rem = need - cum; pop = hi16; } else cum += hi16; }
            if (!f2) { if (cum + lo16 >= need) { f2 = true; bin = (cs * 64 + i) * 2; rem = need - cum; pop = lo16; } else cum += lo16; } }
        const unsigned pf = PASS == 0 ? 0u : PFX[q];
        PFX[q] = (pf << NBITS) | (unsigned)bin; NEED[q] = rem;
        if (PASS == 0 && pop > (unsigned)CREF) *(LAS unsigned*)(lds + RFLAG_OFF) = 1u; }
    __syncthreads();
}
__device__ __forceinline__ void zero_hist(LAS unsigned char* lds, int tid, int n16  ) {
    const f32x4 z = {0.f, 0.f, 0.f, 0.f};
    for (int i = 0; i < n16; ++i) *(LAS f32x4*)(lds + (size_t)(i * NTHR + tid) * 16) = z;
    __syncthreads();
}
__device__ __forceinline__ void pass0(LAS unsigned char* lds, const unsigned short* KI, float* SC, size_t krow0, int qgb, const float (&wh)[8], float aq, int tid, int lane, int wave) {
    const int q = lane & 31, hi = lane >> 5;
    zero_hist(lds, tid, 8);
    const LAS unsigned char* qfl = lds + QF_OFF + lane * 16; const unsigned hbase = (unsigned)(uintptr_t)lds + 4u * (unsigned)q;
    bf16x8 kfa[4], kfb[4], kna[4], knb[4];
    auto tclamp = [&](int t) { return t <= qgb ? t : qgb; };
    if (wave <= qgb) { load_k(kfa, KI, krow0 + (size_t)wave * 32 + q, hi); load_k(kfb, KI, krow0 + (size_t)tclamp(wave + 8) * 32 + q, hi); }
    int kt32 = wave;
    for (; kt32 + 8 <= qgb; kt32 += 16) {
        load_k(kna, KI, krow0 + (size_t)tclamp(kt32 + 16) * 32 + q, hi); load_k(knb, KI, krow0 + (size_t)tclamp(kt32 + 24) * 32 + q, hi);
        float sa[16], sb[16]; score_tile2(sa, sb, kfa, kfb, qfl, wh);
        float* st = SC + (size_t)kt32 * 1024 + lane;
#pragma unroll
        for (int r = 0; r < 16; ++r) { __builtin_nontemporal_store(sa[r], st + r * 64); __builtin_nontemporal_store(sb[r], st + 8192 + r * 64); }
        hist_tile_lin<false>(sa, hbase, aq, q, hi);
        if (kt32 + 8 == qgb) hist_tile_lin<true>(sb, hbase, aq, q, hi); else hist_tile_lin<false>(sb, hbase, aq, q, hi);
#pragma unroll
        for (int ks = 0; ks < 4; ++ks) { kfa[ks] = kna[ks]; kfb[ks] = knb[ks]; }
    }
    if (kt32 <= qgb) {
        float sc[16]; score_tile(sc, kfa, qfl, wh);
        float* st = SC + (size_t)kt32 * 1024 + lane;
#pragma unroll
        for (int r = 0; r < 16; ++r) __builtin_nontemporal_store(sc[r], st + r * 64);
        if (kt32 == qgb) hist_tile_lin<true>(sc, hbase, aq, q, hi); else hist_tile_lin<false>(sc, hbase, aq, q, hi);
    }
    __syncthreads();
    scan_hist<0>(lds, tid, lane, wave);
}
__device__ __forceinline__ void load_sc(float (&sc)[16], const float* SC, int kt32, int lane) {
    const float* st = SC + (size_t)kt32 * 1024 + lane;
#pragma unroll
    for (int r = 0; r < 16; ++r) sc[r] = __builtin_nontemporal_load(st + r * 64);
}
template <int PASS> __device__ __forceinline__ void stream_pass(LAS unsigned char* lds, const float* SC, int qgb, int tid, int lane, int wave) {
    const int q = lane & 31, hi = lane >> 5;
    zero_hist(lds, tid, 16);
    const unsigned pfx = ((LAS unsigned*)(lds + PFX_OFF))[q]; const unsigned hbase = (unsigned)(uintptr_t)lds + 4u * (unsigned)q;
    float sc[16], sn[16];
    if (wave <= qgb) load_sc(sc, SC, wave, lane);
    for (int kt32 = wave; kt32 <= qgb; kt32 += 8) {
        const int ktn = kt32 + 8 <= qgb ? kt32 + 8 : kt32;
        load_sc(sn, SC, ktn, lane);
        if (kt32 == qgb) hist_tile<PASS, true>(sc, hbase, pfx, q, hi); else hist_tile<PASS, false>(sc, hbase, pfx, q, hi);
#pragma unroll
        for (int r = 0; r < 16; ++r) sc[r] = sn[r];
    }
    __syncthreads();
    scan_hist<PASS>(lds, tid, lane, wave);
}
__device__ __forceinline__ void refine_pass(LAS unsigned char* lds, const float* SC, int qgb, float aq, int tid, int lane, int wave) {
    const int q = lane & 31, hi = lane >> 5;
    zero_hist(lds, tid, 16);
    const unsigned pfx = ((LAS unsigned*)(lds + PFX_OFF))[q]; const unsigned hbase = (unsigned)(uintptr_t)lds + 4u * (unsigned)q;
    float sc[16], sn[16];
    if (wave <= qgb) load_sc(sc, SC, wave, lane);
    for (int kt32 = wave; kt32 <= qgb; kt32 += 8) {
        const int ktn = kt32 + 8 <= qgb ? kt32 + 8 : kt32;
        load_sc(sn, SC, ktn, lane);
        if (kt32 == qgb) hist_tile_sub<true>(sc, hbase, pfx, aq, q, hi); else hist_tile_sub<false>(sc, hbase, pfx, aq, q, hi);
#pragma unroll
        for (int r = 0; r < 16; ++r) sc[r] = sn[r];
    }
    __syncthreads();
    scan_hist<1>(lds, tid, lane, wave);
}
template <bool REF> __device__ __forceinline__ void fused_last(LAS unsigned char* lds, unsigned char* ws, const float* SC, unsigned* MK, int b, int qgb, int nout, float aq, int tid, int lane, int wave) {
    const int q = lane & 31, hi = lane >> 5;
    LAS unsigned* cu = (LAS unsigned*)lds; LAS unsigned* cp = cu + NTHR * CAPT; LAS unsigned* pcnt = cp + NTHR * CAPT; LAS unsigned* Lu = pcnt + NTHR; LAS unsigned* Lp = Lu + 32 * CAPQ;
    LAS unsigned* oflag = (LAS unsigned*)(lds + OFLAG_OFF);
    const unsigned pfx = ((LAS unsigned*)(lds + PFX_OFF))[q]; unsigned pc = 0u;
    float sa[16], sb[16], na[16], nb[16]; unsigned word = 0u;
    auto tile = [&](const float (&sc)[16], int kt64, int p) { const int kt32 = 2 * kt64 + p;
        if (kt32 <= qgb) {
#pragma unroll
            for (int r = 0; r < 16; ++r) { const bool causal = kt32 < qgb || crow(r, hi) <= q; const unsigned cls = cls_id<REF>(sc[r], aq);
                word |= ((causal && cls >= pfx) ? 1u : 0u) << (16 * p + r);
                if (causal && cls == pfx) { if (pc < (unsigned)CAPT) { cu[pc * NTHR + tid] = key32(sc[r]); cp[pc * NTHR + tid] = ((unsigned)kt64 << 6) | ((unsigned)hi << 5) | (unsigned)(16 * p + r); } ++pc; } } } };
    auto clampt = [&](int kt32) { return kt32 <= qgb ? kt32 : qgb; };
    if (wave < nout) { load_sc(sa, SC, clampt(2 * wave), lane); load_sc(sb, SC, clampt(2 * wave + 1), lane); }
    for (int kt64 = wave; kt64 < nout; kt64 += 8) { const int kn = kt64 + 8 < nout ? kt64 + 8 : kt64;
        load_sc(na, SC, clampt(2 * kn), lane); load_sc(nb, SC, clampt(2 * kn + 1), lane);
        word = 0u; tile(sa, kt64, 0); tile(sb, kt64, 1);
        MK[(size_t)kt64 * 64] = word;
#pragma unroll
        for (int r = 0; r < 16; ++r) { sa[r] = na[r]; sb[r] = nb[r]; } }
    pcnt[tid] = pc;
    asm volatile("s_waitcnt vmcnt(0)" ::: "memory");
    __syncthreads();
    const int sl = 2 * wave + hi; unsigned cq = 0u, off = 0u;
#pragma unroll
    for (int s2 = 0; s2 < 16; ++s2) { const unsigned cn = pcnt[(s2 >> 1) * 64 + (s2 & 1) * 32 + q]; cq += cn; off += s2 < sl ? cn : 0u; }
    if (pc > (unsigned)CAPT || cq > (unsigned)CAPQ) oflag[0] = 1u;
    else for (unsigned i = 0; i < pc; ++i) { Lu[q * CAPQ + off + i] = cu[i * NTHR + tid]; Lp[q * CAPQ + off + i] = cp[i * NTHR + tid]; }
    __syncthreads();
    const unsigned need = ((LAS unsigned*)(lds + NEED_OFF))[q];
    if (oflag[0] == 0u && cq > need && (unsigned)sl < cq) { unsigned um[CAPQ / 16], rk[CAPQ / 16];
#pragma unroll
        for (int k = 0; k < CAPQ / 16; ++k) { const unsigned i = (unsigned)(sl + 16 * k); um[k] = i < cq ? Lu[q * CAPQ + i] : 0xffffffffu; rk[k] = 0u; }
#pragma unroll 4
        for (unsigned j = 0; j < cq; ++j) { const unsigned v = Lu[q * CAPQ + j];
#pragma unroll
            for (int k = 0; k < CAPQ / 16; ++k) rk[k] += v > um[k] ? 1u : 0u; }
        unsigned* mkq = (unsigned*)(ws + WS_MASK) + (((size_t)b * 256 + (size_t)qgb) * 128) * 64 + q;
#pragma unroll
        for (int k = 0; k < CAPQ / 16; ++k) { const unsigned i = (unsigned)(sl + 16 * k);
            if (i < cq && rk[k] >= need) { const unsigned ps = Lp[q * CAPQ + i]; atomicAnd(mkq + (size_t)(ps >> 6) * 64 + ((ps >> 5) & 1u) * 32, ~(1u << (ps & 31u))); } } }
    asm volatile("s_waitcnt vmcnt(0)" ::: "memory");
    __syncthreads();
}
__device__ __forceinline__ void unit(LAS unsigned char* lds, unsigned char* ws, int b, int qgb, int tid, int lane, int wave) {
    asm volatile("" : "+v"(lane), "+v"(tid));
    const unsigned short* QI = (const unsigned short*)(ws + WS_QI); const unsigned short* KI = (const unsigned short*)(ws + WS_KI); const float* WI = (const float*)(ws + WS_WI);
    unsigned* MK = (unsigned*)(ws + WS_MASK) + (((size_t)b * 256 + (size_t)qgb) * 128) * 64 + lane;
    float* SC = (float*)(ws + WS_XG) + ((size_t)b * 32896 + (size_t)(qgb * (qgb + 1) / 2)) * 1024;
    const int q = lane & 31, hi = lane >> 5; const size_t qrow = (size_t)b * SEQ + (size_t)qgb * 32 + q, krow0 = (size_t)b * SEQ;
    const int nout = 4 * (qgb >> 3) + 4;
    if (qgb < 8) {
        for (int kt64 = wave; kt64 < nout; kt64 += 8) { unsigned word = 0u;
#pragma unroll
            for (int p = 0; p < 2; ++p) { const int kt32 = 2 * kt64 + p;
#pragma unroll
                for (int r = 0; r < 16; ++r) { const bool s = kt32 < qgb || (kt32 == qgb && crow(r, hi) <= q); word |= (s ? 1u : 0u) << (16 * p + r); } }
            MK[(size_t)kt64 * 64] = word; }
        return;
    }
    float wh[8];
#pragma unroll
    for (int h = 0; h < 8; ++h) wh[h] = WI[qrow * 8 + h] * (0.5f * 0.04419417382415922f);
#pragma unroll
    for (int ks = 0; ks < 4; ++ks) *(LAS bf16x8*)(lds + QF_OFF + (wave * 4 + ks) * 1024 + lane * 16) = *(const bf16x8*)(QI + qrow * 512 + wave * 64 + ks * 16 + hi * 8);
    __syncthreads();
    if (tid < 256) { const int ks = tid >> 6; float lin[8] = {0.f, 0.f, 0.f, 0.f, 0.f, 0.f, 0.f, 0.f};
#pragma unroll
        for (int h = 0; h < 8; ++h) { const bf16x8 f = *(const LAS bf16x8*)(lds + QF_OFF + (h * 4 + ks) * 1024 + lane * 16);
#pragma unroll
            for (int j = 0; j < 8; ++j) lin[j] = __builtin_fmaf(wh[h], bf2f((unsigned short)f[j]), lin[j]); }
        *(LAS v4u*)(lds + QF_OFF + (32 + ks) * 1024 + lane * 16) = (v4u){pk2(lin[0], lin[1]), pk2(lin[2], lin[3]), pk2(lin[4], lin[5]), pk2(lin[6], lin[7])}; }
    if (tid == 0) { *(LAS unsigned*)(lds + OFLAG_OFF) = 0u; *(LAS unsigned*)(lds + RFLAG_OFF) = 0u; }
    float aq; { float wn = 0.f;
#pragma unroll
        for (int h = 0; h < 8; ++h) wn = __builtin_fmaf(wh[h], wh[h], wn);
        aq = wn > 1e-30f ? 8.0f * __builtin_amdgcn_rsqf(wn) : 0.0f; }
    pass0(lds, KI, SC, krow0, qgb, wh, aq, tid, lane, wave);
    asm volatile("" : "+v"(lane), "+v"(tid));
    { int b2 = b, g2 = qgb; asm volatile("" : "+s"(b2), "+s"(g2)); b = b2; qgb = g2;
      MK = (unsigned*)(ws + WS_MASK) + (((size_t)b * 256 + (size_t)qgb) * 128) * 64 + lane; SC = (float*)(ws + WS_XG) + ((size_t)b * 32896 + (size_t)(qgb * (qgb + 1) / 2)) * 1024; }
    if (*(LAS unsigned*)(lds + RFLAG_OFF) != 0u) { refine_pass(lds, SC, qgb, aq, tid, lane, wave); fused_last<true>(lds, ws, SC, MK, b, qgb, nout, aq, tid, lane, wave); }
    else fused_last<false>(lds, ws, SC, MK, b, qgb, nout, aq, tid, lane, wave);
    { LAS unsigned* oflag = (LAS unsigned*)(lds + OFLAG_OFF);
      if (oflag[0] != 0u) {
          stream_pass<0>(lds, SC, qgb, tid, lane, wave);
          stream_pass<1>(lds, SC, qgb, tid, lane, wave);
          stream_pass<2>(lds, SC, qgb, tid, lane, wave);
          const unsigned thr = ((LAS unsigned*)(lds + PFX_OFF))[q];
          for (int kt64 = wave; kt64 < nout; kt64 += 8) { unsigned word = 0u;
#pragma unroll
              for (int p = 0; p < 2; ++p) { const int kt32 = 2 * kt64 + p;
                  if (kt32 <= qgb) { float sc[16]; load_sc(sc, SC, kt32, lane);
#pragma unroll
                      for (int r = 0; r < 16; ++r) { const bool sel = (kt32 < qgb || crow(r, hi) <= q) && key32(sc[r]) >= thr; word |= (sel ? 1u : 0u) << (16 * p + r); } } }
              MK[(size_t)kt64 * 64] = word; } } }
    __syncthreads();
}
}
__device__ __forceinline__ void indexer_phase(Frame& F) {
    for (int v = F.vcu; v < 256; v += F.G) {
        idx::unit(F.lds, F.ws, 0, v, F.tid, F.lane, F.wave);
        idx::unit(F.lds, F.ws, 1, 255 - v, F.tid, F.lane, F.wave);
    }
}
__device__ __forceinline__ void kmax_phase(Frame& F) {
    LAS float* red = (LAS float*)(F.lds + MISC_OFF + 3072);
    for (int v = F.vcu; v < 256; v += F.G) { const int bh = v >> 4, part = v & 15;
        const bf16* kr = (const bf16*)(F.ws + WS_K) + ((size_t)(bh >> 3) * SEQ + (size_t)part * 512 + F.tid) * 512 + (bh & 7) * 64; float ss = 0.f;
#pragma unroll
        for (int c = 0; c < 8; ++c) { const v4u w = *(const v4u*)(kr + 8 * c); const float x[8] = {bflo(w.x), bfhi(w.x), bflo(w.y), bfhi(w.y), bflo(w.z), bfhi(w.z), bflo(w.w), bfhi(w.w)};
#pragma unroll
            for (int i = 0; i < 8; ++i) ss = __builtin_fmaf(x[i], x[i], ss); }
        ss = wave_max(ss);
        __syncthreads();
        if (F.lane == 0) red[F.wave] = ss;
        __syncthreads();
        if (F.tid == 0) { float m = red[0];
#pragma unroll
            for (int w = 1; w < 8; ++w) m = fmaxf(m, red[w]);
            atomicMax((unsigned*)(F.ws + WS_CTL) + CW_KMAX + bh, __builtin_bit_cast(unsigned, m)); } }
}
constexpr size_t WS_OPART = WS_XG;
constexpr size_t WS_LSE = WS_XG + 64 * MiB;
__device__ __forceinline__ void attn_item(int i, int pr, int& h, int& qb, int& toff, int& ntp, bool& part) {
    const int hs = i / 48, r = i % 48; h = pr == 0 ? 7 : pr == 1 ? 6 : pr == 2 ? (hs == 0 ? 5 : 3) : (hs == 0 ? 4 : 3 - hs);
    if (r < 32) { qb = 31 - (r >> 1); part = true; if ((r & 1) == 0) { toff = 0; ntp = 64; } else { toff = 64; ntp = 4 * (qb + 1) - 64; } }
    else { qb = 47 - r; part = false; toff = 0; ntp = 4 * (qb + 1); }
}
__device__ __forceinline__ int attn_cost(int i, int pr) {
    int h, qb, toff, ntp; bool part; attn_item(i, pr, h, qb, toff, ntp, part);
    const int cap = h == 7 ? 128 : h == 6 ? 116 : h == 5 ? 62 : h == 4 ? 36 : h == 3 ? 22 : h == 2 ? 16 : h == 1 ? 12 : 10;
    const int lim = 4 * (qb + 1) < cap ? 4 * (qb + 1) : cap, c = lim - toff;
    return c <= 0 ? 0 : (c > ntp ? ntp : c);
}
__device__ __forceinline__ bool conv_up_tickets(Frame& F, const float* wup, int n) {
    volatile LAS int* qs = (volatile LAS int*)(F.lds + MISC_OFF + 3072); LAS float* scr = (LAS float*)(F.lds + F.wave * 16640);
    for (int k = 0; k < n; ++k) {
        __syncthreads();
        if (F.tid == 0) qs[2] = (int)atomicAdd((unsigned*)(F.ws + WS_CTL) + CW_CVU, 1u);
        __syncthreads();
        const int u = qs[2];
        if (u >= NE * 512 / NWAVES) return false;
        const int item = u * NWAVES + F.wave, e = item >> 9;
        p0_transpose_item(wup + (size_t)e * D * 2048, D, 2048, 2048, 2, (bf16*)(F.ws + WS_WUP) + (size_t)e * 2048 * D, scr, item & 511, F.lane);
    }
    return true;
}
__device__ __forceinline__ void attn_phase(Frame& F, unsigned char* lds_generic, const float* wup) {
    volatile LAS int* qs = (volatile LAS int*)(F.lds + MISC_OFF + 3072); volatile LAS int* ord = qs + 16;
    const float* kmx = (const float*)((unsigned*)(F.ws + WS_CTL) + CW_KMAX);
    __syncthreads();
    const int NI = ((F.vcu >> 5) & 3) < 2 ? 48 : ((F.vcu >> 5) & 3) == 2 ? 96 : 192;
    if (F.tid == 0) { qs[0] = NI; qs[1] = -1; }
    __syncthreads();
    for (;;) {
        const int u = qs[0]; int st = qs[1];
        __syncthreads();
        if (u >= NI) {
            ++st; if (st >= 1) break;
            const int y = (((F.vcu >> 5) & 7) + st) & 7, pr = y & 3;
            { volatile LAS int* cst = ord + 192;
              if (F.tid < NI) cst[F.tid] = attn_cost(F.tid, pr);
              __syncthreads();
              if (F.tid < NI) { const int c = cst[F.tid]; int rank = 0;
                  for (int j = 0; j < NI; ++j) { const int cj = cst[j]; rank += (cj > c || (cj == c && j < F.tid)) ? 1 : 0; }
                  ord[rank] = F.tid; } }
            if (F.tid == 0) { qs[0] = (int)atomicAdd((unsigned*)(F.ws + WS_CTL) + CW_ATTQ + 64 * y, 1u); qs[1] = st; }
            __syncthreads();
            continue; }
        const int y = (((F.vcu >> 5) & 7) + st) & 7, b = y >> 2;
        int nxt = 0; if (F.tid == 0) nxt = (int)atomicAdd((unsigned*)(F.ws + WS_CTL) + CW_ATTQ + 64 * y, 1u);
        int h, qb, toff, ntp; bool part; attn_item(ord[u], y & 3, h, qb, toff, ntp, part);
        const size_t piece = ((size_t)((b * 8 + h) * 32 + qb)) * 2 + (toff ? 1 : 0);
        attn_body::attn_unit<8>(b, h, qb, toff, ntp, part, (const attn_body::bf16*)(F.ws + WS_Q), (const attn_body::bf16*)(F.ws + WS_K), (const attn_body::bf16*)(F.ws + WS_V),
                                (attn_body::bf16*)(F.ws + WS_O), (attn_body::bf16*)(F.ws + WS_OPART) + piece * 256 * 64, (float*)(F.ws + WS_LSE) + piece * 256,
                                (const unsigned*)(F.ws + WS_MASK), kmx[b * 8 + h], (char*)lds_generic);
        if (F.tid == 0) qs[0] = nxt;
        __syncthreads();
    }
    for (;;) {
        if (F.tid == 0) qs[0] = (int)atomicAdd((unsigned*)(F.ws + WS_CTL) + CW_GLUQ, 1u);
        __syncthreads();
        const int u = qs[0];
        __syncthreads();
        if (u >= 512) break;
        pg8::Gemm g{(const bf16*)(F.ws + WS_YG), (const bf16*)(F.ws + WS_WGLU), T, 2048, SSMW}; pg8::OneUnit S{{u >> 3, u & 7, u & 7, 0}, true};
        EpiGlu E{F.ws}; pg8::gemm_phase<EpiGlu, pg8::OneUnit, false, true>(F.lds, g, S, E);
        (void)conv_up_tickets(F, wup, 4);
    }
    while (conv_up_tickets(F, wup, 4)) {}
}
__device__ __forceinline__ void attn_merge(Frame& F) {
    const int gt = F.vcu * NTHR + F.tid, NGT = F.G * NTHR;
    const bf16* OPp = (const bf16*)(F.ws + WS_OPART); const float* LS = (const float*)(F.ws + WS_LSE); bf16* O = (bf16*)(F.ws + WS_O);
    constexpr int NIT = 16 * 16 * 256 * 8;
    for (int i0 = gt; i0 < NIT; i0 += 4 * NGT) {
        float l0[4], l1[4]; size_t p0[4]; int row[4], ch[4], qb[4], bh[4];
#pragma unroll
        for (int k = 0; k < 4; ++k) { const int i = i0 + k * NGT < NIT ? i0 + k * NGT : i0;
            ch[k] = i & 7; row[k] = (i >> 3) & 255; qb[k] = 16 + ((i >> 11) & 15); bh[k] = i >> 15; p0[k] = ((size_t)(bh[k] * 32 + qb[k])) * 2;
            l0[k] = LS[p0[k] * 256 + row[k]]; l1[k] = LS[(p0[k] + 1) * 256 + row[k]]; }
        v4u a[4], c[4]; float f0[4], f1[4];
#pragma unroll
        for (int k = 0; k < 4; ++k) { const float mx = fmaxf(l0[k], l1[k]), w0 = exp2f(l0[k] - mx), w1 = exp2f(l1[k] - mx), inv = 1.f / (w0 + w1); f0[k] = w0 * inv; f1[k] = w1 * inv;
            a[k] = (v4u){0u, 0u, 0u, 0u}; c[k] = (v4u){0u, 0u, 0u, 0u};
            if (w0 > 0.f) a[k] = *(const v4u*)(OPp + (p0[k] * 256 + row[k]) * 64 + ch[k] * 8);
            if (w1 > 0.f) c[k] = *(const v4u*)(OPp + ((p0[k] + 1) * 256 + row[k]) * 64 + ch[k] * 8); }
#pragma unroll
        for (int k = 0; k < 4; ++k) if (i0 + k * NGT < NIT) { v4u o;
            o.x = pk2(f0[k] * bflo(a[k].x) + f1[k] * bflo(c[k].x), f0[k] * bfhi(a[k].x) + f1[k] * bfhi(c[k].x)); o.y = pk2(f0[k] * bflo(a[k].y) + f1[k] * bflo(c[k].y), f0[k] * bfhi(a[k].y) + f1[k] * bfhi(c[k].y));
            o.z = pk2(f0[k] * bflo(a[k].z) + f1[k] * bflo(c[k].z), f0[k] * bfhi(a[k].z) + f1[k] * bfhi(c[k].z)); o.w = pk2(f0[k] * bflo(a[k].w) + f1[k] * bflo(c[k].w), f0[k] * bfhi(a[k].w) + f1[k] * bfhi(c[k].w));
            *(v4u*)(O + ((size_t)(bh[k] >> 3) * SEQ + (size_t)qb[k] * 256 + row[k]) * 512 + (bh[k] & 7) * 64 + ch[k] * 8) = o; }
    }
}

__device__ __forceinline__ void ln1_router(Frame& F, const Args& a) {
    typedef float f32x16 __attribute__((ext_vector_type(16)));
    constexpr int RS = 1028;
    LAS float* tile = (LAS float*)F.lds; LAS float* part = (LAS float*)F.lds; LAS float* lg = (LAS float*)(F.lds + 32768);
    const int lane = F.lane, wave = F.wave, tid = F.tid;
    float* H = (float*)(F.ws + WS_H); const float* MIX = (const float*)(F.ws + WS_MIX); bf16* XN = (bf16*)(F.ws + WS_XN);
    int* top_e = (int*)(F.ws + WS_RT); float* top_g = (float*)(F.ws + WS_RT + 256 * 1024);
    unsigned* cnt = (unsigned*)(F.ws + WS_CTL) + CW_CNT;
    const f32x4* WRF = (const f32x4*)(F.ws + WS_WRF); const float* br = a.in[19];
    LAS unsigned* lcnt = (LAS unsigned*)(F.lds + 132096);
    int* lrank = (int*)(F.ws + WS_RT + 512 * 1024);
    if (tid < NE) lcnt[tid] = 0u;
    __syncthreads();
    f32x4 wrf[16];
#pragma unroll
    for (int tt = 0; tt < 16; ++tt) wrf[tt] = WRF[(16 * wave + tt) * 64 + lane];
    for (int grp = F.vcu; grp < T / 32; grp += F.G) {
        {
          f32x4 v[4][4]; const size_t m0 = (size_t)grp * 32 + 4 * wave;
#pragma unroll
          for (int i = 0; i < 4; ++i)
#pragma unroll
              for (int j = 0; j < 4; ++j) { const v2u hw = ((const GAS v2u*)(XN + (m0 + i) * D) + lane)[64 * j], mw = ((const GAS v2u*)((const bf16*)MIX + (m0 + i) * D) + lane)[64 * j];
                  v[i][j] = (f32x4){bflo(hw.x), bfhi(hw.x), bflo(hw.y), bfhi(hw.y)} * ALPHA + (f32x4){bflo(mw.x), bfhi(mw.x), bflo(mw.y), bfhi(mw.y)}; }
          f32x4 gg[4], bb[4];
#pragma unroll
          for (int j = 0; j < 4; ++j) { gg[j] = ((const GAS f32x4*)a.in[16] + lane)[64 * j]; bb[j] = ((const GAS f32x4*)a.in[17] + lane)[64 * j]; }
          float sm[4], sq[4];
#pragma unroll
          for (int i = 0; i < 4; ++i) { sm[i] = 0.f;
#pragma unroll
              for (int j = 0; j < 4; ++j) sm[i] += (v[i][j].x + v[i][j].y) + (v[i][j].z + v[i][j].w); }
#pragma unroll
          for (int o = 1; o < 64; o <<= 1)
#pragma unroll
              for (int i = 0; i < 4; ++i) sm[i] += __shfl_xor(sm[i], o);
#pragma unroll
          for (int i = 0; i < 4; ++i) { const float mean = sm[i] * (1.f / D); sq[i] = 0.f;
#pragma unroll
              for (int j = 0; j < 4; ++j) { v[i][j] = v[i][j] - mean; sq[i] += (v[i][j].x * v[i][j].x + v[i][j].y * v[i][j].y) + (v[i][j].z * v[i][j].z + v[i][j].w * v[i][j].w); } }
#pragma unroll
          for (int o = 1; o < 64; o <<= 1)
#pragma unroll
              for (int i = 0; i < 4; ++i) sq[i] += __shfl_xor(sq[i], o);
#pragma unroll
          for (int i = 0; i < 4; ++i) { const float rstd = 1.f / sqrtf(sq[i] * (1.f / D) + LN_EPS); const int r = 4 * wave + i;
#pragma unroll
              for (int j = 0; j < 4; ++j) { const f32x4 y = v[i][j] * rstd * gg[j] + bb[j];
                  ((GAS v2u*)(XN + (m0 + i) * D) + lane)[64 * j] = (v2u){pk2(y.x, y.y), pk2(y.z, y.w)};
                  *(LAS f32x4*)(tile + r * RS + 256 * j + 4 * lane) = y; } } }
        __syncthreads();
        f32x16 acc = {};
#pragma unroll
        for (int tt = 0; tt < 16; ++tt) { const int t = 16 * wave + tt;
            const f32x4 bv = *(const LAS f32x4*)(tile + (lane & 31) * RS + 8 * t + 4 * (lane >> 5)); const f32x4 av = wrf[tt];
#pragma unroll
            for (int j = 0; j < 4; ++j) acc = __builtin_amdgcn_mfma_f32_32x32x2f32(av[j], bv[j], acc, 0, 0, 0); }
        __syncthreads();
#pragma unroll
        for (int r = 0; r < 16; ++r) part[wave * 1024 + r * 64 + lane] = acc[r];
        __syncthreads();
#pragma unroll
        for (int k = 0; k < 2; ++k) { const int idx = tid + 512 * k; float sum = 0.f;
#pragma unroll
            for (int w = 0; w < 8; ++w) sum += part[w * 1024 + idx];
            const int r = idx >> 6, l = idx & 63, e = (r & 3) + 8 * (r >> 2) + 4 * (l >> 5), row = l & 31;
            lg[row * 33 + e] = sum + br[e]; }
        __syncthreads();
        if (tid < 32) { const size_t m = (size_t)grp * 32 + tid; float tv[4] = {-INFINITY, -INFINITY, -INFINITY, -INFINITY}; int te[4] = {0, 0, 0, 0};
            for (int e = 0; e < NE; ++e) { const float x = lg[tid * 33 + e];
                if (x > tv[3]) { tv[3] = x; te[3] = e;
#pragma unroll
                    for (int k = 3; k > 0; --k) if (tv[k] > tv[k - 1]) { const float tf = tv[k]; tv[k] = tv[k - 1]; tv[k - 1] = tf; const int ti = te[k]; te[k] = te[k - 1]; te[k - 1] = ti; } } }
            const float e1 = __expf(tv[1] - tv[0]), e2 = __expf(tv[2] - tv[0]), e3 = __expf(tv[3] - tv[0]); const float inv = 1.f / (1.f + e1 + e2 + e3);
            *(int4*)(top_e + m * 4) = make_int4(te[0], te[1], te[2], te[3]); *(f32x4*)(top_g + m * 4) = (f32x4){inv, e1 * inv, e2 * inv, e3 * inv};
            int4 rk;
            rk.x = (int)atomicAdd((unsigned*)&lcnt[te[0]], 1u); rk.y = (int)atomicAdd((unsigned*)&lcnt[te[1]], 1u); rk.z = (int)atomicAdd((unsigned*)&lcnt[te[2]], 1u); rk.w = (int)atomicAdd((unsigned*)&lcnt[te[3]], 1u);
            *(int4*)(lrank + m * 4) = rk; }
        __syncthreads();
    }
    if (tid < NE) ((unsigned*)(F.ws + WS_BASE))[F.vcu * NE + tid] = atomicAdd(cnt + tid, lcnt[tid]);
}
__device__ __forceinline__ void moe_offsets(const unsigned* cnt, LAS int* pstart  , LAS int* tile_e  , int tid) {
    LAS int* cl = (LAS int*)((LAS unsigned char*)pstart + 12288);
    if (tid < NE) cl[tid] = (int)__hip_atomic_load(cnt + tid, __ATOMIC_RELAXED, __HIP_MEMORY_SCOPE_AGENT);
    __syncthreads();
    if (tid == 0) { int s = 0; for (int e = 0; e < NE; ++e) { pstart[e] = s; const int nt = (cl[e] + 255) >> 8; for (int t = 0; t < nt; ++t) tile_e[(s >> 8) + t] = e; s += nt << 8; } pstart[NE] = s; }
    __syncthreads();
}
__device__ __forceinline__ void moe_scatter(Frame& F) {
    LAS int* pstart = (LAS int*)(F.lds + MISC_OFF); LAS int* tile_e = pstart + 64;
    unsigned* ctl = (unsigned*)(F.ws + WS_CTL);
    moe_offsets(ctl + CW_CNT, pstart, tile_e, F.tid);
    const int gt = F.vcu * NTHR + F.tid, NGT = F.G * NTHR;
    const int* top_e = (const int*)(F.ws + WS_RT); const float* top_g = (const float*)(F.ws + WS_RT + 256 * 1024);
    int* slot_of = (int*)(F.ws + WS_RT + 512 * 1024); float* row_gate = (float*)(F.ws + WS_RT + 768 * 1024); int* row_tok = (int*)(F.ws + WS_RT + 1280 * 1024);
    for (int idx = gt; idx < T * 4; idx += NGT) { const int m = idx >> 2, e = top_e[idx], blk = (m >> 5) % F.G;
        const int slot = pstart[e] + (int)((const unsigned*)(F.ws + WS_BASE))[blk * NE + e] + slot_of[idx];
        slot_of[idx] = slot; row_gate[slot] = top_g[idx]; row_tok[slot] = m; }
    for (int idx = gt; idx < NE * 256; idx += NGT) { const int e = idx >> 8, sl = pstart[e] + (int)ctl[CW_CNT + e] + (idx & 255);
        if (sl < pstart[e + 1]) { row_tok[sl] = 0; row_gate[sl] = 0.f; } }
}
__device__ __forceinline__ void moe_combine(Frame& F, const Args& a) {
    const int gw = F.vcu * NWAVES + F.wave, NGW = F.G * NWAVES, lane = F.lane;
    const bf16* XNb = (const bf16*)(F.ws + WS_XN); const bf16* Y = (const bf16*)(F.ws + WS_XG); const int* slot_of = (const int*)(F.ws + WS_RT + 512 * 1024);
    f32x4 gg[4], bb[4];
#pragma unroll
    for (int j = 0; j < 4; ++j) { gg[j] = ((const GAS f32x4*)a.in[24] + lane)[64 * j]; bb[j] = ((const GAS f32x4*)a.in[25] + lane)[64 * j]; }
    for (int m = gw; m + NGW < T; m += 2 * NGW) {
        const int4 sa = *(const int4*)(slot_of + (size_t)m * 4), sb = *(const int4*)(slot_of + (size_t)(m + NGW) * 4);
        const int ss[2][4] = {{sa.x, sa.y, sa.z, sa.w}, {sb.x, sb.y, sb.z, sb.w}};
        v2u hw[2][4], yw[2][4][4];
#pragma unroll
        for (int t = 0; t < 2; ++t)
#pragma unroll
            for (int j = 0; j < 4; ++j) { hw[t][j] = ((const GAS v2u*)(XNb + (size_t)(m + t * NGW) * D) + lane)[64 * j];
#pragma unroll
                for (int k = 0; k < 4; ++k) yw[t][k][j] = ((const GAS v2u*)(Y + (size_t)ss[t][k] * D) + lane)[64 * j]; }
        f32x4 v[2][4]; float s[2], q[2];
#pragma unroll
        for (int t = 0; t < 2; ++t) { s[t] = 0.f;
#pragma unroll
            for (int j = 0; j < 4; ++j) { v[t][j] = (f32x4){bflo(hw[t][j].x), bfhi(hw[t][j].x), bflo(hw[t][j].y), bfhi(hw[t][j].y)} * ALPHA;
#pragma unroll
                for (int k = 0; k < 4; ++k) { const v2u w = yw[t][k][j]; v[t][j] += (f32x4){bflo(w.x), bfhi(w.x), bflo(w.y), bfhi(w.y)}; }
                s[t] += (v[t][j].x + v[t][j].y) + (v[t][j].z + v[t][j].w); } }
#pragma unroll
        for (int o = 1; o < 64; o <<= 1) { s[0] += __shfl_xor(s[0], o); s[1] += __shfl_xor(s[1], o); }
#pragma unroll
        for (int t = 0; t < 2; ++t) { const float mean = s[t] * (1.f / D); q[t] = 0.f;
#pragma unroll
            for (int j = 0; j < 4; ++j) { v[t][j] = v[t][j] - mean; q[t] += (v[t][j].x * v[t][j].x + v[t][j].y * v[t][j].y) + (v[t][j].z * v[t][j].z + v[t][j].w * v[t][j].w); } }
#pragma unroll
        for (int o = 1; o < 64; o <<= 1) { q[0] += __shfl_xor(q[0], o); q[1] += __shfl_xor(q[1], o); }
#pragma unroll
        for (int t = 0; t < 2; ++t) { const float rstd = 1.f / sqrtf(q[t] * (1.f / D) + LN_EPS);
#pragma unroll
            for (int j = 0; j < 4; ++j) ((GAS f32x4*)(a.out + (size_t)(m + t * NGW) * D) + lane)[64 * j] = v[t][j] * rstd * gg[j] + bb[j]; }
    }
}

constexpr int N_PHASES = 13;
__global__ void __launch_bounds__(NTHR, 2) fwd(Args args) {
    extern __shared__ __attribute__((aligned(16))) unsigned char lds[];
    Frame F; F.lds = (LAS unsigned char*)lds; F.tid = threadIdx.x; F.lane = F.tid & 63; F.wave = __builtin_amdgcn_readfirstlane(F.tid >> 6);
    F.G = gridDim.x; { const int bx = blockIdx.x; F.vcu = (F.G % 8 == 0) ? (bx % 8) * (F.G / 8) + bx / 8 : bx; }
    F.ws = args.ws;
    const int lo = args.ph_lo, hi = args.ph_hi;
    { volatile LAS unsigned* st0 = (volatile LAS unsigned*)(F.lds + LDS_BYTES - 16); if (F.tid < 2) st0[F.tid] = 0u; }
    __syncthreads();
    const XcdBarrier gbar = xcd_barrier_post((unsigned*)(F.ws + WS_CTL) + CW_BAR, (volatile LAS unsigned*)(F.lds + LDS_BYTES - 16));
#define GSYNC() xcd_barrier(gbar)
#define IN(k) (lo <= (k) && (k) < hi)
#define SEAM(k) do { if (IN(k) && IN((k) + 1)) GSYNC(); } while (0)
    if (IN(0)) p0_prologue(F, args);
    SEAM(0);
    if (IN(1)) { pg8::Gemm g{(const bf16*)(F.ws + WS_XN), (const bf16*)(F.ws + WS_WIN), T, IN_WP, D}; pg8::StaticOrder S; S.init(T, IN_WP, F.G, (int)blockIdx.x);
        EpiIn E{F.ws, args.in[4]}; pg8::gemm_phase<EpiIn, pg8::StaticOrder, true, true>(F.lds, g, S, E);
        if (F.G == 256 && blockIdx.x >= 192) (void)conv_up_tickets(F, args.in[20], 3); }
    SEAM(1);
    if (IN(2)) s5::phase_a(F);
    SEAM(2);
    if (IN(3)) s5::phase_b(F);
    if (IN(5)) { kmax_phase(F); indexer_phase(F); GSYNC(); attn_phase(F, lds, args.in[20]); GSYNC(); attn_merge(F); }
    SEAM(5);
    if (IN(6)) {
      for (int c = blockIdx.x; c < 256; c += F.G) {
        const bool have = true; const int pm = c >> 2, s = c & 3;
        { pg8::Gemm g{(const bf16*)(F.ws + WS_O), (const bf16*)(F.ws + WS_WAP), T, D, AW}; pg8::OneUnit S{{pm, s, s, 0}, have};
            EpiAtt E{F.ws}; pg8::gemm_phase<EpiAtt, pg8::OneUnit, false, true>(F.lds, g, S, E); }
      }
    }
    SEAM(6);
    if (IN(7)) { pg8::Gemm g{(const bf16*)(F.ws + WS_Z), (const bf16*)(F.ws + WS_WO), T, D, D}; pg8::StaticOrder S; S.init(T, D, F.G, (int)blockIdx.x);
        EpiMix E{(bf16*)(F.ws + WS_MIX)}; pg8::gemm_phase<EpiMix, pg8::StaticOrder, false, true>(F.lds, g, S, E); }
    SEAM(7);
    if (IN(8)) ln1_router(F, args);
    SEAM(8);
    if (IN(9)) moe_scatter(F);
    SEAM(9);
    if (IN(10) || IN(11)) {
        LAS int* pstart = (LAS int*)(F.lds + MISC_OFF); LAS int* tile_e = pstart + 64;
        __syncthreads();
        moe_offsets((unsigned*)(F.ws + WS_CTL) + CW_CNT, pstart, tile_e, F.tid);
        const int ntiles = pstart[NE] >> 8;
        if (IN(10)) { LAS int* tokl = (LAS int*)(F.lds + MISC_OFF + 1536); const int* row_tok = (const int*)(F.ws + WS_RT + 1280 * 1024);
            pg8::MoeOrder S{ntiles * 8, 8, F.G, (int)blockIdx.x, tile_e};
            for (int i = 0; i < 9; ++i) { pg8::Unit uu; if (S.next(i, uu) && F.tid < 256) tokl[i * 256 + F.tid] = row_tok[uu.pm * 256 + F.tid]; }
            __syncthreads();
            pg8::Gemm g{(const bf16*)(F.ws + WS_XN), (const bf16*)(F.ws + WS_WUP), MOE_ROWS, 2048, D, tokl};
            EpiSwiglu E{F.ws, args.in[21]}; pg8::gemm_phase<EpiSwiglu, pg8::MoeOrder, true, true, true>(F.lds, g, S, E);
            { volatile LAS int* qs = (volatile LAS int*)(F.lds + MISC_OFF + 3072); LAS float* scr = (LAS float*)(F.lds + F.wave * 16640);
              for (;;) {
                  if (F.tid == 0) qs[0] = (int)atomicAdd((unsigned*)(F.ws + WS_CTL) + CW_CVQ, 1u);
                  __syncthreads();
                  const int u = qs[0];
                  __syncthreads();
                  if (u >= NE * 256 / NWAVES) break;
                  const int item = u * NWAVES + F.wave, e = item >> 8;
                  p0_transpose_item(args.in[22] + (size_t)e * FF * D, FF, D, D, 0, (bf16*)(F.ws + WS_WDN) + (size_t)e * D * FF, scr, item & 255, F.lane); }
              __syncthreads();
              moe_offsets((unsigned*)(F.ws + WS_CTL) + CW_CNT, pstart, tile_e, F.tid); } }
        SEAM(10);
        if (IN(11)) { pg8::Gemm g{(const bf16*)(F.ws + WS_HH), (const bf16*)(F.ws + WS_WDN), MOE_ROWS, D, FF}; pg8::MoeOrder S{ntiles * 4, 4, F.G, (int)blockIdx.x, tile_e};
            EpiDown E{F.ws, args.in[23], (const float*)(F.ws + WS_RT + 768 * 1024)}; pg8::gemm_phase<EpiDown, pg8::MoeOrder, true, true>(F.lds, g, S, E); }
    }
    SEAM(11);
    if (IN(12)) moe_combine(F, args);
#undef IN
#undef SEAM
}

extern "C" void kernel_launch(void* const* d_in, const int* in_sizes, int n_in, void* d_out, int out_size, void* d_ws, size_t ws_size, hipStream_t stream) {
    static int grid = 0;
    if (grid == 0) {
        if (n_in != 26 || ws_size < WS_END) { fprintf(stderr, "kernel_launch: unexpected n_in %d / ws %zu\n", n_in, ws_size); grid = -1; return; }
        if (hipFuncSetAttribute((const void*)fwd, hipFuncAttributeMaxDynamicSharedMemorySize, LDS_BYTES) != hipSuccess) { fprintf(stderr, "hipFuncSetAttribute failed\n"); grid = -1; return; }
        int dev = 0, cus = 0, per_cu = 0;
        hipGetDevice(&dev); hipDeviceGetAttribute(&cus, hipDeviceAttributeMultiprocessorCount, dev);
        if (hipOccupancyMaxActiveBlocksPerMultiprocessor(&per_cu, (const void*)fwd, NTHR, LDS_BYTES) != hipSuccess || per_cu < 1) { fprintf(stderr, "occupancy query failed (%d)\n", per_cu); grid = -1; return; }
        grid = cus * per_cu; if (grid < 256) { fprintf(stderr, "needs 256 resident workgroups (have %d)\n", grid); grid = -1; return; } grid = 256;
        grid &= ~7; if (grid < 8) { grid = -1; return; }
    }
    if (grid < 0) return;
    (void)hipMemsetAsync((char*)d_ws + WS_CTL, 0, CTL_ZERO_BYTES, stream);
    Args a{};
    for (int i = 0; i < 26; ++i) a.in[i] = (const float*)d_in[i];
    a.out = (float*)d_out; a.ws = (unsigned char*)d_ws;
    a.ph_lo = 0; a.ph_hi = N_PHASES;
    void* kargs[] = {&a};
    hipError_t e = hipLaunchCooperativeKernel((const void*)fwd, dim3(grid), dim3(NTHR), kargs, LDS_BYTES, stream);
    if (e != hipSuccess) fprintf(stderr, "cooperative launch failed: %s (grid %d)\n", hipGetErrorString(e), grid);
}
```
